# Optimizing an MI355X kernel written in HIP

```python
import jax, jax.numpy as jnp
from jax import lax
import numpy as np

D_MODEL = 1024
BATCH = 8
SEQ = 2048
DEPTH = 4
DEC_BATCH = 16
DEC_SEQ = 32
PAST_LEN = 4096

CHUNK = 64
N_META = 16
HA = D_MODEL // 128
DK = 128
DV = 128
QK_W = HA * DK
V_W = HA * DV
QKV_W = 2 * QK_W + V_W
LRU_W = D_MODEL
NB = D_MODEL // 128
BW = LRU_W // NB
CONV_W = 4
LRU_C = 8.0
D_FF = ((8 * D_MODEL // 3 + 127) // 128) * 128
EPS = 1e-6

OFF_Z = QKV_W
OFF_BETA = OFF_Z + V_W
OFF_ALPHA = OFF_BETA + HA
OFF_LX = OFF_ALPHA + HA
OFF_LY = OFF_LX + LRU_W
OFF_GA = OFF_LY + LRU_W
OFF_GB = OFF_GA + D_MODEL
IN_COLS = OFF_GB + D_MODEL

kernel_name = "hybrid_gdn_rglru_macaron_stream_step"


def _rmsnorm(x, w):
    xf = x.astype(jnp.float32)
    y = xf * lax.rsqrt(jnp.mean(xf * xf, axis=-1, keepdims=True) + EPS)
    return (y * w.astype(jnp.float32)).astype(x.dtype)


def _l2norm(t):
    return t * lax.rsqrt(jnp.sum(t * t, axis=-1, keepdims=True) + EPS)


def _swiglu(xn, w_gu, w_down):
    gate, up = jnp.split(xn @ w_gu, 2, axis=-1)
    return (jax.nn.silu(gate) * up) @ w_down


def _causal_conv(x, buf, w):
    L = x.shape[1]
    xp = jnp.concatenate([buf.astype(x.dtype), x], axis=1)
    y = xp[:, 0:L] * w[0]
    for j in range(1, CONV_W):
        y = y + xp[:, j:j + L] * w[j]
    return y, xp[:, -(CONV_W - 1):]


def _gated_delta_rule(q, k, v, g, beta, S0, chunk):
    B, H, L, _ = q.shape
    n = L // chunk
    rs = lambda t: t.reshape((B, H, n, chunk) + t.shape[3:])
    q, k, v, g, beta = rs(q), rs(k), rs(v), rs(g), rs(beta)
    g = jnp.cumsum(g, axis=-1)
    tri_incl = jnp.tril(jnp.ones((chunk, chunk), bool))
    tri_strict = jnp.tril(jnp.ones((chunk, chunk), bool), -1)
    diff = g[..., :, None] - g[..., None, :]
    decay = jnp.where(tri_incl, jnp.exp(jnp.where(tri_incl, diff, 0.0)), 0.0)
    k_beta = k * beta[..., None]
    v_beta = v * beta[..., None]
    low = jnp.where(tri_strict, jnp.einsum('bhnid,bhnjd->bhnij', k_beta, k) * decay, 0.0)
    eye = jnp.eye(chunk, dtype=q.dtype)
    T = lax.linalg.triangular_solve(eye + low, jnp.broadcast_to(eye, low.shape),
                                    left_side=True, lower=True)
    u = jnp.einsum('bhnij,bhnjd->bhnid', T, v_beta)
    w = jnp.einsum('bhnij,bhnjd->bhnid', T, k_beta * jnp.exp(g)[..., None])
    a_intra = jnp.where(tri_incl, jnp.einsum('bhnid,bhnjd->bhnij', q, k) * decay, 0.0)
    q_dec = q * jnp.exp(g)[..., None]
    k_dec = k * jnp.exp(g[..., -1:] - g)[..., None]
    g_last = jnp.exp(g[..., -1])

    def step(S, xs):
        u_i, w_i, qd_i, kd_i, a_i, gl_i = xs
        v_new = u_i - jnp.einsum('bhck,bhkv->bhcv', w_i, S)
        o = jnp.einsum('bhck,bhkv->bhcv', qd_i, S) + jnp.einsum('bhij,bhjv->bhiv', a_i, v_new)
        S = S * gl_i[..., None, None] + jnp.einsum('bhck,bhcv->bhkv', kd_i, v_new)
        return S, o

    mv = lambda t: jnp.moveaxis(t, 2, 0)
    S, o = lax.scan(step, S0, (mv(u), mv(w), mv(q_dec), mv(k_dec), mv(a_intra), mv(g_last)))
    o = jnp.moveaxis(o, 0, 2).reshape(B, H, L, v.shape[-1])
    return o, S


def _gated_delta_branch(proj, S0, conv_buf, chunk, conv_w, A_log, dt_bias, out_norm):
    f32 = jnp.float32
    B, L, _ = proj.shape
    qkv, new_buf = _causal_conv(proj[..., :QKV_W], conv_buf, conv_w)
    qkv = jax.nn.silu(qkv.astype(f32))
    q = _l2norm(qkv[..., :QK_W].reshape(B, L, HA, DK)) * (DK ** -0.5)
    k = _l2norm(qkv[..., QK_W:2 * QK_W].reshape(B, L, HA, DK))
    v = qkv[..., 2 * QK_W:].reshape(B, L, HA, DV)
    beta = jax.nn.sigmoid(proj[..., OFF_BETA:OFF_ALPHA].astype(f32))
    g = -jnp.exp(A_log.astype(f32)) * jax.nn.softplus(
        proj[..., OFF_ALPHA:OFF_LX].astype(f32) + dt_bias.astype(f32))
    pad = (-L) % chunk

    def prep(t):
        t = jnp.moveaxis(t, 2, 1)
        return jnp.pad(t, ((0, 0), (0, 0), (pad, 0)) + ((0, 0),) * (t.ndim - 3))

    o, S = _gated_delta_rule(prep(q), prep(k), prep(v), prep(g), prep(beta), S0.astype(f32), chunk)
    o = jnp.moveaxis(o[:, :, pad:], 1, 2)
    z = proj[..., OFF_Z:OFF_BETA].astype(f32).reshape(B, L, HA, DV)
    o = o * lax.rsqrt(jnp.mean(o * o, axis=-1, keepdims=True) + EPS) * out_norm.astype(f32) * jax.nn.silu(z)
    return o.reshape(B, L, V_W).astype(proj.dtype), S, new_buf


def _linear_scan(a, b, h0):
    b = b.at[:, 0].add(a[:, 0] * h0)

    def comb(x, y):
        return x[0] * y[0], y[0] * x[1] + y[1]

    _, h = lax.associative_scan(comb, (a, b), axis=1)
    return h


def _rglru_branch(proj, h0, conv_buf, conv_w, conv_b, w_r, b_r, w_i, b_i, lam):
    f32 = jnp.float32
    B, L, _ = proj.shape
    xc, new_buf = _causal_conv(proj[..., OFF_LX:OFF_LY], conv_buf, conv_w)
    xc = xc.astype(f32) + conv_b.astype(f32)
    xb = xc.reshape(B, L, NB, BW)
    r = jax.nn.sigmoid(jnp.einsum('blnc,ncd->blnd', xb, w_r.astype(f32)).reshape(B, L, LRU_W) + b_r.astype(f32))
    i = jax.nn.sigmoid(jnp.einsum('blnc,ncd->blnd', xb, w_i.astype(f32)).reshape(B, L, LRU_W) + b_i.astype(f32))
    log_a = -LRU_C * r * jax.nn.softplus(-lam.astype(f32))
    a = jnp.exp(log_a)
    mult = jnp.sqrt(-jnp.expm1(2.0 * log_a))
    h = _linear_scan(a, mult * (i * xc), h0.astype(f32))
    y = h * jax.nn.gelu(proj[..., OFF_LY:OFF_GA].astype(f32))
    return y.astype(proj.dtype), h[:, -1], new_buf


def _trunk(x, S_all, cq_all, h_all, cx_all, chunk, weights):
    (ffn1_norm, ffn1_w_gu, ffn1_w_down, mix_norm, w_in, delta_conv_w, delta_A_log, delta_dt_bias,
     delta_out_norm, lru_conv_w, lru_conv_b, lru_w_r, lru_b_r, lru_w_i, lru_b_i, lru_lambda,
     w_branch_a, w_branch_b, w_out, ffn2_norm, ffn2_w_gu, ffn2_w_down) = weights
    new_S, new_cq, new_h, new_cx = [], [], [], []
    for l in range(DEPTH):
        x = x + 0.5 * _swiglu(_rmsnorm(x, ffn1_norm[l]), ffn1_w_gu[l], ffn1_w_down[l])
        proj = _rmsnorm(x, mix_norm[l]) @ w_in[l]
        o_a, S, cq = _gated_delta_branch(proj, S_all[l], cq_all[l], chunk, delta_conv_w[l],
                                         delta_A_log[l], delta_dt_bias[l], delta_out_norm[l])
        o_b, h, cx = _rglru_branch(proj, h_all[l], cx_all[l], lru_conv_w[l], lru_conv_b[l],
                                   lru_w_r[l], lru_b_r[l], lru_w_i[l], lru_b_i[l], lru_lambda[l])
        gate_a = jax.nn.sigmoid(proj[..., OFF_GA:OFF_GB].astype(jnp.float32))
        gate_b = jax.nn.sigmoid(proj[..., OFF_GB:IN_COLS].astype(jnp.float32))
        merged = gate_a * (o_a @ w_branch_a[l]) + gate_b * (o_b @ w_branch_b[l])
        x = x + merged.astype(x.dtype) @ w_out[l]
        x = x + 0.5 * _swiglu(_rmsnorm(x, ffn2_norm[l]), ffn2_w_gu[l], ffn2_w_down[l])
        new_S.append(S)
        new_cq.append(cq)
        new_h.append(h)
        new_cx.append(cx)
    return (x, jnp.stack(new_S).astype(S_all.dtype), jnp.stack(new_cq).astype(cq_all.dtype),
            jnp.stack(new_h).astype(h_all.dtype), jnp.stack(new_cx).astype(cx_all.dtype))


def setup_inputs(seed: int = 0) -> dict:
    key = jax.random.key(seed)
    ks = iter(jax.random.split(key, 32))
    f32 = jnp.float32
    nrm = lambda shape, scale: jax.random.normal(next(ks), shape, f32) * scale
    gain = lambda shape: 1.0 + nrm(shape, 0.02)
    lam_u = jax.random.uniform(next(ks), (DEPTH, LRU_W), f32, 0.9, 0.999)
    dt = jnp.exp(jax.random.uniform(next(ks), (DEPTH, HA), f32, np.log(1e-3), np.log(1e-1)))
    return {
        "x_prompt": nrm((BATCH, SEQ, D_MODEL), 1.0),
        "x_sample": nrm((DEC_BATCH, DEC_SEQ, D_MODEL), 1.0),
        "state_delta_S": nrm((DEPTH, DEC_BATCH, HA, DK, DV), 0.5),
        "state_delta_conv": nrm((DEPTH, DEC_BATCH, CONV_W - 1, QKV_W), 1.0),
        "state_lru_h": nrm((DEPTH, DEC_BATCH, LRU_W), 0.5),
        "state_lru_conv": nrm((DEPTH, DEC_BATCH, CONV_W - 1, LRU_W), 1.0),
        "meta_tokens": nrm((N_META, D_MODEL), 1.0),
        "ffn1_norm": gain((DEPTH, D_MODEL)),
        "ffn1_w_gu": nrm((DEPTH, D_MODEL, 2 * D_FF), D_MODEL ** -0.5),
        "ffn1_w_down": nrm((DEPTH, D_FF, D_MODEL), D_FF ** -0.5),
        "mix_norm": gain((DEPTH, D_MODEL)),
        "w_in": nrm((DEPTH, D_MODEL, IN_COLS), D_MODEL ** -0.5),
        "delta_conv_w": nrm((DEPTH, CONV_W, QKV_W), CONV_W ** -0.5),
        "delta_A_log": jnp.log(jax.random.uniform(next(ks), (DEPTH, HA), f32, 1.0, 16.0)),
        "delta_dt_bias": dt + jnp.log(-jnp.expm1(-dt)),
        "delta_out_norm": gain((DEPTH, DV)),
        "lru_conv_w": nrm((DEPTH, CONV_W, LRU_W), CONV_W ** -0.5),
        "lru_conv_b": nrm((DEPTH, LRU_W), 0.01),
        "lru_w_r": nrm((DEPTH, NB, BW, BW), BW ** -0.5),
        "lru_b_r": nrm((DEPTH, LRU_W), 0.01),
        "lru_w_i": nrm((DEPTH, NB, BW, BW), BW ** -0.5),
        "lru_b_i": nrm((DEPTH, LRU_W), 0.01),
        "lru_lambda": jnp.log(lam_u) - jnp.log1p(-lam_u),
        "w_branch_a": nrm((DEPTH, V_W, D_MODEL), V_W ** -0.5),
        "w_branch_b": nrm((DEPTH, LRU_W, D_MODEL), LRU_W ** -0.5),
        "w_out": nrm((DEPTH, D_MODEL, D_MODEL), D_MODEL ** -0.5),
        "ffn2_norm": gain((DEPTH, D_MODEL)),
        "ffn2_w_gu": nrm((DEPTH, D_MODEL, 2 * D_FF), D_MODEL ** -0.5),
        "ffn2_w_down": nrm((DEPTH, D_FF, D_MODEL), D_FF ** -0.5),
        "final_norm": gain((D_MODEL,)),
    }


def reference(x_prompt, x_sample, state_delta_S, state_delta_conv, state_lru_h, state_lru_conv,
              meta_tokens, ffn1_norm, ffn1_w_gu, ffn1_w_down, mix_norm, w_in, delta_conv_w,
              delta_A_log, delta_dt_bias, delta_out_norm, lru_conv_w, lru_conv_b, lru_w_r, lru_b_r,
              lru_w_i, lru_b_i, lru_lambda, w_branch_a, w_branch_b, w_out, ffn2_norm, ffn2_w_gu,
              ffn2_w_down, final_norm):
    weights = (ffn1_norm, ffn1_w_gu, ffn1_w_down, mix_norm, w_in, delta_conv_w, delta_A_log,
               delta_dt_bias, delta_out_norm, lru_conv_w, lru_conv_b, lru_w_r, lru_b_r, lru_w_i,
               lru_b_i, lru_lambda, w_branch_a, w_branch_b, w_out, ffn2_norm, ffn2_w_gu, ffn2_w_down)
    dt = x_prompt.dtype
    B = x_prompt.shape[0]
    meta = jnp.broadcast_to(meta_tokens.astype(dt)[None], (B, N_META, D_MODEL))
    xp = jnp.concatenate([meta, x_prompt], axis=1)
    xp, p_S, p_cq, p_h, p_cx = _trunk(
        xp,
        jnp.zeros((DEPTH, B, HA, DK, DV), dt),
        jnp.zeros((DEPTH, B, CONV_W - 1, QKV_W), dt),
        jnp.zeros((DEPTH, B, LRU_W), dt),
        jnp.zeros((DEPTH, B, CONV_W - 1, LRU_W), dt),
        CHUNK, weights)
    y_prompt = _rmsnorm(xp, final_norm)[:, N_META:]
    xs, s_S, s_cq, s_h, s_cx = _trunk(x_sample, state_delta_S, state_delta_conv, state_lru_h,
                                      state_lru_conv, x_sample.shape[1], weights)
    y_sample = _rmsnorm(xs, final_norm)
    return (y_prompt, y_sample, p_S, p_cq, p_h, p_cx, s_S, s_cq, s_h, s_cx)
```

```cpp
#include <hip/hip_runtime.h>
#include <hip/hip_cooperative_groups.h>
#include <cstdio>
namespace cg = cooperative_groups;

typedef unsigned short u16;
typedef short bf16x8 __attribute__((ext_vector_type(8)));
typedef float f32x16 __attribute__((ext_vector_type(16)));
typedef unsigned u32x4 __attribute__((ext_vector_type(4)));
typedef __bf16 bf2_t __attribute__((ext_vector_type(2)));
typedef float f2_t __attribute__((ext_vector_type(2)));
#define DI __device__ __forceinline__
#define MFMA(a, b, c) __builtin_amdgcn_mfma_f32_32x32x16_bf16((a), (b), (c), 0, 0, 0)

constexpr int T_TOK = 17024;
constexpr int DM = 1024, DFF = 2816, PLD = 6272;
constexpr int NMT = 133;
constexpr int PC_Z = 3072, PC_LX = 4096, PC_LY = 5120, PC_BETA = 6144, PC_ALPHA = 6152;
constexpr float EPS = 1e-6f;
constexpr int LDS_BYTES = 69632;
constexpr int NITEM = 2240;

constexpr size_t WB_GU1 = 0, WB_DN1 = 5767168, WB_WIN = 8650752, WB_WG = 15073280, WB_BA = 17170432, WB_BB = 18219008,
                 WB_WO = 19267584, WB_GU2 = 20316160, WB_DN2 = 26083328, WB_WR = 28966912, WB_WI = 29097984;
constexpr size_t X_OFF = 0, XB_OFF = 69730304, SSQ_OFF = 104595456, W_OFF = 105684992, P_OFF = 164143104,
                 QD_OFF = 377692160, WW_OFF = 414392320, KD_OFF = 451092480, UT_OFF = 487792640, A_OFF = 524492800,
                 GL_OFF = 542842880, WS_NEED = 542851840;
constexpr size_t O_YP = 0, O_YS = 16777216, O_PS = 17301504, O_PCQ = 21495808, O_PH = 21790720, O_PCX = 21823488,
                 O_SS = 21921792, O_SCQ = 30310400, O_SH = 30900224, O_SCX = 30965760;

struct Params {
  const float* in[30];
  float* out;
  char* ws;
};

DI unsigned pk2(float a, float b) { f2_t v = {a, b}; bf2_t r = __builtin_convertvector(v, bf2_t); return __builtin_bit_cast(unsigned, r); }
DI u16 f2bf(float x) { __bf16 b = (__bf16)x; return __builtin_bit_cast(u16, b); }
DI float bf2f(u16 v) { return __uint_as_float(((unsigned)v) << 16); }
DI float4 ld_bf4(const u16* p) {
  uint2 v = *(const uint2*)p;
  return make_float4(__uint_as_float(v.x << 16), __uint_as_float(v.x & 0xffff0000u), __uint_as_float(v.y << 16), __uint_as_float(v.y & 0xffff0000u));
}
DI void st_bf4(u16* p, float a, float b, float c, float d) { uint2 v; v.x = pk2(a, b); v.y = pk2(c, d); *(uint2*)p = v; }
DI float sigmoid_(float x) { return 1.f / (1.f + __expf(-x)); }
DI float silu_(float x) { return x / (1.f + __expf(-x)); }
DI float softplus_(float x) { return fmaxf(x, 0.f) + log1pf(__expf(-fabsf(x))); }
DI float gelu_tanh_(float x) { float u = 0.7978845608028654f * (x + 0.044715f * x * x * x); return 0.5f * x * (1.f + tanhf(u)); }
DI int otid() { int t = threadIdx.x; asm volatile("" : "+v"(t)); return t; }
DI int crow(int reg, int h) { return (reg & 3) + 8 * (reg >> 2) + 4 * h; }
DI bf16x8 ldsfrag(const char* base, int off) { return *(const bf16x8*)(base + off); }
DI int sw128(int row, int ch) { return row * 128 + ((ch ^ ((row >> 1) & 7)) << 4); }
DI int sw256(int row, int ch) { return row * 256 + ((ch ^ (row & 15)) << 4); }
template <int S> DI bf16x8 pack8(const f32x16& x) {
  u32x4 u;
  u[0] = pk2(x[8 * S + 0], x[8 * S + 1]); u[1] = pk2(x[8 * S + 2], x[8 * S + 3]);
  u[2] = pk2(x[8 * S + 4], x[8 * S + 5]); u[3] = pk2(x[8 * S + 6], x[8 * S + 7]);
  return __builtin_bit_cast(bf16x8, u);
}
DI void zero16(f32x16& a) {
#pragma unroll
  for (int i = 0; i < 16; ++i) a[i] = 0.f;
}
DI float row_rs(const float* ssq, int row) {
  const float4* q = (const float4*)(ssq + (size_t)row * 16);
  float4 a = q[0], b = q[1], c = q[2], d = q[3];
  float s = (a.x + a.y + a.z + a.w) + (b.x + b.y + b.z + b.w) + (c.x + c.y + c.z + c.w) + (d.x + d.y + d.z + d.w);
  return rsqrtf(s * (1.f / 1024.f) + EPS);
}

DI void gemm_core(const u16* __restrict__ A, int lda, const u16* __restrict__ Bt, int ldb, int K, char* smem, f32x16 (&acc)[2][2]) {
  const int tid = otid(), lane = tid & 63, wid = tid >> 6, wm = wid >> 1, wn = wid & 1;
  const int lr = lane & 31, lh = lane >> 5;
  const int sc = tid & 7, sr = tid >> 3;
  const u16* ag = A + (size_t)sr * lda + sc * 8;
  const u16* bg = Bt + (size_t)sr * ldb + sc * 8;
  u32x4 ra[4], rb[4];
#pragma unroll
  for (int i = 0; i < 2; ++i)
#pragma unroll
    for (int j = 0; j < 2; ++j) zero16(acc[i][j]);
#pragma unroll
  for (int i = 0; i < 4; ++i) { ra[i] = *(const u32x4*)(ag + (size_t)(32 * i) * lda); rb[i] = *(const u32x4*)(bg + (size_t)(32 * i) * ldb); }
  __syncthreads();
#pragma unroll
  for (int i = 0; i < 4; ++i) { *(u32x4*)(smem + sw128(sr + 32 * i, sc)) = ra[i]; *(u32x4*)(smem + 16384 + sw128(sr + 32 * i, sc)) = rb[i]; }
  __syncthreads();
  const int nk = K >> 6;
  for (int kt = 0; kt < nk; ++kt) {
    const char* sa = smem + (kt & 1) * 32768;
    const char* sb = sa + 16384;
    const bool more = (kt + 1 < nk);
    if (more) {
      ag += 64; bg += 64;
#pragma unroll
      for (int i = 0; i < 4; ++i) { ra[i] = *(const u32x4*)(ag + (size_t)(32 * i) * lda); rb[i] = *(const u32x4*)(bg + (size_t)(32 * i) * ldb); }
    }
#pragma unroll
    for (int ks = 0; ks < 4; ++ks) {
      bf16x8 a0 = ldsfrag(sa, sw128(64 * wm + lr, 2 * ks + lh));
      bf16x8 a1 = ldsfrag(sa, sw128(64 * wm + 32 + lr, 2 * ks + lh));
      bf16x8 b0 = ldsfrag(sb, sw128(64 * wn + lr, 2 * ks + lh));
      bf16x8 b1 = ldsfrag(sb, sw128(64 * wn + 32 + lr, 2 * ks + lh));
      acc[0][0] = MFMA(b0, a0, acc[0][0]);
      acc[0][1] = MFMA(b1, a0, acc[0][1]);
      acc[1][0] = MFMA(b0, a1, acc[1][0]);
      acc[1][1] = MFMA(b1, a1, acc[1][1]);
    }
    if (more) {
      char* da = smem + ((kt + 1) & 1) * 32768;
#pragma unroll
      for (int i = 0; i < 4; ++i) { *(u32x4*)(da + sw128(sr + 32 * i, sc)) = ra[i]; *(u32x4*)(da + 16384 + sw128(sr + 32 * i, sc)) = rb[i]; }
    }
    __syncthreads();
  }
}

DI bool tile_of(int it, int NT, int& mt, int& nt) {
  const int G = gridDim.x, b = blockIdx.x;
  const int rb = ((G & 7) == 0) ? ((b & 7) * (G >> 3) + (b >> 3)) : b;
  const int L = it * G + rb;
  if (L >= NMT * NT) return false;
  const int nig = 8 * NT, gid = L / nig, fm = gid * 8, gsz = (NMT - fm) < 8 ? (NMT - fm) : 8, w = L - gid * nig;
  mt = fm + (w % gsz); nt = w / gsz;
  return true;
}
DI int num_rounds(int NT) { return (NMT * NT + gridDim.x - 1) / gridDim.x; }

enum { EPI_GU = 0, EPI_DOWN = 1, EPI_WIN = 2 };

template <int EPI>
DI void gemm_phase(const Params& p, const u16* A, int lda, const u16* Bt, int ldb, int K, int NT, float f, char* smem) {
  float* x = (float*)(p.ws + X_OFF);
  u16* xb = (u16*)(p.ws + XB_OFF);
  float* ssq = (float*)(p.ws + SSQ_OFF);
  u16* P = (u16*)(p.ws + P_OFF);
  const int tid_ = otid(), lane = tid_ & 63, wid = tid_ >> 6, wm = wid >> 1, wn = wid & 1, lr = lane & 31, lh = lane >> 5;
  const int nr = num_rounds(NT);
  for (int it = 0; it < nr; ++it) {
    int mt, nt;
    if (!tile_of(it, NT, mt, nt)) break;
    f32x16 acc[2][2];
    gemm_core(A + (size_t)(mt * 128) * lda, lda, Bt + (size_t)(nt * 128) * ldb, ldb, K, smem, acc);
#pragma unroll
    for (int mi = 0; mi < 2; ++mi) {
      const int row = mt * 128 + 64 * wm + 32 * mi + lr;
      if (EPI == EPI_GU) {
        const float rs = row_rs(ssq, row);
        u16* hrow = P + (size_t)row * DFF + 32 * (2 * nt + wn) + 4 * lh;
#pragma unroll
        for (int b = 0; b < 4; ++b) {
          float hv[4];
#pragma unroll
          for (int r = 0; r < 4; ++r) { float g = acc[mi][0][4 * b + r] * rs, u = acc[mi][1][4 * b + r] * rs; hv[r] = silu_(g) * u; }
          st_bf4(hrow + 8 * b, hv[0], hv[1], hv[2], hv[3]);
        }
      } else if (EPI == EPI_WIN) {
        const float rs = row_rs(ssq, row);
#pragma unroll
        for (int ni = 0; ni < 2; ++ni)
#pragma unroll
          for (int b = 0; b < 4; ++b) {
            const int col = nt * 128 + 64 * wn + 32 * ni + 8 * b + 4 * lh;
            st_bf4(P + (size_t)row * PLD + col, acc[mi][ni][4 * b] * rs, acc[mi][ni][4 * b + 1] * rs, acc[mi][ni][4 * b + 2] * rs, acc[mi][ni][4 * b + 3] * rs);
          }
      } else {
        float ss = 0.f;
#pragma unroll
        for (int ni = 0; ni < 2; ++ni)
#pragma unroll
          for (int b = 0; b < 4; ++b) {
            const int col = nt * 128 + 64 * wn + 32 * ni + 8 * b + 4 * lh;
            float4* xp = (float4*)(x + (size_t)row * DM + col);
            float4 xo = *xp;
            xo.x += f * acc[mi][ni][4 * b]; xo.y += f * acc[mi][ni][4 * b + 1]; xo.z += f * acc[mi][ni][4 * b + 2]; xo.w += f * acc[mi][ni][4 * b + 3];
            *xp = xo;
            st_bf4(xb + (size_t)row * DM + col, xo.x, xo.y, xo.z, xo.w);
            ss += xo.x * xo.x + xo.y * xo.y + xo.z * xo.z + xo.w * xo.w;
          }
        ss += __shfl_xor(ss, 32);
        if (lh == 0) ssq[(size_t)row * 16 + 2 * nt + wn] = ss;
      }
    }
  }
}

DI void merge_phase(const Params& p, char* smem) {
  const u16* xb = (const u16*)(p.ws + XB_OFF);
  const float* ssq = (const float*)(p.ws + SSQ_OFF);
  u16* P = (u16*)(p.ws + P_OFF);
  const u16* W = (const u16*)(p.ws + W_OFF);
  const int tid_ = otid(), lane = tid_ & 63, wid = tid_ >> 6, wm = wid >> 1, wn = wid & 1, lr = lane & 31, lh = lane >> 5;
  const int nr = num_rounds(8);
  for (int it = 0; it < nr; ++it) {
    int mt, nt;
    if (!tile_of(it, 8, mt, nt)) break;
    for (int pass = 0; pass < 2; ++pass) {
      f32x16 acc[2][2];
      unsigned Gp[2][2][8];
      gemm_core(xb + (size_t)(mt * 128) * DM, DM, W + WB_WG + (size_t)(pass * 1024 + nt * 128) * DM, DM, DM, smem, acc);
#pragma unroll
      for (int mi = 0; mi < 2; ++mi) {
        const float rs = row_rs(ssq, mt * 128 + 64 * wm + 32 * mi + lr);
#pragma unroll
        for (int ni = 0; ni < 2; ++ni)
#pragma unroll
          for (int r = 0; r < 8; ++r) Gp[mi][ni][r] = pk2(sigmoid_(acc[mi][ni][2 * r] * rs), sigmoid_(acc[mi][ni][2 * r + 1] * rs));
      }
      gemm_core(P + (size_t)(mt * 128) * PLD + (pass ? PC_LY : PC_Z), PLD, W + (pass ? WB_BB : WB_BA) + (size_t)(nt * 128) * DM, DM, DM, smem, acc);
#pragma unroll
      for (int mi = 0; mi < 2; ++mi) {
        const int row = mt * 128 + 64 * wm + 32 * mi + lr;
#pragma unroll
        for (int ni = 0; ni < 2; ++ni)
#pragma unroll
          for (int b = 0; b < 4; ++b) {
            u16* op = P + (size_t)row * PLD + nt * 128 + 64 * wn + 32 * ni + 8 * b + 4 * lh;
            float4 prev = make_float4(0.f, 0.f, 0.f, 0.f);
            if (pass) prev = ld_bf4(op);
            const unsigned g0 = Gp[mi][ni][2 * b], g1 = Gp[mi][ni][2 * b + 1];
            st_bf4(op, prev.x + __uint_as_float(g0 << 16) * acc[mi][ni][4 * b], prev.y + __uint_as_float(g0 & 0xffff0000u) * acc[mi][ni][4 * b + 1],
                   prev.z + __uint_as_float(g1 << 16) * acc[mi][ni][4 * b + 2], prev.w + __uint_as_float(g1 & 0xffff0000u) * acc[mi][ni][4 * b + 3]);
          }
      }
    }
  }
}

DI void wconv_tile(const Params& p, int l, int t, char* smem) {
  u16* W = (u16*)(p.ws + W_OFF);
  const float* src; const float* fold = nullptr; int ld, K, map = 0; u16* dst; int tn, tk;
  if (t < 7072) {
    int ntk;
    if (t < 1408) { src = p.in[8] + (size_t)l * 1024 * 5632; ld = 5632; K = 1024; fold = p.in[7] + l * 1024; map = 1; dst = W + WB_GU1; }
    else if (t < 2112) { t -= 1408; src = p.in[9] + (size_t)l * 2816 * 1024; ld = 1024; K = 2816; dst = W + WB_DN1; }
    else if (t < 3680) { t -= 2112; src = p.in[11] + (size_t)l * 1024 * 8208; ld = 8208; K = 1024; fold = p.in[10] + l * 1024; map = 2; dst = W + WB_WIN; }
    else if (t < 4192) { t -= 3680; src = p.in[11] + (size_t)l * 1024 * 8208 + 6160; ld = 8208; K = 1024; fold = p.in[10] + l * 1024; dst = W + WB_WG; }
    else if (t < 4448) { t -= 4192; src = p.in[23] + (size_t)l * 1048576; ld = 1024; K = 1024; dst = W + WB_BA; }
    else if (t < 4704) { t -= 4448; src = p.in[24] + (size_t)l * 1048576; ld = 1024; K = 1024; dst = W + WB_BB; }
    else if (t < 4960) { t -= 4704; src = p.in[25] + (size_t)l * 1048576; ld = 1024; K = 1024; dst = W + WB_WO; }
    else if (t < 6368) { t -= 4960; src = p.in[27] + (size_t)l * 1024 * 5632; ld = 5632; K = 1024; fold = p.in[26] + l * 1024; map = 1; dst = W + WB_GU2; }
    else { t -= 6368; src = p.in[28] + (size_t)l * 2816 * 1024; ld = 1024; K = 2816; dst = W + WB_DN2; }
    ntk = K >> 6; tn = t / ntk; tk = t - tn * ntk;
  } else {
    t -= 7072;
    const int mat = t >> 5, n = (t >> 2) & 7;
    src = p.in[mat ? 20 : 18] + (size_t)l * 131072 + n * 16384; ld = 128; K = 128;
    dst = W + (mat ? WB_WI : WB_WR) + n * 16384; tn = (t >> 1) & 1; tk = t & 1;
  }
  u16* tl = (u16*)smem;
  const int tid = otid(), nl = tid & 63, kl = tid >> 6;
  const int np = tn * 64 + nl;
  int sc = np;
  if (map == 1) sc = ((np >> 5) & 1) * 2816 + 32 * (np >> 6) + (np & 31);
  else if (map == 2) sc = np < 4096 ? np : (np < 6144 ? np + 16 : (np < 6152 ? 4096 + (np - 6144) : (np < 6160 ? 4104 + (np - 6152) : -1)));
  __syncthreads();
#pragma unroll
  for (int i = 0; i < 16; ++i) {
    const int k = tk * 64 + kl + 4 * i;
    float v = 0.f;
    if (sc >= 0) { v = src[(size_t)k * ld + sc]; if (fold) v *= fold[k]; }
    tl[nl * 66 + kl + 4 * i] = f2bf(v);
  }
  __syncthreads();
  const int n = tid >> 2, kq = tid & 3;
  const unsigned* rp = (const unsigned*)(tl + n * 66 + 16 * kq);
  uint4 o0, o1;
  o0.x = rp[0]; o0.y = rp[1]; o0.z = rp[2]; o0.w = rp[3]; o1.x = rp[4]; o1.y = rp[5]; o1.z = rp[6]; o1.w = rp[7];
  uint4* dp = (uint4*)(dst + (size_t)(tn * 64 + n) * K + tk * 64 + 16 * kq);
  dp[0] = o0; dp[1] = o1;
}

DI void gather_item(const Params& p, int item, char* smem) {
  float* x = (float*)(p.ws + X_OFF);
  u16* xb = (u16*)(p.ws + XB_OFF);
  float* ssq = (float*)(p.ws + SSQ_OFF);
  float* red = (float*)smem;
  const int tid = otid();
  for (int rr = 0; rr < 8; ++rr) {
    const int row = item * 8 + rr;
    const float* src;
    if (row < 16512) { const int s = row / 2064, pos = row - s * 2064; src = pos < 16 ? p.in[6] + pos * 1024 : p.in[0] + ((size_t)s * 2048 + (pos - 16)) * 1024; }
    else src = p.in[1] + (size_t)(row - 16512) * 1024;
    float4 v = ((const float4*)src)[tid];
    ((float4*)(x + (size_t)row * DM))[tid] = v;
    st_bf4(xb + (size_t)row * DM + 4 * tid, v.x, v.y, v.z, v.w);
    float ss = v.x * v.x + v.y * v.y + v.z * v.z + v.w * v.w;
#pragma unroll
    for (int o = 32; o > 0; o >>= 1) ss += __shfl_xor(ss, o);
    __syncthreads();
    if ((tid & 63) == 0) red[tid >> 6] = ss;
    __syncthreads();
    if (tid < 16) ssq[(size_t)row * 16 + tid] = (tid == 0) ? (red[0] + red[1] + red[2] + red[3]) : 0.f;
  }
}

DI void final_phase(const Params& p) {
  const float* x = (const float*)(p.ws + X_OFF);
  const float* ssq = (const float*)(p.ws + SSQ_OFF);
  const int tid = otid();
  const float4 fw = ((const float4*)p.in[29])[tid];
  for (int row = blockIdx.x; row < T_TOK; row += gridDim.x) {
    float* dst;
    if (row < 16512) { const int s = row / 2064, pos = row - s * 2064; if (pos < 16) continue; dst = p.out + O_YP + ((size_t)s * 2048 + (pos - 16)) * 1024; }
    else dst = p.out + O_YS + (size_t)(row - 16512) * 1024;
    const float rs = row_rs(ssq, row);
    float4 v = ((const float4*)(x + (size_t)row * DM))[tid];
    v.x *= rs * fw.x; v.y *= rs * fw.y; v.z *= rs * fw.z; v.w *= rs * fw.w;
    ((float4*)dst)[tid] = v;
  }
}

struct CI { int r0, nv, sbase, stream, last, sample; };
DI CI chunk_info(int ci) {
  CI c;
  if (ci < 264) {
    const int s = ci / 33, k = ci - s * 33;
    c.stream = s; c.sbase = s * 2064; c.sample = 0;
    if (k == 0) { c.r0 = c.sbase; c.nv = 16; } else { c.r0 = c.sbase + 16 + 64 * (k - 1); c.nv = 64; }
    c.last = (k == 32);
  } else {
    const int s = ci - 264;
    c.stream = 8 + s; c.sbase = 16512 + 32 * s; c.r0 = c.sbase; c.nv = 32; c.last = 1; c.sample = 1;
  }
  return c;
}

DI void dconv_store(const Params& p, int l, const CI& c, int cc, int ch, int half, char* RM, char* RT, float* cqo) {
  const u16* P = (const u16*)(p.ws + P_OFF);
  const float* cwp = p.in[12] + (size_t)l * 4 * 3072 + cc;
  const float w0 = cwp[0], w1 = cwp[3072], w2 = cwp[2 * 3072], w3 = cwp[3 * 3072];
  const int pad = 64 - c.nv;
#pragma unroll 1
  for (int q = 0; q < 4; ++q) {
    const int tq = 32 * half + 8 * q;
    float r[11];
#pragma unroll
    for (int i = 0; i < 11; ++i) {
      const int u = tq - 3 + i;
      float v = 0.f;
      if (u >= pad - 3) {
        const int rowu = c.r0 + u - pad;
        if (rowu >= c.sbase) v = bf2f(P[(size_t)rowu * PLD + cc]);
        else if (c.sample) v = p.in[3][((size_t)(l * 16 + (c.stream - 8)) * 3 + (3 + rowu - c.sbase)) * 3072 + cc];
      }
      r[i] = v;
    }
    float o[8];
#pragma unroll
    for (int i = 0; i < 8; ++i) {
      const float sv = r[i] * w0 + r[i + 1] * w1 + r[i + 2] * w2 + r[i + 3] * w3;
      o[i] = (tq + i >= pad) ? silu_(sv) : 0.f;
    }
    if (RM) {
#pragma unroll
      for (int i = 0; i < 8; ++i) *(u16*)(RM + sw256(tq + i, ch >> 3) + (ch & 7) * 2) = f2bf(o[i]);
    }
    if (RT) {
      u32x4 v; v[0] = pk2(o[0], o[1]); v[1] = pk2(o[2], o[3]); v[2] = pk2(o[4], o[5]); v[3] = pk2(o[6], o[7]);
      *(u32x4*)(RT + sw128(ch, 4 * half + q)) = v;
    }
    if (q == 3 && half && c.last) { cqo[cc] = r[8]; cqo[3072 + cc] = r[9]; cqo[6144 + cc] = r[10]; }
  }
}

DI void delta_pre_item(const Params& p, int l, int it, char* smem) {
  const int ci = it >> 3, h = it & 7;
  const CI c = chunk_info(ci);
  const u16* P = (const u16*)(p.ws + P_OFF);
  char* R0 = smem; char* R1 = smem + 16384; char* R2 = smem + 32768; float* Lm = (float*)(smem + 49152);
  float* sBeta = (float*)(smem + 65536); float* sGc = sBeta + 64; float* sNk = sBeta + 128; float* sNq = sBeta + 192;
  const int tid = otid(), lane = tid & 63, wid = tid >> 6, lr = lane & 31, lh = lane >> 5;
  const int ch = tid & 127, half = tid >> 7, t0 = 32 * half;
  const int pad = 64 - c.nv;
  float* cqo = p.out + (c.sample ? O_SCQ + ((size_t)(l * 16 + (c.stream - 8)) * 3) * 3072 : O_PCQ + ((size_t)(l * 8 + c.stream) * 3) * 3072);
  __syncthreads();
  dconv_store(p, l, c, h * 128 + ch, ch, half, R0, nullptr, cqo);
  dconv_store(p, l, c, 1024 + h * 128 + ch, ch, half, R1, R2, cqo);
  if (tid < 64) {
    float beta = 0.f, g = 0.f;
    if (tid >= pad) {
      const size_t row = (size_t)(c.r0 + tid - pad);
      beta = sigmoid_(bf2f(P[row * PLD + PC_BETA + h]));
      g = -__expf(p.in[13][l * 8 + h]) * softplus_(bf2f(P[row * PLD + PC_ALPHA + h]) + p.in[14][l * 8 + h]);
    }
#pragma unroll
    for (int o = 1; o < 64; o <<= 1) { const float v = __shfl_up(g, o); if (lane >= o) g += v; }
    sBeta[tid] = beta; sGc[tid] = g;
  }
  __syncthreads();
  const int ti = wid >> 1, tj = wid & 1;
  f32x16 aQK, aKK, aQQ;
  zero16(aQK); zero16(aKK); zero16(aQQ);
#pragma unroll
  for (int ks = 0; ks < 8; ++ks) {
    const bf16x8 kf = ldsfrag(R1, sw256(32 * tj + lr, 2 * ks + lh));
    const bf16x8 qf = ldsfrag(R0, sw256(32 * ti + lr, 2 * ks + lh));
    const bf16x8 kif = ldsfrag(R1, sw256(32 * ti + lr, 2 * ks + lh));
    aQK = MFMA(kf, qf, aQK);
    aKK = MFMA(kf, kif, aKK);
    if (ti == tj) aQQ = MFMA(qf, qf, aQQ);
  }
  if (ti == tj && (((lr >> 2) & 1) == lh)) {
    float vk = 0.f, vq = 0.f;
#pragma unroll
    for (int reg = 0; reg < 16; ++reg) if (crow(reg, lh) == lr) { vk = aKK[reg]; vq = aQQ[reg]; }
    sNk[32 * ti + lr] = vk; sNq[32 * ti + lr] = vq;
  }
  __syncthreads();
  const size_t itb = (size_t)it;
  {
    u16* Ag = (u16*)(p.ws + A_OFF) + itb * 4096;
    const int i = 32 * ti + lr;
    const float gi = sGc[i], rqi = rsqrtf(sNq[i] + EPS) * 0.08838834764831845f, bki = sBeta[i] * rsqrtf(sNk[i] + EPS);
#pragma unroll
    for (int b = 0; b < 4; ++b) {
      float av[4], lv[4];
#pragma unroll
      for (int r = 0; r < 4; ++r) {
        const int j = 32 * tj + 8 * b + 4 * lh + r;
        const float rkj = rsqrtf(sNk[j] + EPS);
        const float dec = (j <= i) ? __expf(gi - sGc[j]) : 0.f;
        av[r] = rqi * rkj * aQK[4 * b + r] * dec;
        lv[r] = (j < i) ? bki * rkj * aKK[4 * b + r] * dec : 0.f;
      }
      st_bf4(Ag + i * 64 + 16 * (2 * tj + (b >> 1)) + 8 * lh + 4 * (b & 1), av[0], av[1], av[2], av[3]);
      *(float4*)(Lm + i * 64 + 32 * tj + 8 * b + 4 * lh) = make_float4(lv[0], lv[1], lv[2], lv[3]);
    }
    u16* Qg = (u16*)(p.ws + QD_OFF) + itb * 8192;
    u16* Kg = (u16*)(p.ws + KD_OFF) + itb * 8192;
    const float glc = sGc[63];
#pragma unroll
    for (int ii = 0; ii < 4; ++ii) {
      const int q = tid + 256 * ii;
      {
        const int t = q >> 4, chn = q & 15, s = chn >> 1, hh = chn & 1;
        const float sc = rsqrtf(sNq[t] + EPS) * 0.08838834764831845f * __expf(sGc[t]);
        const int c0 = 16 * s + 4 * hh, c1 = c0 + 8;
        const float4 v0 = ld_bf4((const u16*)(R0 + sw256(t, c0 >> 3) + (c0 & 7) * 2));
        const float4 v1 = ld_bf4((const u16*)(R0 + sw256(t, c1 >> 3) + (c1 & 7) * 2));
        uint4 o; o.x = pk2(v0.x * sc, v0.y * sc); o.y = pk2(v0.z * sc, v0.w * sc); o.z = pk2(v1.x * sc, v1.y * sc); o.w = pk2(v1.z * sc, v1.w * sc);
        *(uint4*)(Qg + t * 128 + 8 * chn) = o;
      }
      {
        const int dk = q >> 3, chn = q & 7, s = chn >> 1, hh = chn & 1;
        const int ta = 16 * s + 4 * hh, tb = ta + 8;
        const float4 v0 = ld_bf4((const u16*)(R2 + sw128(dk, ta >> 3) + (ta & 7) * 2));
        const float4 v1 = ld_bf4((const u16*)(R2 + sw128(dk, tb >> 3) + (tb & 7) * 2));
        float sa[4], sb[4];
#pragma unroll
        for (int r = 0; r < 4; ++r) { sa[r] = rsqrtf(sNk[ta + r] + EPS) * __expf(glc - sGc[ta + r]); sb[r] = rsqrtf(sNk[tb + r] + EPS) * __expf(glc - sGc[tb + r]); }
        uint4 o; o.x = pk2(v0.x * sa[0], v0.y * sa[1]); o.y = pk2(v0.z * sa[2], v0.w * sa[3]); o.z = pk2(v1.x * sb[0], v1.y * sb[1]); o.w = pk2(v1.z * sb[2], v1.w * sb[3]);
        *(uint4*)(Kg + dk * 64 + 8 * chn) = o;
      }
    }
    if (tid == 0) ((float*)(p.ws + GL_OFF))[it] = __expf(glc);
  }
  __syncthreads();
  dconv_store(p, l, c, 2048 + h * 128 + ch, ch, half, nullptr, R0, cqo);
  if (wid == 0) {
    float* Tm = (float*)R1;
#pragma unroll 8
    for (int i = 0; i < 64; ++i) Tm[i * 64 + lane] = 0.f;
    for (int i = 0; i < 64; ++i) {
      float s = (i == lane) ? 1.f : 0.f;
      const float* Li = Lm + i * 64;
      for (int j4 = 0; j4 < i; j4 += 4) {
        const float4 lv = *(const float4*)(Li + j4);
        s -= lv.x * Tm[j4 * 64 + lane]; s -= lv.y * Tm[(j4 + 1) * 64 + lane]; s -= lv.z * Tm[(j4 + 2) * 64 + lane]; s -= lv.w * Tm[(j4 + 3) * 64 + lane];
      }
      Tm[i * 64 + lane] = s;
    }
    const float b1 = sBeta[lane], c1 = b1 * rsqrtf(sNk[lane] + EPS) * __expf(sGc[lane]);
    char* R3 = (char*)Lm;
#pragma unroll 4
    for (int t = 0; t < 64; ++t) {
      const int off = sw128(t, lane >> 3) + (lane & 7) * 2;
      const float tv = Tm[t * 64 + lane];
      *(u16*)(R3 + off) = f2bf(tv * c1);
      *(u16*)(R3 + 8192 + off) = f2bf(tv * b1);
    }
  }
  __syncthreads();
  {
    u16* Wg = (u16*)(p.ws + WW_OFF) + itb * 8192;
    u16* Ug = (u16*)(p.ws + UT_OFF) + itb * 8192;
    f32x16 aw[2], au[2];
    zero16(aw[0]); zero16(aw[1]); zero16(au[0]); zero16(au[1]);
#pragma unroll
    for (int ks = 0; ks < 4; ++ks) {
      const bf16x8 kT = ldsfrag(R2, sw128(32 * wid + lr, 2 * ks + lh));
      const bf16x8 vT = ldsfrag(R0, sw128(32 * wid + lr, 2 * ks + lh));
#pragma unroll
      for (int bb = 0; bb < 2; ++bb) {
        const bf16x8 t1 = ldsfrag((const char*)Lm, sw128(32 * bb + lr, 2 * ks + lh));
        const bf16x8 t2 = ldsfrag((const char*)Lm + 8192, sw128(32 * bb + lr, 2 * ks + lh));
        aw[bb] = MFMA(kT, t1, aw[bb]);
        au[bb] = MFMA(t2, vT, au[bb]);
      }
    }
#pragma unroll
    for (int bb = 0; bb < 2; ++bb)
#pragma unroll
      for (int b = 0; b < 4; ++b) {
        st_bf4(Wg + (32 * bb + lr) * 128 + 32 * wid + 16 * (b >> 1) + 8 * lh + 4 * (b & 1), aw[bb][4 * b], aw[bb][4 * b + 1], aw[bb][4 * b + 2], aw[bb][4 * b + 3]);
        st_bf4(Ug + (32 * wid + lr) * 64 + 32 * bb + 8 * b + 4 * lh, au[bb][4 * b], au[bb][4 * b + 1], au[bb][4 * b + 2], au[bb][4 * b + 3]);
      }
  }
}

DI void delta_seq_item(const Params& p, int l, int item, char* smem) {
  const int stream = item >> 3, h = item & 7;
  const int tid = otid(), lane = tid & 63, wid = tid >> 6, lr = lane & 31, lh = lane >> 5;
  const int dv = 32 * wid + lr;
  u16* P = (u16*)(p.ws + P_OFF);
  f32x16 S[4];
  float* Sout;
  int nchunk, ci0;
  if (stream < 8) {
#pragma unroll
    for (int m = 0; m < 4; ++m) zero16(S[m]);
    Sout = p.out + O_PS + ((size_t)(l * 8 + stream) * 8 + h) * 16384;
    nchunk = 33; ci0 = stream * 33;
  } else {
    const float* S0 = p.in[2] + ((size_t)(l * 16 + (stream - 8)) * 8 + h) * 16384;
    const float* sp = S0 + (4 * lh) * 128 + dv;
#pragma unroll
    for (int m = 0; m < 4; ++m)
#pragma unroll
      for (int b = 0; b < 4; ++b) {
#pragma unroll
        for (int r = 0; r < 4; ++r) S[m][4 * b + r] = sp[r * 128];
        sp += 8 * 128;
        __builtin_amdgcn_sched_barrier(0);
      }
    Sout = p.out + O_SS + ((size_t)(l * 16 + (stream - 8)) * 8 + h) * 16384;
    nchunk = 1; ci0 = 264 + (stream - 8);
  }
  for (int k = 0; k < nchunk; ++k) {
    const int ci = ci0 + k;
    const CI c = chunk_info(ci);
    const size_t it = (size_t)ci * 8 + h;
    const u16* Wg = (const u16*)(p.ws + WW_OFF) + it * 8192;
    const u16* Qg = (const u16*)(p.ws + QD_OFF) + it * 8192;
    const u16* Kg = (const u16*)(p.ws + KD_OFF) + it * 8192;
    const u16* Ag = (const u16*)(p.ws + A_OFF) + it * 4096;
    const u16* Ug = (const u16*)(p.ws + UT_OFF) + it * 8192;
    const float gl = ((const float*)(p.ws + GL_OFF))[it];
    __syncthreads();
#pragma unroll
    for (int ii = 0; ii < 4; ++ii) {
      const int q = tid + 256 * ii;
      *(uint4*)(smem + sw256(q >> 4, q & 15)) = *(const uint4*)(Wg + q * 8);
      *(uint4*)(smem + 16384 + sw256(q >> 4, q & 15)) = *(const uint4*)(Qg + q * 8);
      *(uint4*)(smem + 32768 + sw128(q >> 3, q & 7)) = *(const uint4*)(Kg + q * 8);
    }
#pragma unroll
    for (int ii = 0; ii < 2; ++ii) {
      const int q = tid + 256 * ii;
      *(uint4*)(smem + 49152 + sw128(q >> 3, q & 7)) = *(const uint4*)(Ag + q * 8);
    }
    float4 uv[2][4];
#pragma unroll
    for (int m = 0; m < 2; ++m)
#pragma unroll
      for (int b = 0; b < 4; ++b) uv[m][b] = ld_bf4(Ug + dv * 64 + 32 * m + 8 * b + 4 * lh);
    __syncthreads();
    f32x16 M1[2], M2[2];
    zero16(M1[0]); zero16(M1[1]); zero16(M2[0]); zero16(M2[1]);
#pragma unroll
    for (int mt = 0; mt < 4; ++mt) {
#pragma unroll
      for (int s = 0; s < 2; ++s) {
        const int ks = 2 * mt + s;
        const bf16x8 Sp = s ? pack8<1>(S[mt]) : pack8<0>(S[mt]);
#pragma unroll
        for (int m = 0; m < 2; ++m) {
          const bf16x8 wf = ldsfrag(smem, sw256(32 * m + lr, 2 * ks + lh));
          const bf16x8 qf = ldsfrag(smem + 16384, sw256(32 * m + lr, 2 * ks + lh));
          M1[m] = MFMA(wf, Sp, M1[m]);
          M2[m] = MFMA(qf, Sp, M2[m]);
        }
      }
    }
#pragma unroll
    for (int m = 0; m < 2; ++m)
#pragma unroll
      for (int b = 0; b < 4; ++b) {
        M1[m][4 * b] = uv[m][b].x - M1[m][4 * b]; M1[m][4 * b + 1] = uv[m][b].y - M1[m][4 * b + 1];
        M1[m][4 * b + 2] = uv[m][b].z - M1[m][4 * b + 2]; M1[m][4 * b + 3] = uv[m][b].w - M1[m][4 * b + 3];
      }
    bf16x8 Vp[4];
    Vp[0] = pack8<0>(M1[0]); Vp[1] = pack8<1>(M1[0]); Vp[2] = pack8<0>(M1[1]); Vp[3] = pack8<1>(M1[1]);
#pragma unroll
    for (int m = 0; m < 2; ++m)
#pragma unroll
      for (int kk = 0; kk < 4; ++kk) {
        const bf16x8 af = ldsfrag(smem + 49152, sw128(32 * m + lr, 2 * kk + lh));
        M2[m] = MFMA(af, Vp[kk], M2[m]);
      }
#pragma unroll
    for (int mt = 0; mt < 4; ++mt) {
#pragma unroll
      for (int r = 0; r < 16; ++r) S[mt][r] *= gl;
#pragma unroll
      for (int kk = 0; kk < 4; ++kk) {
        const bf16x8 kf = ldsfrag(smem + 32768, sw128(32 * mt + lr, 2 * kk + lh));
        S[mt] = MFMA(kf, Vp[kk], S[mt]);
      }
    }
    __syncthreads();
    float* ot = (float*)smem;
#pragma unroll
    for (int m = 0; m < 2; ++m)
#pragma unroll
      for (int r = 0; r < 16; ++r) ot[(32 * m + crow(r, lh)) * 128 + dv] = M2[m][r];
    __syncthreads();
    {
      const int t = tid >> 2, q = tid & 3, pad = 64 - c.nv;
      float4 v[8];
      float ss = 0.f;
#pragma unroll
      for (int i = 0; i < 8; ++i) { v[i] = *(const float4*)(ot + t * 128 + 32 * q + 4 * i); ss += v[i].x * v[i].x + v[i].y * v[i].y + v[i].z * v[i].z + v[i].w * v[i].w; }
      ss += __shfl_xor(ss, 1); ss += __shfl_xor(ss, 2);
      const float rs = rsqrtf(ss * (1.f / 128.f) + EPS);
      if (t >= pad) {
        u16* zp = P + (size_t)(c.r0 + t - pad) * PLD + PC_Z + h * 128 + 32 * q;
        const float* nw = p.in[15] + l * 128 + 32 * q;
#pragma unroll
        for (int i = 0; i < 8; ++i) {
          const float4 z = ld_bf4(zp + 4 * i);
          const float4 w4 = *(const float4*)(nw + 4 * i);
          st_bf4(zp + 4 * i, v[i].x * rs * w4.x * silu_(z.x), v[i].y * rs * w4.y * silu_(z.y), v[i].z * rs * w4.z * silu_(z.z), v[i].w * rs * w4.w * silu_(z.w));
        }
      }
    }
  }
  float* so = Sout + (4 * lh) * 128 + dv;
#pragma unroll
  for (int m = 0; m < 4; ++m)
#pragma unroll
    for (int b = 0; b < 4; ++b) {
#pragma unroll
      for (int r = 0; r < 4; ++r) so[r * 128] = S[m][4 * b + r];
      so += 8 * 128;
      __builtin_amdgcn_sched_barrier(0);
    }
}

DI void lru_seq_item(const Params& p, int l, int item, char* smem) {
  const int stream = item >> 3, n = item & 7;
  const int tid = otid(), lane = tid & 63, wid = tid >> 6, lr = lane & 31, lh = lane >> 5;
  u16* P = (u16*)(p.ws + P_OFF);
  const u16* W = (const u16*)(p.ws + W_OFF);
  float* raw = (float*)smem; float* xc = (float*)(smem + 18432); char* xcb = smem + 34816;
  const int ch = tid & 127, rp = tid >> 7;
  const int gc = n * 128 + ch;
  const float* cwp = p.in[16] + (size_t)l * 4 * 1024 + gc;
  const float cw0 = cwp[0], cw1 = cwp[1024], cw2 = cwp[2048], cw3 = cwp[3072], cb = p.in[17][l * 1024 + gc];
  const int d = 32 * wid + lr, gd = n * 128 + d;
  bf16x8 wrf[8], wif[8];
#pragma unroll
  for (int ks = 0; ks < 8; ++ks) {
    wrf[ks] = *(const bf16x8*)(W + WB_WR + n * 16384 + d * 128 + (2 * ks + lh) * 8);
    wif[ks] = *(const bf16x8*)(W + WB_WI + n * 16384 + d * 128 + (2 * ks + lh) * 8);
  }
  const float br = p.in[19][l * 1024 + gd], bi = p.in[21][l * 1024 + gd];
  const float c8 = -8.f * softplus_(-p.in[22][l * 1024 + gd]);
  float hc; int sbase, nsteps;
  float *oh, *ocx;
  __syncthreads();
  if (stream < 8) {
    hc = 0.f; sbase = stream * 2064; nsteps = 65;
    if (tid < 128) { raw[tid] = 0.f; raw[128 + tid] = 0.f; raw[256 + tid] = 0.f; }
    oh = p.out + O_PH + (size_t)(l * 8 + stream) * 1024; ocx = p.out + O_PCX + (size_t)(l * 8 + stream) * 3 * 1024;
  } else {
    const int s = stream - 8;
    hc = p.in[4][(size_t)(l * 16 + s) * 1024 + gd]; sbase = 16512 + 32 * s; nsteps = 1;
    if (tid < 128) {
      const float* cs = p.in[5] + (size_t)(l * 16 + s) * 3 * 1024 + gc;
      raw[tid] = cs[0]; raw[128 + tid] = cs[1024]; raw[256 + tid] = cs[2048];
    }
    oh = p.out + O_SH + (size_t)(l * 16 + s) * 1024; ocx = p.out + O_SCX + (size_t)(l * 16 + s) * 3 * 1024;
  }
  for (int st = 0; st < nsteps; ++st) {
    int r0, nv;
    if (stream < 8) { if (st == 0) { r0 = sbase; nv = 16; } else { r0 = sbase + 16 + 32 * (st - 1); nv = 32; } }
    else { r0 = sbase; nv = 32; }
    for (int t = rp; t < nv; t += 2) raw[(3 + t) * 128 + ch] = bf2f(P[(size_t)(r0 + t) * PLD + PC_LX + gc]);
    __syncthreads();
    for (int t = rp; t < 32; t += 2) {
      float v = 0.f;
      if (t < nv) v = cb + raw[t * 128 + ch] * cw0 + raw[(t + 1) * 128 + ch] * cw1 + raw[(t + 2) * 128 + ch] * cw2 + raw[(t + 3) * 128 + ch] * cw3;
      xc[t * 128 + ch] = v;
      *(u16*)(xcb + sw256(t, ch >> 3) + (ch & 7) * 2) = f2bf(v);
    }
    __syncthreads();
    if (tid < 128) {
      const float h0 = raw[nv * 128 + tid], h1 = raw[(nv + 1) * 128 + tid], h2 = raw[(nv + 2) * 128 + tid];
      raw[tid] = h0; raw[128 + tid] = h1; raw[256 + tid] = h2;
    }
    f32x16 aR, aI;
    zero16(aR); zero16(aI);
#pragma unroll
    for (int ks = 0; ks < 8; ++ks) {
      const bf16x8 af = ldsfrag(xcb, sw256(lr, 2 * ks + lh));
      aR = MFMA(af, wrf[ks], aR);
      aI = MFMA(af, wif[ks], aI);
    }
    float av[16], bv[16], hv[16];
#pragma unroll
    for (int r = 0; r < 16; ++r) {
      const int t = crow(r, lh);
      const float rr = sigmoid_(aR[r] + br), ig = sigmoid_(aI[r] + bi);
      const float la = c8 * rr;
      const float a = __expf(la), mult = sqrtf(fmaxf(-expm1f(2.f * la), 0.f));
      const float xv = xc[t * 128 + d];
      av[r] = (t < nv) ? a : 1.f;
      bv[r] = (t < nv) ? mult * ig * xv : 0.f;
    }
#pragma unroll
    for (int b = 0; b < 4; ++b) {
      float cA = hc, tA[4], tB[4];
#pragma unroll
      for (int r = 0; r < 4; ++r) { cA = av[4 * b + r] * cA + bv[4 * b + r]; tA[r] = cA; }
      hc = __shfl(cA, lr);
      float cB = hc;
#pragma unroll
      for (int r = 0; r < 4; ++r) { cB = av[4 * b + r] * cB + bv[4 * b + r]; tB[r] = cB; }
      hc = __shfl(cB, lr + 32);
#pragma unroll
      for (int r = 0; r < 4; ++r) hv[4 * b + r] = lh ? tB[r] : tA[r];
    }
#pragma unroll
    for (int r = 0; r < 16; ++r) {
      const int t = crow(r, lh);
      if (t < nv) {
        u16* yp = P + (size_t)(r0 + t) * PLD + PC_LY + gd;
        *yp = f2bf(hv[r] * gelu_tanh_(bf2f(*yp)));
      }
    }
    __syncthreads();
  }
  if (lh == 0) oh[gd] = hc;
  if (tid < 128) { ocx[gc] = raw[tid]; ocx[1024 + gc] = raw[128 + tid]; ocx[2048 + gc] = raw[256 + tid]; }
}

__global__ void __launch_bounds__(256, 2) mega(Params p, int lo, int hi) {
  extern __shared__ __attribute__((aligned(16))) char smem[];
  const u16* xb = (const u16*)(p.ws + XB_OFF);
  const u16* P = (const u16*)(p.ws + P_OFF);
  const u16* W = (const u16*)(p.ws + W_OFF);
  int ph = 0;
#define PH(body) { if (ph >= lo && ph < hi) { if (ph > lo) cg::this_grid().sync(); body } ++ph; }
#pragma unroll 1
  for (int l = 0; l < 4; ++l) {
    PH({
      const int nw = 7136 + (l == 0 ? 2128 : 0);
      for (int w = blockIdx.x; w < nw; w += gridDim.x) { if (w < 7136) wconv_tile(p, l, w, smem); else gather_item(p, w - 7136, smem); }
    })
    PH(gemm_phase<EPI_GU>(p, xb, DM, W + WB_GU1, DM, DM, 44, 0.f, smem);)
    PH(gemm_phase<EPI_DOWN>(p, P, DFF, W + WB_DN1, DFF, DFF, 8, 0.5f, smem);)
    PH(gemm_phase<EPI_WIN>(p, xb, DM, W + WB_WIN, DM, DM, 49, 0.f, smem);)
    PH(for (int w = blockIdx.x; w < NITEM; w += gridDim.x) delta_pre_item(p, l, w, smem);)
    PH({
      for (int w = blockIdx.x; w < 384; w += gridDim.x) {
        if (w < 64) delta_seq_item(p, l, w, smem);
        else if (w < 128) lru_seq_item(p, l, w - 64, smem);
        else if (w < 256) delta_seq_item(p, l, 64 + (w - 128), smem);
        else lru_seq_item(p, l, 64 + (w - 256), smem);
      }
    })
    PH(merge_phase(p, smem);)
    PH(gemm_phase<EPI_DOWN>(p, P, PLD, W + WB_WO, DM, DM, 8, 1.f, smem);)
    PH(gemm_phase<EPI_GU>(p, xb, DM, W + WB_GU2, DM, DM, 44, 0.f, smem);)
    PH(gemm_phase<EPI_DOWN>(p, P, DFF, W + WB_DN2, DFF, DFF, 8, 0.5f, smem);)
  }
  PH(final_phase(p);)
}

extern "C" void kernel_launch(void* const* d_in, const int* in_sizes, int n_in, void* d_out, int out_size, void* d_ws, size_t ws_size,
                              hipStream_t stream) {
  if (ws_size < WS_NEED || n_in < 30) { fprintf(stderr, "workspace too small: %zu < %zu\n", ws_size, (size_t)WS_NEED); return; }
  static int grid_blocks = 0;
  if (!grid_blocks) {
    hipFuncSetAttribute((const void*)mega, hipFuncAttributeMaxDynamicSharedMemorySize, LDS_BYTES);
    int dev = 0, cus = 0, per_cu = 0;
    hipGetDevice(&dev);
    hipDeviceGetAttribute(&cus, hipDeviceAttributeMultiprocessorCount, dev);
    hipOccupancyMaxActiveBlocksPerMultiprocessor(&per_cu, mega, 256, LDS_BYTES);
    if (per_cu > 2) per_cu = 2;
    grid_blocks = cus * per_cu;
  }
  Params p{};
  for (int i = 0; i < 30; ++i) p.in[i] = (const float*)d_in[i];
  p.out = (float*)d_out;
  p.ws = (char*)d_ws;
#ifdef MK_MULTI
  for (int ph = 0; ph < 41; ++ph) {
    int lo = ph, hi = ph + 1;
    hipLaunchKernelGGL(mega, dim3(grid_blocks), dim3(256), LDS_BYTES, stream, p, lo, hi);
  }
#else
  int lo = 0, hi = 41;
  void* args[] = {&p, &lo, &hi};
  hipError_t e = hipLaunchCooperativeKernel((void*)mega, dim3(grid_blocks), dim3(256), args, LDS_BYTES, stream);
  if (e != hipSuccess) fprintf(stderr, "cooperative launch failed: %s (grid %d)\n", hipGetErrorString(e), grid_blocks);
#endif
}
```

```cpp
#include <hip/hip_runtime.h>
#include <hip/hip_cooperative_groups.h>
#include <cstdio>
namespace cg = cooperative_groups;

typedef unsigned short u16;
typedef short bf16x8 __attribute__((ext_vector_type(8)));
typedef float f32x16 __attribute__((ext_vector_type(16)));
typedef unsigned u32x4 __attribute__((ext_vector_type(4)));
typedef __bf16 bf2_t __attribute__((ext_vector_type(2)));
typedef float f2_t __attribute__((ext_vector_type(2)));
#define DI __device__ __forceinline__
#define MFMA(a, b, c) __builtin_amdgcn_mfma_f32_32x32x16_bf16((a), (b), (c), 0, 0, 0)

constexpr int T_TOK = 17024;
constexpr int DM = 1024, DFF = 2816, PLD = 6272;
constexpr int NMT = 133;
constexpr int PC_Z = 3072, PC_LX = 4096, PC_LY = 5120, PC_BETA = 6144, PC_ALPHA = 6152;
constexpr int PC_OA = 0, PC_Y = 1024, PC_MRG = 2048;
constexpr int NLT = 536;
constexpr float EPS = 1e-6f;
constexpr int LDS_BYTES = 69648;
constexpr int NITEM = 2240;

constexpr size_t WB_GU1 = 0, WB_DN1 = 5767168, WB_WIN = 8650752, WB_WG = 15073280, WB_BA = 17170432, WB_BB = 18219008,
                 WB_WO = 19267584, WB_GU2 = 20316160, WB_DN2 = 26083328, WB_WR = 28966912, WB_WI = 29097984;
constexpr size_t X_OFF = 0, XB_OFF = 69730304, SSQ_OFF = 104595456, W_OFF = 105684992, P_OFF = 164143104,
                 QD_OFF = 377692160, WW_OFF = 414392320, KD_OFF = 451092480, UT_OFF = 487792640, A_OFF = 524492800,
                 GL_OFF = 542842880, BAR_OFF = 542851840, AG_OFF = 542868224, WS_NEED = 542868224 + 4390912;
constexpr size_t O_YP = 0, O_YS = 16777216, O_PS = 17301504, O_PCQ = 21495808, O_PH = 21790720, O_PCX = 21823488,
                 O_SS = 21921792, O_SCQ = 30310400, O_SH = 30900224, O_SCX = 30965760;

struct Params {
  const float* in[30];
  float* out;
  char* ws;
};

DI unsigned pk2(float a, float b) { f2_t v = {a, b}; bf2_t r = __builtin_convertvector(v, bf2_t); return __builtin_bit_cast(unsigned, r); }
DI u16 f2bf(float x) { __bf16 b = (__bf16)x; return __builtin_bit_cast(u16, b); }
DI float bf2f(u16 v) { return __uint_as_float(((unsigned)v) << 16); }
DI float4 ld_bf4(const u16* p) {
  uint2 v = *(const uint2*)p;
  return make_float4(__uint_as_float(v.x << 16), __uint_as_float(v.x & 0xffff0000u), __uint_as_float(v.y << 16), __uint_as_float(v.y & 0xffff0000u));
}
DI void st_bf4(u16* p, float a, float b, float c, float d) { uint2 v; v.x = pk2(a, b); v.y = pk2(c, d); *(uint2*)p = v; }
DI float sigmoid_(float x) { return 1.f / (1.f + __expf(-x)); }
DI float silu_(float x) { return x / (1.f + __expf(-x)); }
DI float softplus_(float x) { return fmaxf(x, 0.f) + log1pf(__expf(-fabsf(x))); }
DI float gelu_tanh_(float x) { float u = 0.7978845608028654f * (x + 0.044715f * x * x * x); return 0.5f * x * (1.f + tanhf(u)); }
DI int otid() { int t = threadIdx.x; asm volatile("" : "+v"(t)); return t; }
DI int crow(int reg, int h) { return (reg & 3) + 8 * (reg >> 2) + 4 * h; }
DI bf16x8 ldsfrag(const char* base, int off) { return *(const bf16x8*)(base + off); }
DI int sw128(int row, int ch) { return row * 128 + ((ch ^ ((row >> 1) & 7)) << 4); }
DI int sw256(int row, int ch) { return row * 256 + ((ch ^ (row & 15)) << 4); }
template <int S> DI bf16x8 pack8(const f32x16& x) {
  u32x4 u;
  u[0] = pk2(x[8 * S + 0], x[8 * S + 1]); u[1] = pk2(x[8 * S + 2], x[8 * S + 3]);
  u[2] = pk2(x[8 * S + 4], x[8 * S + 5]); u[3] = pk2(x[8 * S + 6], x[8 * S + 7]);
  return __builtin_bit_cast(bf16x8, u);
}
DI void zero16(f32x16& a) {
#pragma unroll
  for (int i = 0; i < 16; ++i) a[i] = 0.f;
}
DI float row_rs(const float* ssq, int row) {
  const float4* q = (const float4*)(ssq + (size_t)row * 16);
  float4 a = q[0], b = q[1], c = q[2], d = q[3];
  float s = (a.x + a.y + a.z + a.w) + (b.x + b.y + b.z + b.w) + (c.x + c.y + c.z + c.w) + (d.x + d.y + d.z + d.w);
  return rsqrtf(s * (1.f / 1024.f) + EPS);
}

DI void gemm_core(const u16* __restrict__ A, int lda, const u16* __restrict__ Bt, int ldb, int K, char* smem, f32x16 (&acc)[2][2]) {
  const int tid = otid(), lane = tid & 63, wid = tid >> 6, wm = wid >> 1, wn = wid & 1;
  const int lr = lane & 31, lh = lane >> 5;
  const int sc = tid & 7, sr = tid >> 3;
  const u16* ag = A + (size_t)sr * lda + sc * 8;
  const u16* bg = Bt + (size_t)sr * ldb + sc * 8;
  u32x4 ra[4], rb[4];
#pragma unroll
  for (int i = 0; i < 2; ++i)
#pragma unroll
    for (int j = 0; j < 2; ++j) zero16(acc[i][j]);
#pragma unroll
  for (int i = 0; i < 4; ++i) { ra[i] = *(const u32x4*)(ag + (size_t)(32 * i) * lda); rb[i] = *(const u32x4*)(bg + (size_t)(32 * i) * ldb); }
  __syncthreads();
#pragma unroll
  for (int i = 0; i < 4; ++i) { *(u32x4*)(smem + sw128(sr + 32 * i, sc)) = ra[i]; *(u32x4*)(smem + 16384 + sw128(sr + 32 * i, sc)) = rb[i]; }
  __syncthreads();
  const int nk = K >> 6;
  for (int kt = 0; kt < nk; ++kt) {
    const char* sa = smem + (kt & 1) * 32768;
    const char* sb = sa + 16384;
    const bool more = (kt + 1 < nk);
    if (more) {
      ag += 64; bg += 64;
#pragma unroll
      for (int i = 0; i < 4; ++i) { ra[i] = *(const u32x4*)(ag + (size_t)(32 * i) * lda); rb[i] = *(const u32x4*)(bg + (size_t)(32 * i) * ldb); }
    }
#pragma unroll
    for (int ks = 0; ks < 4; ++ks) {
      bf16x8 a0 = ldsfrag(sa, sw128(64 * wm + lr, 2 * ks + lh));
      bf16x8 a1 = ldsfrag(sa, sw128(64 * wm + 32 + lr, 2 * ks + lh));
      bf16x8 b0 = ldsfrag(sb, sw128(64 * wn + lr, 2 * ks + lh));
      bf16x8 b1 = ldsfrag(sb, sw128(64 * wn + 32 + lr, 2 * ks + lh));
      acc[0][0] = MFMA(b0, a0, acc[0][0]);
      acc[0][1] = MFMA(b1, a0, acc[0][1]);
      acc[1][0] = MFMA(b0, a1, acc[1][0]);
      acc[1][1] = MFMA(b1, a1, acc[1][1]);
    }
    if (more) {
      char* da = smem + ((kt + 1) & 1) * 32768;
#pragma unroll
      for (int i = 0; i < 4; ++i) { *(u32x4*)(da + sw128(sr + 32 * i, sc)) = ra[i]; *(u32x4*)(da + 16384 + sw128(sr + 32 * i, sc)) = rb[i]; }
    }
    __syncthreads();
  }
}

DI bool tile_of(int it, int NT, int& mt, int& nt) {
  const int G = gridDim.x, b = blockIdx.x;
  const int rb = ((G & 7) == 0) ? ((b & 7) * (G >> 3) + (b >> 3)) : b;
  const int L = it * G + rb;
  if (L >= NMT * NT) return false;
  const int nig = 8 * NT, gid = L / nig, fm = gid * 8, gsz = (NMT - fm) < 8 ? (NMT - fm) : 8, w = L - gid * nig;
  mt = fm + (w % gsz); nt = w / gsz;
  return true;
}
DI int num_rounds(int NT) { return (NMT * NT + gridDim.x - 1) / gridDim.x; }

enum { EPI_GU = 0, EPI_DOWN = 1, EPI_WIN = 2 };

template <int EPI>
DI void gemm_phase(const Params& p, const u16* A, int lda, const u16* Bt, int ldb, int K, int NT, float f, char* smem) {
  float* x = (float*)(p.ws + X_OFF);
  u16* xb = (u16*)(p.ws + XB_OFF);
  float* ssq = (float*)(p.ws + SSQ_OFF);
  u16* P = (u16*)(p.ws + P_OFF);
  const int tid_ = otid(), lane = tid_ & 63, wid = tid_ >> 6, wm = wid >> 1, wn = wid & 1, lr = lane & 31, lh = lane >> 5;
  const int nr = num_rounds(NT);
  for (int it = 0; it < nr; ++it) {
    int mt, nt;
    if (!tile_of(it, NT, mt, nt)) break;
    f32x16 acc[2][2];
    gemm_core(A + (size_t)(mt * 128) * lda, lda, Bt + (size_t)(nt * 128) * ldb, ldb, K, smem, acc);
#pragma unroll
    for (int mi = 0; mi < 2; ++mi) {
      const int row = mt * 128 + 64 * wm + 32 * mi + lr;
      if (EPI == EPI_GU) {
        const float rs = row_rs(ssq, row);
        u16* hrow = P + (size_t)row * DFF + 32 * (2 * nt + wn) + 4 * lh;
#pragma unroll
        for (int b = 0; b < 4; ++b) {
          float hv[4];
#pragma unroll
          for (int r = 0; r < 4; ++r) { float g = acc[mi][0][4 * b + r] * rs, u = acc[mi][1][4 * b + r] * rs; hv[r] = silu_(g) * u; }
          st_bf4(hrow + 8 * b, hv[0], hv[1], hv[2], hv[3]);
        }
      } else if (EPI == EPI_WIN) {
        const float rs = row_rs(ssq, row);
#pragma unroll
        for (int ni = 0; ni < 2; ++ni)
#pragma unroll
          for (int b = 0; b < 4; ++b) {
            const int col = nt * 128 + 64 * wn + 32 * ni + 8 * b + 4 * lh;
            st_bf4(P + (size_t)row * PLD + col, acc[mi][ni][4 * b] * rs, acc[mi][ni][4 * b + 1] * rs, acc[mi][ni][4 * b + 2] * rs, acc[mi][ni][4 * b + 3] * rs);
          }
      } else {
        float ss = 0.f;
#pragma unroll
        for (int ni = 0; ni < 2; ++ni)
#pragma unroll
          for (int b = 0; b < 4; ++b) {
            const int col = nt * 128 + 64 * wn + 32 * ni + 8 * b + 4 * lh;
            float4* xp = (float4*)(x + (size_t)row * DM + col);
            float4 xo = *xp;
            xo.x += f * acc[mi][ni][4 * b]; xo.y += f * acc[mi][ni][4 * b + 1]; xo.z += f * acc[mi][ni][4 * b + 2]; xo.w += f * acc[mi][ni][4 * b + 3];
            *xp = xo;
            st_bf4(xb + (size_t)row * DM + col, xo.x, xo.y, xo.z, xo.w);
            ss += xo.x * xo.x + xo.y * xo.y + xo.z * xo.z + xo.w * xo.w;
          }
        ss += __shfl_xor(ss, 32);
        if (lh == 0) ssq[(size_t)row * 16 + 2 * nt + wn] = ss;
      }
    }
  }
}

DI void merge_phase(const Params& p, char* smem) {
  const u16* xb = (const u16*)(p.ws + XB_OFF);
  const float* ssq = (const float*)(p.ws + SSQ_OFF);
  u16* P = (u16*)(p.ws + P_OFF);
  const u16* W = (const u16*)(p.ws + W_OFF);
  const int tid_ = otid(), lane = tid_ & 63, wid = tid_ >> 6, wm = wid >> 1, wn = wid & 1, lr = lane & 31, lh = lane >> 5;
  const int nr = num_rounds(8);
  for (int it = 0; it < nr; ++it) {
    int mt, nt;
    if (!tile_of(it, 8, mt, nt)) break;
    for (int pass = 0; pass < 2; ++pass) {
      f32x16 acc[2][2];
      unsigned Gp[2][2][8];
      gemm_core(xb + (size_t)(mt * 128) * DM, DM, W + WB_WG + (size_t)(pass * 1024 + nt * 128) * DM, DM, DM, smem, acc);
#pragma unroll
      for (int mi = 0; mi < 2; ++mi) {
        const float rs = row_rs(ssq, mt * 128 + 64 * wm + 32 * mi + lr);
#pragma unroll
        for (int ni = 0; ni < 2; ++ni)
#pragma unroll
          for (int r = 0; r < 8; ++r) Gp[mi][ni][r] = pk2(sigmoid_(acc[mi][ni][2 * r] * rs), sigmoid_(acc[mi][ni][2 * r + 1] * rs));
      }
      gemm_core(P + (size_t)(mt * 128) * PLD + (pass ? PC_Y : PC_OA), PLD, W + (pass ? WB_BB : WB_BA) + (size_t)(nt * 128) * DM, DM, DM, smem, acc);
#pragma unroll
      for (int mi = 0; mi < 2; ++mi) {
        const int row = mt * 128 + 64 * wm + 32 * mi + lr;
#pragma unroll
        for (int ni = 0; ni < 2; ++ni)
#pragma unroll
          for (int b = 0; b < 4; ++b) {
            u16* op = P + (size_t)row * PLD + PC_MRG + nt * 128 + 64 * wn + 32 * ni + 8 * b + 4 * lh;
            float4 prev = make_float4(0.f, 0.f, 0.f, 0.f);
            if (pass) prev = ld_bf4(op);
            const unsigned g0 = Gp[mi][ni][2 * b], g1 = Gp[mi][ni][2 * b + 1];
            st_bf4(op, prev.x + __uint_as_float(g0 << 16) * acc[mi][ni][4 * b], prev.y + __uint_as_float(g0 & 0xffff0000u) * acc[mi][ni][4 * b + 1],
                   prev.z + __uint_as_float(g1 << 16) * acc[mi][ni][4 * b + 2], prev.w + __uint_as_float(g1 & 0xffff0000u) * acc[mi][ni][4 * b + 3]);
          }
      }
    }
  }
}

DI void wconv_tile(const Params& p, int l, int t, char* smem) {
  u16* W = (u16*)(p.ws + W_OFF);
  const float* src; const float* fold = nullptr; int ld, K, map = 0; u16* dst; int tn, tk;
  if (t < 7072) {
    int ntk;
    if (t < 1408) { src = p.in[8] + (size_t)l * 1024 * 5632; ld = 5632; K = 1024; fold = p.in[7] + l * 1024; map = 1; dst = W + WB_GU1; }
    else if (t < 2112) { t -= 1408; src = p.in[9] + (size_t)l * 2816 * 1024; ld = 1024; K = 2816; dst = W + WB_DN1; }
    else if (t < 3680) { t -= 2112; src = p.in[11] + (size_t)l * 1024 * 8208; ld = 8208; K = 1024; fold = p.in[10] + l * 1024; map = 2; dst = W + WB_WIN; }
    else if (t < 4192) { t -= 3680; src = p.in[11] + (size_t)l * 1024 * 8208 + 6160; ld = 8208; K = 1024; fold = p.in[10] + l * 1024; dst = W + WB_WG; }
    else if (t < 4448) { t -= 4192; src = p.in[23] + (size_t)l * 1048576; ld = 1024; K = 1024; dst = W + WB_BA; }
    else if (t < 4704) { t -= 4448; src = p.in[24] + (size_t)l * 1048576; ld = 1024; K = 1024; dst = W + WB_BB; }
    else if (t < 4960) { t -= 4704; src = p.in[25] + (size_t)l * 1048576; ld = 1024; K = 1024; dst = W + WB_WO; }
    else if (t < 6368) { t -= 4960; src = p.in[27] + (size_t)l * 1024 * 5632; ld = 5632; K = 1024; fold = p.in[26] + l * 1024; map = 1; dst = W + WB_GU2; }
    else { t -= 6368; src = p.in[28] + (size_t)l * 2816 * 1024; ld = 1024; K = 2816; dst = W + WB_DN2; }
    ntk = K >> 6; tn = t / ntk; tk = t - tn * ntk;
  } else {
    t -= 7072;
    const int mat = t >> 5, n = (t >> 2) & 7;
    src = p.in[mat ? 20 : 18] + (size_t)l * 131072 + n * 16384; ld = 128; K = 128;
    dst = W + (mat ? WB_WI : WB_WR) + n * 16384; tn = (t >> 1) & 1; tk = t & 1;
  }
  u16* tl = (u16*)smem;
  const int tid = otid(), nl = tid & 63, kl = tid >> 6;
  const int np = tn * 64 + nl;
  int sc = np;
  if (map == 1) sc = ((np >> 5) & 1) * 2816 + 32 * (np >> 6) + (np & 31);
  else if (map == 2) sc = np < 4096 ? np : (np < 6144 ? np + 16 : (np < 6152 ? 4096 + (np - 6144) : (np < 6160 ? 4104 + (np - 6152) : -1)));
  __syncthreads();
#pragma unroll
  for (int i = 0; i < 16; ++i) {
    const int k = tk * 64 + kl + 4 * i;
    float v = 0.f;
    if (sc >= 0) { v = src[(size_t)k * ld + sc]; if (fold) v *= fold[k]; }
    tl[nl * 66 + kl + 4 * i] = f2bf(v);
  }
  __syncthreads();
  const int n = tid >> 2, kq = tid & 3;
  const unsigned* rp = (const unsigned*)(tl + n * 66 + 16 * kq);
  uint4 o0, o1;
  o0.x = rp[0]; o0.y = rp[1]; o0.z = rp[2]; o0.w = rp[3]; o1.x = rp[4]; o1.y = rp[5]; o1.z = rp[6]; o1.w = rp[7];
  uint4* dp = (uint4*)(dst + (size_t)(tn * 64 + n) * K + tk * 64 + 16 * kq);
  dp[0] = o0; dp[1] = o1;
}

DI void gather_item(const Params& p, int item, char* smem) {
  float* x = (float*)(p.ws + X_OFF);
  u16* xb = (u16*)(p.ws + XB_OFF);
  float* ssq = (float*)(p.ws + SSQ_OFF);
  float* red = (float*)smem;
  const int tid = otid();
  for (int rr = 0; rr < 8; ++rr) {
    const int row = item * 8 + rr;
    const float* src;
    if (row < 16512) { const int s = row / 2064, pos = row - s * 2064; src = pos < 16 ? p.in[6] + pos * 1024 : p.in[0] + ((size_t)s * 2048 + (pos - 16)) * 1024; }
    else src = p.in[1] + (size_t)(row - 16512) * 1024;
    float4 v = ((const float4*)src)[tid];
    ((float4*)(x + (size_t)row * DM))[tid] = v;
    st_bf4(xb + (size_t)row * DM + 4 * tid, v.x, v.y, v.z, v.w);
    float ss = v.x * v.x + v.y * v.y + v.z * v.z + v.w * v.w;
#pragma unroll
    for (int o = 32; o > 0; o >>= 1) ss += __shfl_xor(ss, o);
    __syncthreads();
    if ((tid & 63) == 0) red[tid >> 6] = ss;
    __syncthreads();
    if (tid < 16) ssq[(size_t)row * 16 + tid] = (tid == 0) ? (red[0] + red[1] + red[2] + red[3]) : 0.f;
  }
}

DI void final_phase(const Params& p) {
  const float* x = (const float*)(p.ws + X_OFF);
  const float* ssq = (const float*)(p.ws + SSQ_OFF);
  const int tid = otid();
  const float4 fw = ((const float4*)p.in[29])[tid];
  for (int row = blockIdx.x; row < T_TOK; row += gridDim.x) {
    float* dst;
    if (row < 16512) { const int s = row / 2064, pos = row - s * 2064; if (pos < 16) continue; dst = p.out + O_YP + ((size_t)s * 2048 + (pos - 16)) * 1024; }
    else dst = p.out + O_YS + (size_t)(row - 16512) * 1024;
    const float rs = row_rs(ssq, row);
    float4 v = ((const float4*)(x + (size_t)row * DM))[tid];
    v.x *= rs * fw.x; v.y *= rs * fw.y; v.z *= rs * fw.z; v.w *= rs * fw.w;
    ((float4*)dst)[tid] = v;
  }
}

struct CI { int r0, nv, sbase, stream, last, sample; };
DI CI chunk_info(int ci) {
  CI c;
  if (ci < 264) {
    const int s = ci / 33, k = ci - s * 33;
    c.stream = s; c.sbase = s * 2064; c.sample = 0;
    if (k == 0) { c.r0 = c.sbase; c.nv = 16; } else { c.r0 = c.sbase + 16 + 64 * (k - 1); c.nv = 64; }
    c.last = (k == 32);
  } else {
    const int s = ci - 264;
    c.stream = 8 + s; c.sbase = 16512 + 32 * s; c.r0 = c.sbase; c.nv = 32; c.last = 1; c.sample = 1;
  }
  return c;
}

DI void dconv_store(const Params& p, int l, const CI& c, int cc, int ch, int half, char* RM, char* RT, float* cqo) {
  const u16* P = (const u16*)(p.ws + P_OFF);
  const float* cwp = p.in[12] + (size_t)l * 4 * 3072 + cc;
  const float w0 = cwp[0], w1 = cwp[3072], w2 = cwp[2 * 3072], w3 = cwp[3 * 3072];
  const int pad = 64 - c.nv;
#pragma unroll 1
  for (int q = 0; q < 4; ++q) {
    const int tq = 32 * half + 8 * q;
    float r[11];
#pragma unroll
    for (int i = 0; i < 11; ++i) {
      const int u = tq - 3 + i;
      float v = 0.f;
      if (u >= pad - 3) {
        const int rowu = c.r0 + u - pad;
        if (rowu >= c.sbase) v = bf2f(P[(size_t)rowu * PLD + cc]);
        else if (c.sample) v = p.in[3][((size_t)(l * 16 + (c.stream - 8)) * 3 + (3 + rowu - c.sbase)) * 3072 + cc];
      }
      r[i] = v;
    }
    float o[8];
#pragma unroll
    for (int i = 0; i < 8; ++i) {
      const float sv = r[i] * w0 + r[i + 1] * w1 + r[i + 2] * w2 + r[i + 3] * w3;
      o[i] = (tq + i >= pad) ? silu_(sv) : 0.f;
    }
    if (RM) {
#pragma unroll
      for (int i = 0; i < 8; ++i) *(u16*)(RM + sw256(tq + i, ch >> 3) + (ch & 7) * 2) = f2bf(o[i]);
    }
    if (RT) {
      u32x4 v; v[0] = pk2(o[0], o[1]); v[1] = pk2(o[2], o[3]); v[2] = pk2(o[4], o[5]); v[3] = pk2(o[6], o[7]);
      *(u32x4*)(RT + sw128(ch, 4 * half + q)) = v;
    }
    if (q == 3 && half && c.last) { cqo[cc] = r[8]; cqo[3072 + cc] = r[9]; cqo[6144 + cc] = r[10]; }
  }
}

DI void delta_pre_item(const Params& p, int l, int it, char* smem) {
  const int ci = it >> 3, h = it & 7;
  const CI c = chunk_info(ci);
  const u16* P = (const u16*)(p.ws + P_OFF);
  char* R0 = smem; char* R1 = smem + 16384; char* R2 = smem + 32768; float* Lm = (float*)(smem + 49152);
  float* sBeta = (float*)(smem + 65536); float* sGc = sBeta + 64; float* sNk = sBeta + 128; float* sNq = sBeta + 192;
  const int tid = otid(), lane = tid & 63, wid = tid >> 6, lr = lane & 31, lh = lane >> 5;
  const int ch = tid & 127, half = tid >> 7, t0 = 32 * half;
  const int pad = 64 - c.nv;
  float* cqo = p.out + (c.sample ? O_SCQ + ((size_t)(l * 16 + (c.stream - 8)) * 3) * 3072 : O_PCQ + ((size_t)(l * 8 + c.stream) * 3) * 3072);
  __syncthreads();
  dconv_store(p, l, c, h * 128 + ch, ch, half, R0, nullptr, cqo);
  dconv_store(p, l, c, 1024 + h * 128 + ch, ch, half, R1, R2, cqo);
  if (tid < 64) {
    float beta = 0.f, g = 0.f;
    if (tid >= pad) {
      const size_t row = (size_t)(c.r0 + tid - pad);
      beta = sigmoid_(bf2f(P[row * PLD + PC_BETA + h]));
      g = -__expf(p.in[13][l * 8 + h]) * softplus_(bf2f(P[row * PLD + PC_ALPHA + h]) + p.in[14][l * 8 + h]);
    }
#pragma unroll
    for (int o = 1; o < 64; o <<= 1) { const float v = __shfl_up(g, o); if (lane >= o) g += v; }
    sBeta[tid] = beta; sGc[tid] = g;
  }
  __syncthreads();
  const int ti = wid >> 1, tj = wid & 1;
  f32x16 aQK, aKK, aQQ;
  zero16(aQK); zero16(aKK); zero16(aQQ);
#pragma unroll
  for (int ks = 0; ks < 8; ++ks) {
    const bf16x8 kf = ldsfrag(R1, sw256(32 * tj + lr, 2 * ks + lh));
    const bf16x8 qf = ldsfrag(R0, sw256(32 * ti + lr, 2 * ks + lh));
    const bf16x8 kif = ldsfrag(R1, sw256(32 * ti + lr, 2 * ks + lh));
    aQK = MFMA(kf, qf, aQK);
    aKK = MFMA(kf, kif, aKK);
    if (ti == tj) aQQ = MFMA(qf, qf, aQQ);
  }
  if (ti == tj && (((lr >> 2) & 1) == lh)) {
    float vk = 0.f, vq = 0.f;
#pragma unroll
    for (int reg = 0; reg < 16; ++reg) if (crow(reg, lh) == lr) { vk = aKK[reg]; vq = aQQ[reg]; }
    sNk[32 * ti + lr] = vk; sNq[32 * ti + lr] = vq;
  }
  __syncthreads();
  const size_t itb = (size_t)it;
  {
    u16* Ag = (u16*)(p.ws + A_OFF) + itb * 4096;
    const int i = 32 * ti + lr;
    const float gi = sGc[i], rqi = rsqrtf(sNq[i] + EPS) * 0.08838834764831845f, bki = sBeta[i] * rsqrtf(sNk[i] + EPS);
#pragma unroll
    for (int b = 0; b < 4; ++b) {
      float av[4], lv[4];
#pragma unroll
      for (int r = 0; r < 4; ++r) {
        const int j = 32 * tj + 8 * b + 4 * lh + r;
        const float rkj = rsqrtf(sNk[j] + EPS);
        const float dec = (j <= i) ? __expf(gi - sGc[j]) : 0.f;
        av[r] = rqi * rkj * aQK[4 * b + r] * dec;
        lv[r] = (j < i) ? bki * rkj * aKK[4 * b + r] * dec : 0.f;
      }
      st_bf4(Ag + i * 64 + 16 * (2 * tj + (b >> 1)) + 8 * lh + 4 * (b & 1), av[0], av[1], av[2], av[3]);
      *(float4*)(Lm + i * 64 + 32 * tj + 8 * b + 4 * lh) = make_float4(lv[0], lv[1], lv[2], lv[3]);
    }
    u16* Qg = (u16*)(p.ws + QD_OFF) + itb * 8192;
    u16* Kg = (u16*)(p.ws + KD_OFF) + itb * 8192;
    const float glc = sGc[63];
#pragma unroll
    for (int ii = 0; ii < 4; ++ii) {
      const int q = tid + 256 * ii;
      {
        const int t = q >> 4, chn = q & 15, s = chn >> 1, hh = chn & 1;
        const float sc = rsqrtf(sNq[t] + EPS) * 0.08838834764831845f * __expf(sGc[t]);
        const int c0 = 16 * s + 4 * hh, c1 = c0 + 8;
        const float4 v0 = ld_bf4((const u16*)(R0 + sw256(t, c0 >> 3) + (c0 & 7) * 2));
        const float4 v1 = ld_bf4((const u16*)(R0 + sw256(t, c1 >> 3) + (c1 & 7) * 2));
        uint4 o; o.x = pk2(v0.x * sc, v0.y * sc); o.y = pk2(v0.z * sc, v0.w * sc); o.z = pk2(v1.x * sc, v1.y * sc); o.w = pk2(v1.z * sc, v1.w * sc);
        *(uint4*)(Qg + t * 128 + 8 * chn) = o;
      }
      {
        const int dk = q >> 3, chn = q & 7, s = chn >> 1, hh = chn & 1;
        const int ta = 16 * s + 4 * hh, tb = ta + 8;
        const float4 v0 = ld_bf4((const u16*)(R2 + sw128(dk, ta >> 3) + (ta & 7) * 2));
        const float4 v1 = ld_bf4((const u16*)(R2 + sw128(dk, tb >> 3) + (tb & 7) * 2));
        float sa[4], sb[4];
#pragma unroll
        for (int r = 0; r < 4; ++r) { sa[r] = rsqrtf(sNk[ta + r] + EPS) * __expf(glc - sGc[ta + r]); sb[r] = rsqrtf(sNk[tb + r] + EPS) * __expf(glc - sGc[tb + r]); }
        uint4 o; o.x = pk2(v0.x * sa[0], v0.y * sa[1]); o.y = pk2(v0.z * sa[2], v0.w * sa[3]); o.z = pk2(v1.x * sb[0], v1.y * sb[1]); o.w = pk2(v1.z * sb[2], v1.w * sb[3]);
        *(uint4*)(Kg + dk * 64 + 8 * chn) = o;
      }
    }
    if (tid == 0) ((float*)(p.ws + GL_OFF))[it] = __expf(glc);
  }
  __syncthreads();
  dconv_store(p, l, c, 2048 + h * 128 + ch, ch, half, nullptr, R0, cqo);
  if (wid == 0) {
    float* Tm = (float*)R1;
#pragma unroll 8
    for (int i = 0; i < 64; ++i) Tm[i * 64 + lane] = 0.f;
    for (int i = 0; i < 64; ++i) {
      float s = (i == lane) ? 1.f : 0.f;
      const float* Li = Lm + i * 64;
      for (int j4 = 0; j4 < i; j4 += 4) {
        const float4 lv = *(const float4*)(Li + j4);
        s -= lv.x * Tm[j4 * 64 + lane]; s -= lv.y * Tm[(j4 + 1) * 64 + lane]; s -= lv.z * Tm[(j4 + 2) * 64 + lane]; s -= lv.w * Tm[(j4 + 3) * 64 + lane];
      }
      Tm[i * 64 + lane] = s;
    }
    const float b1 = sBeta[lane], c1 = b1 * rsqrtf(sNk[lane] + EPS) * __expf(sGc[lane]);
    char* R3 = (char*)Lm;
#pragma unroll 4
    for (int t = 0; t < 64; ++t) {
      const int off = sw128(t, lane >> 3) + (lane & 7) * 2;
      const float tv = Tm[t * 64 + lane];
      *(u16*)(R3 + off) = f2bf(tv * c1);
      *(u16*)(R3 + 8192 + off) = f2bf(tv * b1);
    }
  }
  __syncthreads();
  {
    u16* Wg = (u16*)(p.ws + WW_OFF) + itb * 8192;
    u16* Ug = (u16*)(p.ws + UT_OFF) + itb * 8192;
    f32x16 aw[2], au[2];
    zero16(aw[0]); zero16(aw[1]); zero16(au[0]); zero16(au[1]);
#pragma unroll
    for (int ks = 0; ks < 4; ++ks) {
      const bf16x8 kT = ldsfrag(R2, sw128(32 * wid + lr, 2 * ks + lh));
      const bf16x8 vT = ldsfrag(R0, sw128(32 * wid + lr, 2 * ks + lh));
#pragma unroll
      for (int bb = 0; bb < 2; ++bb) {
        const bf16x8 t1 = ldsfrag((const char*)Lm, sw128(32 * bb + lr, 2 * ks + lh));
        const bf16x8 t2 = ldsfrag((const char*)Lm + 8192, sw128(32 * bb + lr, 2 * ks + lh));
        aw[bb] = MFMA(kT, t1, aw[bb]);
        au[bb] = MFMA(t2, vT, au[bb]);
      }
    }
#pragma unroll
    for (int bb = 0; bb < 2; ++bb)
#pragma unroll
      for (int b = 0; b < 4; ++b) {
        st_bf4(Wg + (32 * bb + lr) * 128 + 32 * wid + 16 * (b >> 1) + 8 * lh + 4 * (b & 1), aw[bb][4 * b], aw[bb][4 * b + 1], aw[bb][4 * b + 2], aw[bb][4 * b + 3]);
        st_bf4(Ug + (32 * wid + lr) * 64 + 32 * bb + 8 * b + 4 * lh, au[bb][4 * b], au[bb][4 * b + 1], au[bb][4 * b + 2], au[bb][4 * b + 3]);
      }
  }
}

DI void delta_seq_item(const Params& p, int l, int item, char* smem) {
  const int stream = item >> 3, h = item & 7;
  const int tid = otid(), lane = tid & 63, wid = tid >> 6, lr = lane & 31, lh = lane >> 5;
  const int dv = 32 * wid + lr;
  u16* P = (u16*)(p.ws + P_OFF);
  f32x16 S[4];
  float* Sout;
  int nchunk, ci0;
  if (stream < 8) {
#pragma unroll
    for (int m = 0; m < 4; ++m) zero16(S[m]);
    Sout = p.out + O_PS + ((size_t)(l * 8 + stream) * 8 + h) * 16384;
    nchunk = 33; ci0 = stream * 33;
  } else {
    const float* S0 = p.in[2] + ((size_t)(l * 16 + (stream - 8)) * 8 + h) * 16384;
    const float* sp = S0 + (4 * lh) * 128 + dv;
#pragma unroll
    for (int m = 0; m < 4; ++m)
#pragma unroll
      for (int b = 0; b < 4; ++b) {
#pragma unroll
        for (int r = 0; r < 4; ++r) S[m][4 * b + r] = sp[r * 128];
        sp += 8 * 128;
        __builtin_amdgcn_sched_barrier(0);
      }
    Sout = p.out + O_SS + ((size_t)(l * 16 + (stream - 8)) * 8 + h) * 16384;
    nchunk = 1; ci0 = 264 + (stream - 8);
  }
  for (int k = 0; k < nchunk; ++k) {
    const int ci = ci0 + k;
    const CI c = chunk_info(ci);
    const size_t it = (size_t)ci * 8 + h;
    const u16* Wg = (const u16*)(p.ws + WW_OFF) + it * 8192;
    const u16* Qg = (const u16*)(p.ws + QD_OFF) + it * 8192;
    const u16* Kg = (const u16*)(p.ws + KD_OFF) + it * 8192;
    const u16* Ag = (const u16*)(p.ws + A_OFF) + it * 4096;
    const u16* Ug = (const u16*)(p.ws + UT_OFF) + it * 8192;
    const float gl = ((const float*)(p.ws + GL_OFF))[it];
    __syncthreads();
#pragma unroll
    for (int ii = 0; ii < 4; ++ii) {
      const int q = tid + 256 * ii;
      *(uint4*)(smem + sw256(q >> 4, q & 15)) = *(const uint4*)(Wg + q * 8);
      *(uint4*)(smem + 16384 + sw256(q >> 4, q & 15)) = *(const uint4*)(Qg + q * 8);
      *(uint4*)(smem + 32768 + sw128(q >> 3, q & 7)) = *(const uint4*)(Kg + q * 8);
    }
#pragma unroll
    for (int ii = 0; ii < 2; ++ii) {
      const int q = tid + 256 * ii;
      *(uint4*)(smem + 49152 + sw128(q >> 3, q & 7)) = *(const uint4*)(Ag + q * 8);
    }
    float4 uv[2][4];
#pragma unroll
    for (int m = 0; m < 2; ++m)
#pragma unroll
      for (int b = 0; b < 4; ++b) uv[m][b] = ld_bf4(Ug + dv * 64 + 32 * m + 8 * b + 4 * lh);
    __syncthreads();
    f32x16 M1[2], M2[2];
    zero16(M1[0]); zero16(M1[1]); zero16(M2[0]); zero16(M2[1]);
#pragma unroll
    for (int mt = 0; mt < 4; ++mt) {
#pragma unroll
      for (int s = 0; s < 2; ++s) {
        const int ks = 2 * mt + s;
        const bf16x8 Sp = s ? pack8<1>(S[mt]) : pack8<0>(S[mt]);
#pragma unroll
        for (int m = 0; m < 2; ++m) {
          const bf16x8 wf = ldsfrag(smem, sw256(32 * m + lr, 2 * ks + lh));
          const bf16x8 qf = ldsfrag(smem + 16384, sw256(32 * m + lr, 2 * ks + lh));
          M1[m] = MFMA(wf, Sp, M1[m]);
          M2[m] = MFMA(qf, Sp, M2[m]);
        }
      }
    }
#pragma unroll
    for (int m = 0; m < 2; ++m)
#pragma unroll
      for (int b = 0; b < 4; ++b) {
        M1[m][4 * b] = uv[m][b].x - M1[m][4 * b]; M1[m][4 * b + 1] = uv[m][b].y - M1[m][4 * b + 1];
        M1[m][4 * b + 2] = uv[m][b].z - M1[m][4 * b + 2]; M1[m][4 * b + 3] = uv[m][b].w - M1[m][4 * b + 3];
      }
    bf16x8 Vp[4];
    Vp[0] = pack8<0>(M1[0]); Vp[1] = pack8<1>(M1[0]); Vp[2] = pack8<0>(M1[1]); Vp[3] = pack8<1>(M1[1]);
#pragma unroll
    for (int m = 0; m < 2; ++m)
#pragma unroll
      for (int kk = 0; kk < 4; ++kk) {
        const bf16x8 af = ldsfrag(smem + 49152, sw128(32 * m + lr, 2 * kk + lh));
        M2[m] = MFMA(af, Vp[kk], M2[m]);
      }
#pragma unroll
    for (int mt = 0; mt < 4; ++mt) {
#pragma unroll
      for (int r = 0; r < 16; ++r) S[mt][r] *= gl;
#pragma unroll
      for (int kk = 0; kk < 4; ++kk) {
        const bf16x8 kf = ldsfrag(smem + 32768, sw128(32 * mt + lr, 2 * kk + lh));
        S[mt] = MFMA(kf, Vp[kk], S[mt]);
      }
    }
    __syncthreads();
    float* ot = (float*)smem;
#pragma unroll
    for (int m = 0; m < 2; ++m)
#pragma unroll
      for (int r = 0; r < 16; ++r) ot[(32 * m + crow(r, lh)) * 128 + dv] = M2[m][r];
    __syncthreads();
    {
      const int t = tid >> 2, q = tid & 3, pad = 64 - c.nv;
      float4 v[8];
      float ss = 0.f;
#pragma unroll
      for (int i = 0; i < 8; ++i) { v[i] = *(const float4*)(ot + t * 128 + 32 * q + 4 * i); ss += v[i].x * v[i].x + v[i].y * v[i].y + v[i].z * v[i].z + v[i].w * v[i].w; }
      ss += __shfl_xor(ss, 1); ss += __shfl_xor(ss, 2);
      const float rs = rsqrtf(ss * (1.f / 128.f) + EPS);
      if (t >= pad) {
        u16* zp = P + (size_t)(c.r0 + t - pad) * PLD + PC_Z + h * 128 + 32 * q;
        u16* op = P + (size_t)(c.r0 + t - pad) * PLD + PC_OA + h * 128 + 32 * q;
        const float* nw = p.in[15] + l * 128 + 32 * q;
#pragma unroll
        for (int i = 0; i < 8; ++i) {
          const float4 z = ld_bf4(zp + 4 * i);
          const float4 w4 = *(const float4*)(nw + 4 * i);
          st_bf4(op + 4 * i, v[i].x * rs * w4.x * silu_(z.x), v[i].y * rs * w4.y * silu_(z.y), v[i].z * rs * w4.z * silu_(z.z), v[i].w * rs * w4.w * silu_(z.w));
        }
      }
    }
  }
  float* so = Sout + (4 * lh) * 128 + dv;
#pragma unroll
  for (int m = 0; m < 4; ++m)
#pragma unroll
    for (int b = 0; b < 4; ++b) {
#pragma unroll
      for (int r = 0; r < 4; ++r) so[r * 128] = S[m][4 * b + r];
      so += 8 * 128;
      __builtin_amdgcn_sched_barrier(0);
    }
}

struct LT { int r0, nv, first, last, stream; };
DI LT lru_tile(int tl) {
  LT t;
  if (tl < 520) { const int s = tl / 65, j = tl - s * 65; t.stream = s; t.first = (j == 0); t.last = (j == 64); t.nv = j ? 32 : 16; t.r0 = s * 2064 + (j ? 16 + 32 * (j - 1) : 0); }
  else { const int s = tl - 520; t.stream = 8 + s; t.first = 1; t.last = 1; t.nv = 32; t.r0 = 16512 + 32 * s; }
  return t;
}
DI void lru_a_item(const Params& p, int l, int item, char* smem) {
  const int tl = item >> 3, n = item & 7;
  const LT T = lru_tile(tl);
  const int tid = otid(), lane = tid & 63, wid = tid >> 6, lr = lane & 31, lh = lane >> 5;
  u16* P = (u16*)(p.ws + P_OFF);
  u16* Ya = (u16*)(p.out + O_YP);
  const u16* W = (const u16*)(p.ws + W_OFF);
  float* AG = (float*)(p.ws + AG_OFF);
  float* raw = (float*)smem; float* xc = (float*)(smem + 18432); char* xcb = smem + 34816;
  const int ch = tid & 127, rp = tid >> 7;
  const int gc = n * 128 + ch;
  const int d = 32 * wid + lr, gd = n * 128 + d;
  float lyv[16];
#pragma unroll
  for (int r = 0; r < 16; ++r) { const int t = crow(r, lh); lyv[r] = (t < T.nv) ? bf2f(P[(size_t)(T.r0 + t) * PLD + PC_LY + gd]) : 0.f; }
  bf16x8 wrf[8], wif[8];
#pragma unroll
  for (int ks = 0; ks < 8; ++ks) {
    wrf[ks] = *(const bf16x8*)(W + WB_WR + n * 16384 + d * 128 + (2 * ks + lh) * 8);
    wif[ks] = *(const bf16x8*)(W + WB_WI + n * 16384 + d * 128 + (2 * ks + lh) * 8);
  }
  const float* cwp = p.in[16] + (size_t)l * 4 * 1024 + gc;
  const float cw0 = cwp[0], cw1 = cwp[1024], cw2 = cwp[2048], cw3 = cwp[3072], cb = p.in[17][l * 1024 + gc];
  const float br = p.in[19][l * 1024 + gd], bi = p.in[21][l * 1024 + gd];
  const float c8 = -8.f * softplus_(-p.in[22][l * 1024 + gd]);
  __syncthreads();
#pragma unroll
  for (int i = 0; i < 18; ++i) {
    const int rr = rp + 2 * i;
    if (rr < 3 + T.nv) {
      float v;
      if (rr >= 3 || !T.first) v = bf2f(P[(size_t)(T.r0 + rr - 3) * PLD + PC_LX + gc]);
      else v = (T.stream >= 8) ? p.in[5][((size_t)(l * 16 + (T.stream - 8)) * 3 + rr) * 1024 + gc] : 0.f;
      raw[rr * 128 + ch] = v;
    }
  }
  __syncthreads();
#pragma unroll 4
  for (int t = rp; t < 32; t += 2) {
    float v = 0.f;
    if (t < T.nv) v = cb + raw[t * 128 + ch] * cw0 + raw[(t + 1) * 128 + ch] * cw1 + raw[(t + 2) * 128 + ch] * cw2 + raw[(t + 3) * 128 + ch] * cw3;
    xc[t * 128 + ch] = v;
    *(u16*)(xcb + sw256(t, ch >> 3) + (ch & 7) * 2) = f2bf(v);
  }
  if (T.last && tid < 128) {
    float* ocx = (T.stream < 8) ? p.out + O_PCX + (size_t)(l * 8 + T.stream) * 3 * 1024 : p.out + O_SCX + (size_t)(l * 16 + (T.stream - 8)) * 3 * 1024;
    ocx[gc] = raw[T.nv * 128 + ch]; ocx[1024 + gc] = raw[(T.nv + 1) * 128 + ch]; ocx[2048 + gc] = raw[(T.nv + 2) * 128 + ch];
  }
  __syncthreads();
  f32x16 aR, aI;
  zero16(aR); zero16(aI);
#pragma unroll
  for (int ks = 0; ks < 8; ++ks) {
    const bf16x8 af = ldsfrag(xcb, sw256(lr, 2 * ks + lh));
    aR = MFMA(af, wrf[ks], aR);
    aI = MFMA(af, wif[ks], aI);
  }
  float av[16], bv[16], hv[16], pv[16];
#pragma unroll
  for (int r = 0; r < 16; ++r) {
    const int t = crow(r, lh);
    const float rr = sigmoid_(aR[r] + br), ig = sigmoid_(aI[r] + bi);
    const float la = c8 * rr;
    const float a = __expf(la), mult = sqrtf(fmaxf(1.f - __expf(2.f * la), 0.f));
    const float xv = xc[t * 128 + d];
    av[r] = (t < T.nv) ? a : 1.f;
    bv[r] = (t < T.nv) ? mult * ig * xv : 0.f;
  }
  float hc = 0.f, pc = 1.f;
#pragma unroll
  for (int b = 0; b < 4; ++b) {
    float cA = hc, qA = pc, tA[4], uA[4], tB[4], uB[4];
#pragma unroll
    for (int r = 0; r < 4; ++r) { cA = av[4 * b + r] * cA + bv[4 * b + r]; qA = av[4 * b + r] * qA; tA[r] = cA; uA[r] = qA; }
    hc = __shfl(cA, lr); pc = __shfl(qA, lr);
    float cB = hc, qB = pc;
#pragma unroll
    for (int r = 0; r < 4; ++r) { cB = av[4 * b + r] * cB + bv[4 * b + r]; qB = av[4 * b + r] * qB; tB[r] = cB; uB[r] = qB; }
    hc = __shfl(cB, lr + 32); pc = __shfl(qB, lr + 32);
#pragma unroll
    for (int r = 0; r < 4; ++r) { hv[4 * b + r] = lh ? tB[r] : tA[r]; pv[4 * b + r] = lh ? uB[r] : uA[r]; }
  }
#pragma unroll
  for (int r = 0; r < 16; ++r) {
    const int t = crow(r, lh);
    if (t < T.nv) {
      const float g = gelu_tanh_(lyv[r]);
      P[(size_t)(T.r0 + t) * PLD + PC_LY + gd] = f2bf(hv[r] * g);
      Ya[(size_t)(T.r0 + t) * 1024 + gd] = f2bf(pv[r] * g);
    }
  }
  if (lh == 0) { AG[(size_t)(tl * 2) * 1024 + gd] = pc; AG[(size_t)(tl * 2 + 1) * 1024 + gd] = hc; }
}

DI void lru_b_item(const Params& p, int l, int item, char* smem) {
  const int tid = otid();
  u16* P = (u16*)(p.ws + P_OFF);
  const u16* Ya = (const u16*)(p.out + O_YP);
  const float* AG = (const float*)(p.ws + AG_OFF);
  float* cin = (float*)smem;
  int stream, n, qtr, ntile, tl0, rbase, L;
  if (item < 256) { stream = item >> 5; n = (item >> 2) & 7; qtr = item & 3; ntile = 65; tl0 = stream * 65; rbase = stream * 2064; L = 2064; }
  else { const int q = item - 256; stream = 8 + (q >> 3); n = q & 7; qtr = -1; ntile = 1; tl0 = 520 + (stream - 8); rbase = 16512 + 32 * (stream - 8); L = 32; }
  __syncthreads();
  if (tid < 128) {
    const int gd = n * 128 + tid;
    float c = (stream >= 8) ? p.in[4][(size_t)(l * 16 + (stream - 8)) * 1024 + gd] : 0.f;
#pragma unroll 13
    for (int j = 0; j < ntile; ++j) {
      const float a = AG[(size_t)((tl0 + j) * 2) * 1024 + gd], h = AG[(size_t)((tl0 + j) * 2 + 1) * 1024 + gd];
      cin[j * 128 + tid] = c;
      c = a * c + h;
    }
    if (qtr <= 0) {
      float* oh = (stream < 8) ? p.out + O_PH + (size_t)(l * 8 + stream) * 1024 : p.out + O_SH + (size_t)(l * 16 + (stream - 8)) * 1024;
      oh[gd] = c;
    }
  }
  __syncthreads();
  const int ck = tid & 15, rsub = tid >> 4;
  int pb = 0, pe = L;
  if (qtr >= 0) { pb = 516 * qtr; pe = pb + 516; }
#pragma unroll 2
  for (int pr = pb + rsub; pr < pe; pr += 16) {
    const int j = (stream < 8) ? (pr < 16 ? 0 : 1 + ((pr - 16) >> 5)) : 0;
    const size_t row = (size_t)(rbase + pr);
    const u32x4 yl = *(const u32x4*)(P + row * PLD + PC_LY + n * 128 + 8 * ck);
    const u32x4 ya = *(const u32x4*)(Ya + row * 1024 + n * 128 + 8 * ck);
    const float* cp = cin + j * 128 + 8 * ck;
    u32x4 o;
#pragma unroll
    for (int e = 0; e < 4; ++e) {
      const float y0 = __uint_as_float(yl[e] << 16) + __uint_as_float(ya[e] << 16) * cp[2 * e];
      const float y1 = __uint_as_float(yl[e] & 0xffff0000u) + __uint_as_float(ya[e] & 0xffff0000u) * cp[2 * e + 1];
      o[e] = pk2(y0, y1);
    }
    *(u32x4*)(P + row * PLD + PC_Y + n * 128 + 8 * ck) = o;
  }
}

#define XB_TMO      128
#define XB_XCNT(j)  (256  + 64 * (j))
#define XB_XSUB(j)  (1280 + 64 * (j))
#define XB_XGEN(j)  (2304 + 64 * (j))
#define XB_TOP      3328
#define XB_TOPGEN   3392
#define XCD_BAR_WORDS 3456
#define XB_SPIN_CAP (1u << 22)
DI unsigned xb_ld(unsigned* p) { return __hip_atomic_load(p, __ATOMIC_RELAXED, __HIP_MEMORY_SCOPE_AGENT); }
DI unsigned xb_add(unsigned* p, unsigned v) { return __hip_atomic_fetch_add(p, v, __ATOMIC_RELAXED, __HIP_MEMORY_SCOPE_AGENT); }
DI unsigned xb_xcc_id() { return (unsigned)__builtin_amdgcn_s_getreg((3 << 11) | 20) & 0xFu; }
#define XB_SPIN(cond, bar) do { unsigned _sp = 0; while (cond) { __builtin_amdgcn_s_sleep(1); \
    if ((++_sp & 255u) == 0u) { if (xb_ld(&(bar)[XB_TMO])) break; if (_sp > XB_SPIN_CAP) { atomicAdd(&(bar)[XB_TMO], 1u); break; } } } } while (0)
struct XcdBarrier { unsigned* bar; unsigned x; volatile unsigned* st; };
DI XcdBarrier xcd_barrier_post(unsigned* bar, volatile unsigned* st) {
  XcdBarrier b; b.bar = bar; b.x = xb_xcc_id(); b.st = st;
  if (threadIdx.x == 0) (void)xb_add(&bar[XB_XCNT(b.x)], 1u);
  return b;
}
DI void xcd_barrier_complete(unsigned* bar, unsigned x, unsigned& nloc, unsigned& nx) {
  const unsigned G = gridDim.x * gridDim.y * gridDim.z;
  unsigned sum, cnt, mine, sp = 0u;
  for (;;) {
    sum = 0u; cnt = 0u; mine = 0u;
#pragma unroll
    for (unsigned j = 0; j < 16; ++j) { const unsigned c = xb_ld(&bar[XB_XCNT(j)]); sum += c; cnt += (c > 0u) ? 1u : 0u; mine = (j == x) ? c : mine; }
    if (sum == G) break;
    __builtin_amdgcn_s_sleep(1);
    if ((++sp & 255u) == 0u) { if (xb_ld(&bar[XB_TMO])) break; if (sp > XB_SPIN_CAP) { atomicAdd(&bar[XB_TMO], 1u); break; } }
  }
  nloc = mine > 0u ? mine : 1u; nx = cnt > 0u ? cnt : 1u;
}
DI void xcd_barrier(const XcdBarrier& b) {
  asm volatile("s_waitcnt vmcnt(0)" ::: "memory");
  __syncthreads();
  if (threadIdx.x == 0) {
    unsigned* bar = b.bar;
    __builtin_amdgcn_s_waitcnt(0);
    unsigned nloc = b.st[0], nx = b.st[1];
    if (nloc == 0u) { xcd_barrier_complete(bar, b.x, nloc, nx); b.st[0] = nloc; b.st[1] = nx; }
    const unsigned old = xb_add(&bar[XB_XSUB(b.x)], 1u);
    const unsigned gen = old / nloc;
    if (old + 1u == (gen + 1u) * nloc) {
      __builtin_amdgcn_fence(__ATOMIC_RELEASE, "agent");
      asm volatile("s_waitcnt vmcnt(0)" ::: "memory");
      const unsigned og = xb_add(&bar[XB_TOP], 1u);
      const unsigned tg = og / nx;
      if (og + 1u == (tg + 1u) * nx) xb_add(&bar[XB_TOPGEN], 1u);
      else XB_SPIN(xb_ld(&bar[XB_TOPGEN]) == tg, bar);
      __builtin_amdgcn_fence(__ATOMIC_ACQUIRE, "agent");
      xb_add(&bar[XB_XGEN(b.x)], 1u);
      asm volatile("s_waitcnt vmcnt(0)" ::: "memory");
    } else {
      XB_SPIN(xb_ld(&bar[XB_XGEN(b.x)]) == gen, bar);
      __builtin_amdgcn_fence(__ATOMIC_ACQUIRE, "agent");
      asm volatile("s_waitcnt vmcnt(0)" ::: "memory");
    }
  }
  __syncthreads();
}

__global__ void __launch_bounds__(256, 2) mega(Params p, int lo, int hi) {
  extern __shared__ __attribute__((aligned(16))) char smem[];
  const u16* xb = (const u16*)(p.ws + XB_OFF);
  const u16* P = (const u16*)(p.ws + P_OFF);
  const u16* W = (const u16*)(p.ws + W_OFF);
  volatile unsigned* bst = (volatile unsigned*)(smem + 69632);
  if (threadIdx.x == 0) { bst[0] = 0u; bst[1] = 0u; }
  __syncthreads();
  const XcdBarrier gb = xcd_barrier_post((unsigned*)(p.ws + BAR_OFF), bst);
  if (lo < 0) cg::this_grid().sync();
#define GRID_SYNC() xcd_barrier(gb)
  int ph = 0;
#ifndef PROBE_MASK
#define PROBE_MASK 0
#endif
#define PH(body) { if (ph >= lo && ph < hi) { if (ph > lo) GRID_SYNC(); body } ++ph; }
#define PHX(bit, body, rep) { if (ph >= lo && ph < hi) { if (ph > lo) GRID_SYNC(); body if (PROBE_MASK & (bit)) { GRID_SYNC(); rep } } ++ph; }
#pragma unroll 1
  for (int l = 0; l < 4; ++l) {
    PHX(2, {
      const int nw = 7136 + (l == 0 ? 2128 : 0);
      for (int w = blockIdx.x; w < nw; w += gridDim.x) { if (w < 7136) wconv_tile(p, l, w, smem); else gather_item(p, w - 7136, smem); }
    }, { for (int w = blockIdx.x; w < 7136; w += gridDim.x) wconv_tile(p, l, w, smem); })
    PHX(1, gemm_phase<EPI_GU>(p, xb, DM, W + WB_GU1, DM, DM, 44, 0.f, smem);, gemm_phase<EPI_GU>(p, xb, DM, W + WB_GU1, DM, DM, 44, 0.f, smem);)
    PHX(1, gemm_phase<EPI_DOWN>(p, P, DFF, W + WB_DN1, DFF, DFF, 8, 0.5f, smem);, gemm_phase<EPI_DOWN>(p, P, DFF, W + WB_DN1, DFF, DFF, 8, 0.f, smem);)
    PHX(1, gemm_phase<EPI_WIN>(p, xb, DM, W + WB_WIN, DM, DM, 49, 0.f, smem);, gemm_phase<EPI_WIN>(p, xb, DM, W + WB_WIN, DM, DM, 49, 0.f, smem);)
    PHX(2, {
      for (int w = blockIdx.x; w < NITEM + NLT * 8; w += gridDim.x) { if (w < NITEM) delta_pre_item(p, l, w, smem); else lru_a_item(p, l, w - NITEM, smem); }
    }, { for (int w = blockIdx.x; w < NITEM; w += gridDim.x) delta_pre_item(p, l, w, smem); })
    PHX(4, {
      for (int w = blockIdx.x; w < 192 + 384; w += gridDim.x) {
        if (w < 192) delta_seq_item(p, l, w, smem);
        else lru_b_item(p, l, w - 192, smem);
      }
    }, { for (int q = 0; q < 19; ++q) GRID_SYNC(); })
    PHX(1, merge_phase(p, smem);, merge_phase(p, smem);)
    PHX(1, gemm_phase<EPI_DOWN>(p, P + PC_MRG, PLD, W + WB_WO, DM, DM, 8, 1.f, smem);, gemm_phase<EPI_DOWN>(p, P + PC_MRG, PLD, W + WB_WO, DM, DM, 8, 0.f, smem);)
    PHX(1, gemm_phase<EPI_GU>(p, xb, DM, W + WB_GU2, DM, DM, 44, 0.f, smem);, gemm_phase<EPI_GU>(p, xb, DM, W + WB_GU2, DM, DM, 44, 0.f, smem);)
    PHX(1, gemm_phase<EPI_DOWN>(p, P, DFF, W + WB_DN2, DFF, DFF, 8, 0.5f, smem);, gemm_phase<EPI_DOWN>(p, P, DFF, W + WB_DN2, DFF, DFF, 8, 0.f, smem);)
  }
  PH(final_phase(p);)
}

extern "C" void kernel_launch(void* const* d_in, const int* in_sizes, int n_in, void* d_out, int out_size, void* d_ws, size_t ws_size,
                              hipStream_t stream) {
  if (ws_size < WS_NEED || n_in < 30) { fprintf(stderr, "workspace too small: %zu < %zu\n", ws_size, (size_t)WS_NEED); return; }
  static int grid_blocks = 0;
  if (!grid_blocks) {
    hipFuncSetAttribute((const void*)mega, hipFuncAttributeMaxDynamicSharedMemorySize, LDS_BYTES);
    int dev = 0, cus = 0, per_cu = 0;
    hipGetDevice(&dev);
    hipDeviceGetAttribute(&cus, hipDeviceAttributeMultiprocessorCount, dev);
    hipOccupancyMaxActiveBlocksPerMultiprocessor(&per_cu, mega, 256, LDS_BYTES);
    if (per_cu > 2) per_cu = 2;
    grid_blocks = cus * per_cu;
  }
  Params p{};
  for (int i = 0; i < 30; ++i) p.in[i] = (const float*)d_in[i];
  p.out = (float*)d_out;
  p.ws = (char*)d_ws;
  hipMemsetAsync((char*)d_ws + BAR_OFF, 0, XCD_BAR_WORDS * 4, stream);
#ifdef MK_MULTI
  for (int ph = 0; ph < 41; ++ph) {
    int lo = ph, hi = ph + 1;
    hipLaunchKernelGGL(mega, dim3(grid_blocks), dim3(256), LDS_BYTES, stream, p, lo, hi);
  }
#else
  int lo = 0, hi = 41;
  void* args[] = {&p, &lo, &hi};
  hipError_t e = hipLaunchCooperativeKernel((void*)mega, dim3(grid_blocks), dim3(256), args, LDS_BYTES, stream);
  if (e != hipSuccess) fprintf(stderr, "cooperative launch failed: %s (grid %d)\n", hipGetErrorString(e), grid_blocks);
#endif
}
```

```cpp
#include <hip/hip_runtime.h>
#include <hip/hip_cooperative_groups.h>
#include <cstdio>
namespace cg = cooperative_groups;

typedef unsigned short u16;
typedef short bf16x8 __attribute__((ext_vector_type(8)));
typedef float f32x16 __attribute__((ext_vector_type(16)));
typedef unsigned u32x4 __attribute__((ext_vector_type(4)));
typedef __bf16 bf2_t __attribute__((ext_vector_type(2)));
typedef float f2_t __attribute__((ext_vector_type(2)));
#define DI __device__ __forceinline__
#define MFMA(a, b, c) __builtin_amdgcn_mfma_f32_32x32x16_bf16((a), (b), (c), 0, 0, 0)

constexpr int T_TOK = 17024;
constexpr int DM = 1024, DFF = 2816, PLD = 6272;
constexpr int NMT = 133;
constexpr int PC_Z = 3072, PC_LX = 4096, PC_LY = 5120, PC_BETA = 6144, PC_ALPHA = 6152;
constexpr int PC_OA = 0, PC_Y = 1024, PC_MRG = 2048;
constexpr int NLT = 536;
constexpr float EPS = 1e-6f;
constexpr int LDS_BYTES = 73744;
constexpr int NITEM = 2240;

constexpr size_t WB_GU1 = 0, WB_DN1 = 5767168, WB_WIN = 8650752, WB_WG = 15073280, WB_BA = 17170432, WB_BB = 18219008,
                 WB_WO = 19267584, WB_GU2 = 20316160, WB_DN2 = 26083328, WB_WR = 28966912, WB_WI = 29097984;
constexpr size_t X_OFF = 0, XB_OFF = 69730304, SSQ_OFF = 104595456, W_OFF = 105684992, P_OFF = 164143104,
                 QD_OFF = 377692160, WW_OFF = 414392320, KD_OFF = 451092480, UT_OFF = 487792640, A_OFF = 524492800,
                 GL_OFF = 542842880, BAR_OFF = 542851840, AG_OFF = 542868224, WS_NEED = 542868224 + 4390912;
constexpr size_t O_YP = 0, O_YS = 16777216, O_PS = 17301504, O_PCQ = 21495808, O_PH = 21790720, O_PCX = 21823488,
                 O_SS = 21921792, O_SCQ = 30310400, O_SH = 30900224, O_SCX = 30965760;

struct Params {
  const float* in[30];
  float* out;
  char* ws;
};

DI unsigned pk2(float a, float b) { f2_t v = {a, b}; bf2_t r = __builtin_convertvector(v, bf2_t); return __builtin_bit_cast(unsigned, r); }
DI u16 f2bf(float x) { __bf16 b = (__bf16)x; return __builtin_bit_cast(u16, b); }
DI float bf2f(u16 v) { return __uint_as_float(((unsigned)v) << 16); }
DI float4 ld_bf4(const u16* p) {
  uint2 v = *(const uint2*)p;
  return make_float4(__uint_as_float(v.x << 16), __uint_as_float(v.x & 0xffff0000u), __uint_as_float(v.y << 16), __uint_as_float(v.y & 0xffff0000u));
}
DI void st_bf4(u16* p, float a, float b, float c, float d) { uint2 v; v.x = pk2(a, b); v.y = pk2(c, d); *(uint2*)p = v; }
DI float sigmoid_(float x) { return 1.f / (1.f + __expf(-x)); }
DI float silu_(float x) { return x / (1.f + __expf(-x)); }
DI float softplus_(float x) { return fmaxf(x, 0.f) + log1pf(__expf(-fabsf(x))); }
DI float gelu_tanh_(float x) { float u = 0.7978845608028654f * (x + 0.044715f * x * x * x); return 0.5f * x * (1.f + tanhf(u)); }
DI int otid() { int t = threadIdx.x; asm volatile("" : "+v"(t)); return t; }
DI int crow(int reg, int h) { return (reg & 3) + 8 * (reg >> 2) + 4 * h; }
DI bf16x8 ldsfrag(const char* base, int off) { return *(const bf16x8*)(base + off); }
DI int sw128(int row, int ch) { return row * 128 + ((ch ^ ((row >> 1) & 7)) << 4); }
DI int sw256(int row, int ch) { return row * 256 + ((ch ^ (row & 15)) << 4); }
template <int S> DI bf16x8 pack8(const f32x16& x) {
  u32x4 u;
  u[0] = pk2(x[8 * S + 0], x[8 * S + 1]); u[1] = pk2(x[8 * S + 2], x[8 * S + 3]);
  u[2] = pk2(x[8 * S + 4], x[8 * S + 5]); u[3] = pk2(x[8 * S + 6], x[8 * S + 7]);
  return __builtin_bit_cast(bf16x8, u);
}
DI void zero16(f32x16& a) {
#pragma unroll
  for (int i = 0; i < 16; ++i) a[i] = 0.f;
}
DI float row_rs(const float* ssq, int row) {
  const float4* q = (const float4*)(ssq + (size_t)row * 16);
  float4 a = q[0], b = q[1], c = q[2], d = q[3];
  float s = (a.x + a.y + a.z + a.w) + (b.x + b.y + b.z + b.w) + (c.x + c.y + c.z + c.w) + (d.x + d.y + d.z + d.w);
  return rsqrtf(s * (1.f / 1024.f) + EPS);
}

typedef __attribute__((address_space(3))) unsigned lds_u32;
DI void stage_tile(const u16* __restrict__ g, int ld, char* lds, int tid) {
#pragma unroll
  for (int i = 0; i < 4; ++i) {
    const int pos = tid + 256 * i, row = pos >> 3, ch = (pos & 7) ^ ((row >> 1) & 7);
    __builtin_amdgcn_global_load_lds((const unsigned*)(g + (size_t)row * ld + ch * 8), (lds_u32*)(lds + pos * 16), 16, 0, 0);
  }
}
DI void gemm_core(const u16* __restrict__ A, int lda, const u16* __restrict__ Bt, int ldb, int K, char* smem, f32x16 (&acc)[2][2]) {
  const int tid = otid(), lane = tid & 63, wid = tid >> 6, wm = wid >> 1, wn = wid & 1;
  const int lr = lane & 31, lh = lane >> 5;
#pragma unroll
  for (int i = 0; i < 2; ++i)
#pragma unroll
    for (int j = 0; j < 2; ++j) zero16(acc[i][j]);
  __syncthreads();
  stage_tile(A, lda, smem, tid);
  stage_tile(Bt, ldb, smem + 16384, tid);
  const int nk = K >> 6;
  for (int kt = 0; kt < nk; ++kt) {
    const char* sa = smem + (kt & 1) * 32768;
    const char* sb = sa + 16384;
    asm volatile("s_waitcnt vmcnt(0)" ::: "memory");
    __syncthreads();
    if (kt + 1 < nk) {
      char* da = smem + ((kt + 1) & 1) * 32768;
      stage_tile(A + (kt + 1) * 64, lda, da, tid);
      stage_tile(Bt + (kt + 1) * 64, ldb, da + 16384, tid);
    }
#pragma unroll
    for (int ks = 0; ks < 4; ++ks) {
      bf16x8 a0 = ldsfrag(sa, sw128(64 * wm + lr, 2 * ks + lh));
      bf16x8 a1 = ldsfrag(sa, sw128(64 * wm + 32 + lr, 2 * ks + lh));
      bf16x8 b0 = ldsfrag(sb, sw128(64 * wn + lr, 2 * ks + lh));
      bf16x8 b1 = ldsfrag(sb, sw128(64 * wn + 32 + lr, 2 * ks + lh));
      acc[0][0] = MFMA(b0, a0, acc[0][0]);
      acc[0][1] = MFMA(b1, a0, acc[0][1]);
      acc[1][0] = MFMA(b0, a1, acc[1][0]);
      acc[1][1] = MFMA(b1, a1, acc[1][1]);
    }
  }
}

DI bool tile_of(int it, int NT, int& mt, int& nt) {
  const int G = gridDim.x, b = blockIdx.x;
  const int rb = ((G & 7) == 0) ? ((b & 7) * (G >> 3) + (b >> 3)) : b;
  const int L = it * G + rb;
  if (L >= NMT * NT) return false;
  const int nig = 8 * NT, gid = L / nig, fm = gid * 8, gsz = (NMT - fm) < 8 ? (NMT - fm) : 8, w = L - gid * nig;
  mt = fm + (w % gsz); nt = w / gsz;
  return true;
}
DI int num_rounds(int NT) { return (NMT * NT + gridDim.x - 1) / gridDim.x; }

enum { EPI_GU = 0, EPI_DOWN = 1, EPI_WIN = 2 };

template <int EPI>
DI void gemm_phase(const Params& p, const u16* A, int lda, const u16* Bt, int ldb, int K, int NT, float f, char* smem) {
  float* x = (float*)(p.ws + X_OFF);
  u16* xb = (u16*)(p.ws + XB_OFF);
  float* ssq = (float*)(p.ws + SSQ_OFF);
  u16* P = (u16*)(p.ws + P_OFF);
  const int tid_ = otid(), lane = tid_ & 63, wid = tid_ >> 6, wm = wid >> 1, wn = wid & 1, lr = lane & 31, lh = lane >> 5;
  const int nr = num_rounds(NT);
  for (int it = 0; it < nr; ++it) {
    int mt, nt;
    if (!tile_of(it, NT, mt, nt)) break;
    f32x16 acc[2][2];
    gemm_core(A + (size_t)(mt * 128) * lda, lda, Bt + (size_t)(nt * 128) * ldb, ldb, K, smem, acc);
#pragma unroll
    for (int mi = 0; mi < 2; ++mi) {
      const int row = mt * 128 + 64 * wm + 32 * mi + lr;
      if (EPI == EPI_GU) {
        const float rs = row_rs(ssq, row);
        u16* hrow = P + (size_t)row * DFF + 32 * (2 * nt + wn) + 4 * lh;
#pragma unroll
        for (int b = 0; b < 4; ++b) {
          float hv[4];
#pragma unroll
          for (int r = 0; r < 4; ++r) { float g = acc[mi][0][4 * b + r] * rs, u = acc[mi][1][4 * b + r] * rs; hv[r] = silu_(g) * u; }
          st_bf4(hrow + 8 * b, hv[0], hv[1], hv[2], hv[3]);
        }
      } else if (EPI == EPI_WIN) {
        const float rs = row_rs(ssq, row);
#pragma unroll
        for (int ni = 0; ni < 2; ++ni)
#pragma unroll
          for (int b = 0; b < 4; ++b) {
            const int col = nt * 128 + 64 * wn + 32 * ni + 8 * b + 4 * lh;
            st_bf4(P + (size_t)row * PLD + col, acc[mi][ni][4 * b] * rs, acc[mi][ni][4 * b + 1] * rs, acc[mi][ni][4 * b + 2] * rs, acc[mi][ni][4 * b + 3] * rs);
          }
      } else {
        float ss = 0.f;
        float4 xo[2][4];
#pragma unroll
        for (int ni = 0; ni < 2; ++ni)
#pragma unroll
          for (int b = 0; b < 4; ++b) xo[ni][b] = *(const float4*)(x + (size_t)row * DM + nt * 128 + 64 * wn + 32 * ni + 8 * b + 4 * lh);
#pragma unroll
        for (int ni = 0; ni < 2; ++ni)
#pragma unroll
          for (int b = 0; b < 4; ++b) {
            const int col = nt * 128 + 64 * wn + 32 * ni + 8 * b + 4 * lh;
            float4 v = xo[ni][b];
            v.x += f * acc[mi][ni][4 * b]; v.y += f * acc[mi][ni][4 * b + 1]; v.z += f * acc[mi][ni][4 * b + 2]; v.w += f * acc[mi][ni][4 * b + 3];
            *(float4*)(x + (size_t)row * DM + col) = v;
            st_bf4(xb + (size_t)row * DM + col, v.x, v.y, v.z, v.w);
            ss += v.x * v.x + v.y * v.y + v.z * v.z + v.w * v.w;
          }
        ss += __shfl_xor(ss, 32);
        if (lh == 0) ssq[(size_t)row * 16 + 2 * nt + wn] = ss;
      }
    }
  }
}

DI void merge_phase(const Params& p, char* smem) {
  const u16* xb = (const u16*)(p.ws + XB_OFF);
  const float* ssq = (const float*)(p.ws + SSQ_OFF);
  u16* P = (u16*)(p.ws + P_OFF);
  const u16* W = (const u16*)(p.ws + W_OFF);
  const int tid_ = otid(), lane = tid_ & 63, wid = tid_ >> 6, wm = wid >> 1, wn = wid & 1, lr = lane & 31, lh = lane >> 5;
  const int nr = num_rounds(8);
  for (int it = 0; it < nr; ++it) {
    int mt, nt;
    if (!tile_of(it, 8, mt, nt)) break;
    for (int pass = 0; pass < 2; ++pass) {
      f32x16 acc[2][2];
      unsigned Gp[2][2][8];
      gemm_core(xb + (size_t)(mt * 128) * DM, DM, W + WB_WG + (size_t)(pass * 1024 + nt * 128) * DM, DM, DM, smem, acc);
#pragma unroll
      for (int mi = 0; mi < 2; ++mi) {
        const float rs = row_rs(ssq, mt * 128 + 64 * wm + 32 * mi + lr);
#pragma unroll
        for (int ni = 0; ni < 2; ++ni)
#pragma unroll
          for (int r = 0; r < 8; ++r) Gp[mi][ni][r] = pk2(sigmoid_(acc[mi][ni][2 * r] * rs), sigmoid_(acc[mi][ni][2 * r + 1] * rs));
      }
      gemm_core(P + (size_t)(mt * 128) * PLD + (pass ? PC_Y : PC_OA), PLD, W + (pass ? WB_BB : WB_BA) + (size_t)(nt * 128) * DM, DM, DM, smem, acc);
#pragma unroll
      for (int mi = 0; mi < 2; ++mi) {
        const int row = mt * 128 + 64 * wm + 32 * mi + lr;
        float4 prev[2][4];
#pragma unroll
        for (int ni = 0; ni < 2; ++ni)
#pragma unroll
          for (int b = 0; b < 4; ++b) {
            prev[ni][b] = make_float4(0.f, 0.f, 0.f, 0.f);
            if (pass) prev[ni][b] = ld_bf4(P + (size_t)row * PLD + PC_MRG + nt * 128 + 64 * wn + 32 * ni + 8 * b + 4 * lh);
          }
#pragma unroll
        for (int ni = 0; ni < 2; ++ni)
#pragma unroll
          for (int b = 0; b < 4; ++b) {
            u16* op = P + (size_t)row * PLD + PC_MRG + nt * 128 + 64 * wn + 32 * ni + 8 * b + 4 * lh;
            const unsigned g0 = Gp[mi][ni][2 * b], g1 = Gp[mi][ni][2 * b + 1];
            st_bf4(op, prev[ni][b].x + __uint_as_float(g0 << 16) * acc[mi][ni][4 * b], prev[ni][b].y + __uint_as_float(g0 & 0xffff0000u) * acc[mi][ni][4 * b + 1],
                   prev[ni][b].z + __uint_as_float(g1 << 16) * acc[mi][ni][4 * b + 2], prev[ni][b].w + __uint_as_float(g1 & 0xffff0000u) * acc[mi][ni][4 * b + 3]);
          }
      }
    }
  }
}

DI void wconv_tile(const Params& p, int l, int t, char* smem) {
  u16* W = (u16*)(p.ws + W_OFF);
  const float* src; const float* fold = nullptr; int ld, K, map = 0; u16* dst; int tn, tk;
  if (t < 7072) {
    int ntk;
    if (t < 1408) { src = p.in[8] + (size_t)l * 1024 * 5632; ld = 5632; K = 1024; fold = p.in[7] + l * 1024; map = 1; dst = W + WB_GU1; }
    else if (t < 2112) { t -= 1408; src = p.in[9] + (size_t)l * 2816 * 1024; ld = 1024; K = 2816; dst = W + WB_DN1; }
    else if (t < 3680) { t -= 2112; src = p.in[11] + (size_t)l * 1024 * 8208; ld = 8208; K = 1024; fold = p.in[10] + l * 1024; map = 2; dst = W + WB_WIN; }
    else if (t < 4192) { t -= 3680; src = p.in[11] + (size_t)l * 1024 * 8208 + 6160; ld = 8208; K = 1024; fold = p.in[10] + l * 1024; dst = W + WB_WG; }
    else if (t < 4448) { t -= 4192; src = p.in[23] + (size_t)l * 1048576; ld = 1024; K = 1024; dst = W + WB_BA; }
    else if (t < 4704) { t -= 4448; src = p.in[24] + (size_t)l * 1048576; ld = 1024; K = 1024; dst = W + WB_BB; }
    else if (t < 4960) { t -= 4704; src = p.in[25] + (size_t)l * 1048576; ld = 1024; K = 1024; dst = W + WB_WO; }
    else if (t < 6368) { t -= 4960; src = p.in[27] + (size_t)l * 1024 * 5632; ld = 5632; K = 1024; fold = p.in[26] + l * 1024; map = 1; dst = W + WB_GU2; }
    else { t -= 6368; src = p.in[28] + (size_t)l * 2816 * 1024; ld = 1024; K = 2816; dst = W + WB_DN2; }
    ntk = K >> 6; tn = t / ntk; tk = t - tn * ntk;
  } else {
    t -= 7072;
    const int mat = t >> 5, n = (t >> 2) & 7;
    src = p.in[mat ? 20 : 18] + (size_t)l * 131072 + n * 16384; ld = 128; K = 128;
    dst = W + (mat ? WB_WI : WB_WR) + n * 16384; tn = (t >> 1) & 1; tk = t & 1;
  }
  u16* tl = (u16*)smem;
  const int tid = otid(), nl = tid & 63, kl = tid >> 6;
  const int np = tn * 64 + nl;
  int sc = np;
  if (map == 1) sc = ((np >> 5) & 1) * 2816 + 32 * (np >> 6) + (np & 31);
  else if (map == 2) sc = np < 4096 ? np : (np < 6144 ? np + 16 : (np < 6152 ? 4096 + (np - 6144) : (np < 6160 ? 4104 + (np - 6152) : -1)));
  __syncthreads();
#pragma unroll
  for (int i = 0; i < 16; ++i) {
    const int k = tk * 64 + kl + 4 * i;
    float v = 0.f;
    if (sc >= 0) { v = src[(size_t)k * ld + sc]; if (fold) v *= fold[k]; }
    tl[nl * 66 + kl + 4 * i] = f2bf(v);
  }
  __syncthreads();
  const int n = tid >> 2, kq = tid & 3;
  const unsigned* rp = (const unsigned*)(tl + n * 66 + 16 * kq);
  uint4 o0, o1;
  o0.x = rp[0]; o0.y = rp[1]; o0.z = rp[2]; o0.w = rp[3]; o1.x = rp[4]; o1.y = rp[5]; o1.z = rp[6]; o1.w = rp[7];
  uint4* dp = (uint4*)(dst + (size_t)(tn * 64 + n) * K + tk * 64 + 16 * kq);
  dp[0] = o0; dp[1] = o1;
}

DI void gather_item(const Params& p, int item, char* smem) {
  float* x = (float*)(p.ws + X_OFF);
  u16* xb = (u16*)(p.ws + XB_OFF);
  float* ssq = (float*)(p.ws + SSQ_OFF);
  float* red = (float*)smem;
  const int tid = otid();
  for (int rr = 0; rr < 8; ++rr) {
    const int row = item * 8 + rr;
    const float* src;
    if (row < 16512) { const int s = row / 2064, pos = row - s * 2064; src = pos < 16 ? p.in[6] + pos * 1024 : p.in[0] + ((size_t)s * 2048 + (pos - 16)) * 1024; }
    else src = p.in[1] + (size_t)(row - 16512) * 1024;
    float4 v = ((const float4*)src)[tid];
    ((float4*)(x + (size_t)row * DM))[tid] = v;
    st_bf4(xb + (size_t)row * DM + 4 * tid, v.x, v.y, v.z, v.w);
    float ss = v.x * v.x + v.y * v.y + v.z * v.z + v.w * v.w;
#pragma unroll
    for (int o = 32; o > 0; o >>= 1) ss += __shfl_xor(ss, o);
    __syncthreads();
    if ((tid & 63) == 0) red[tid >> 6] = ss;
    __syncthreads();
    if (tid < 16) ssq[(size_t)row * 16 + tid] = (tid == 0) ? (red[0] + red[1] + red[2] + red[3]) : 0.f;
  }
}

DI void final_phase(const Params& p) {
  const float* x = (const float*)(p.ws + X_OFF);
  const float* ssq = (const float*)(p.ws + SSQ_OFF);
  const int tid = otid();
  const float4 fw = ((const float4*)p.in[29])[tid];
  for (int row = blockIdx.x; row < T_TOK; row += gridDim.x) {
    float* dst;
    if (row < 16512) { const int s = row / 2064, pos = row - s * 2064; if (pos < 16) continue; dst = p.out + O_YP + ((size_t)s * 2048 + (pos - 16)) * 1024; }
    else dst = p.out + O_YS + (size_t)(row - 16512) * 1024;
    const float rs = row_rs(ssq, row);
    float4 v = ((const float4*)(x + (size_t)row * DM))[tid];
    v.x *= rs * fw.x; v.y *= rs * fw.y; v.z *= rs * fw.z; v.w *= rs * fw.w;
    ((float4*)dst)[tid] = v;
  }
}

struct CI { int r0, nv, sbase, stream, last, sample; };
DI CI chunk_info(int ci) {
  CI c;
  if (ci < 264) {
    const int s = ci / 33, k = ci - s * 33;
    c.stream = s; c.sbase = s * 2064; c.sample = 0;
    if (k == 0) { c.r0 = c.sbase; c.nv = 16; } else { c.r0 = c.sbase + 16 + 64 * (k - 1); c.nv = 64; }
    c.last = (k == 32);
  } else {
    const int s = ci - 264;
    c.stream = 8 + s; c.sbase = 16512 + 32 * s; c.r0 = c.sbase; c.nv = 32; c.last = 1; c.sample = 1;
  }
  return c;
}

DI void dconv_store(const Params& p, int l, const CI& c, int cc, int ch, int half, char* RM, char* RT, float* cqo) {
  const u16* P = (const u16*)(p.ws + P_OFF);
  const float* cwp = p.in[12] + (size_t)l * 4 * 3072 + cc;
  const float w0 = cwp[0], w1 = cwp[3072], w2 = cwp[2 * 3072], w3 = cwp[3 * 3072];
  const int pad = 64 - c.nv, t0 = 32 * half;
  float r[35];
  const int rowb = c.r0 + t0 - 3 - pad;
#pragma unroll
  for (int i = 0; i < 35; ++i) {
    int rowu = rowb + i;
    rowu = rowu < c.sbase ? c.sbase : rowu;
    r[i] = bf2f(P[(unsigned)rowu * (unsigned)PLD + (unsigned)cc]);
  }
  float hist[3] = {0.f, 0.f, 0.f};
  if (c.sample) {
#pragma unroll
    for (int j = 0; j < 3; ++j) hist[j] = p.in[3][((size_t)(l * 16 + (c.stream - 8)) * 3 + j) * 3072 + cc];
  }
#pragma unroll
  for (int i = 0; i < 35; ++i) {
    const int u = t0 - 3 + i, rowu = rowb + i;
    if (u < pad - 3) r[i] = 0.f;
    else if (rowu < c.sbase) { const int j = 3 + rowu - c.sbase; r[i] = (j == 0) ? hist[0] : (j == 1 ? hist[1] : hist[2]); }
  }
#pragma unroll
  for (int q = 0; q < 4; ++q) {
    const int tq = t0 + 8 * q;
    float o[8];
#pragma unroll
    for (int i = 0; i < 8; ++i) {
      const float sv = r[8 * q + i] * w0 + r[8 * q + i + 1] * w1 + r[8 * q + i + 2] * w2 + r[8 * q + i + 3] * w3;
      o[i] = (tq + i >= pad) ? silu_(sv) : 0.f;
    }
    if (RM) {
#pragma unroll
      for (int i = 0; i < 8; ++i) *(u16*)(RM + sw256(tq + i, ch >> 3) + (ch & 7) * 2) = f2bf(o[i]);
    }
    if (RT) {
      u32x4 v; v[0] = pk2(o[0], o[1]); v[1] = pk2(o[2], o[3]); v[2] = pk2(o[4], o[5]); v[3] = pk2(o[6], o[7]);
      *(u32x4*)(RT + sw128(ch, 4 * half + q)) = v;
    }
  }
  if (half && c.last) { cqo[cc] = r[32]; cqo[3072 + cc] = r[33]; cqo[6144 + cc] = r[34]; }
}

DI void delta_pre_item(const Params& p, int l, int it, char* smem) {
  const int ci = it >> 3, h = it & 7;
  const CI c = chunk_info(ci);
  const u16* P = (const u16*)(p.ws + P_OFF);
  char* R0 = smem; char* R1 = smem + 16384; char* R2 = smem + 32768; float* Lm = (float*)(smem + 49152);
  float* sBeta = (float*)(smem + 65536); float* sGc = sBeta + 64; float* sNk = sBeta + 128; float* sNq = sBeta + 192;
  const int tid = otid(), lane = tid & 63, wid = tid >> 6, lr = lane & 31, lh = lane >> 5;
  const int ch = tid & 127, half = tid >> 7, t0 = 32 * half;
  const int pad = 64 - c.nv;
  float* cqo = p.out + (c.sample ? O_SCQ + ((size_t)(l * 16 + (c.stream - 8)) * 3) * 3072 : O_PCQ + ((size_t)(l * 8 + c.stream) * 3) * 3072);
  __syncthreads();
  dconv_store(p, l, c, h * 128 + ch, ch, half, R0, nullptr, cqo);
  dconv_store(p, l, c, 1024 + h * 128 + ch, ch, half, R1, R2, cqo);
  if (tid < 64) {
    float beta = 0.f, g = 0.f;
    if (tid >= pad) {
      const size_t row = (size_t)(c.r0 + tid - pad);
      beta = sigmoid_(bf2f(P[row * PLD + PC_BETA + h]));
      g = -__expf(p.in[13][l * 8 + h]) * softplus_(bf2f(P[row * PLD + PC_ALPHA + h]) + p.in[14][l * 8 + h]);
    }
#pragma unroll
    for (int o = 1; o < 64; o <<= 1) { const float v = __shfl_up(g, o); if (lane >= o) g += v; }
    sBeta[tid] = beta; sGc[tid] = g;
  }
  __syncthreads();
  const int ti = wid >> 1, tj = wid & 1;
  f32x16 aQK, aKK, aQQ;
  zero16(aQK); zero16(aKK); zero16(aQQ);
#pragma unroll
  for (int ks = 0; ks < 8; ++ks) {
    const bf16x8 kf = ldsfrag(R1, sw256(32 * tj + lr, 2 * ks + lh));
    const bf16x8 qf = ldsfrag(R0, sw256(32 * ti + lr, 2 * ks + lh));
    const bf16x8 kif = ldsfrag(R1, sw256(32 * ti + lr, 2 * ks + lh));
    aQK = MFMA(kf, qf, aQK);
    aKK = MFMA(kf, kif, aKK);
    if (ti == tj) aQQ = MFMA(qf, qf, aQQ);
  }
  if (ti == tj && (((lr >> 2) & 1) == lh)) {
    float vk = 0.f, vq = 0.f;
#pragma unroll
    for (int reg = 0; reg < 16; ++reg) if (crow(reg, lh) == lr) { vk = aKK[reg]; vq = aQQ[reg]; }
    sNk[32 * ti + lr] = vk; sNq[32 * ti + lr] = vq;
  }
  __syncthreads();
  const size_t itb = (size_t)it;
  {
    u16* Ag = (u16*)(p.ws + A_OFF) + itb * 4096;
    const int i = 32 * ti + lr;
    const float gi = sGc[i], rqi = rsqrtf(sNq[i] + EPS) * 0.08838834764831845f, bki = sBeta[i] * rsqrtf(sNk[i] + EPS);
#pragma unroll
    for (int b = 0; b < 4; ++b) {
      float av[4], lv[4];
#pragma unroll
      for (int r = 0; r < 4; ++r) {
        const int j = 32 * tj + 8 * b + 4 * lh + r;
        const float rkj = rsqrtf(sNk[j] + EPS);
        const float dec = (j <= i) ? __expf(gi - sGc[j]) : 0.f;
        av[r] = rqi * rkj * aQK[4 * b + r] * dec;
        lv[r] = (j < i) ? bki * rkj * aKK[4 * b + r] * dec : 0.f;
      }
      st_bf4(Ag + i * 64 + 16 * (2 * tj + (b >> 1)) + 8 * lh + 4 * (b & 1), av[0], av[1], av[2], av[3]);
      *(float4*)(Lm + i * 64 + 32 * tj + 8 * b + 4 * lh) = make_float4(lv[0], lv[1], lv[2], lv[3]);
      if (wid == 2) st_bf4((u16*)(smem + 66560) + lr * 32 + 8 * b + 4 * lh, lv[0], lv[1], lv[2], lv[3]);
    }
    u16* Qg = (u16*)(p.ws + QD_OFF) + itb * 8192;
    u16* Kg = (u16*)(p.ws + KD_OFF) + itb * 8192;
    const float glc = sGc[63];
#pragma unroll
    for (int ii = 0; ii < 4; ++ii) {
      const int q = tid + 256 * ii;
      {
        const int t = q >> 4, chn = q & 15, s = chn >> 1, hh = chn & 1;
        const float sc = rsqrtf(sNq[t] + EPS) * 0.08838834764831845f * __expf(sGc[t]);
        const int c0 = 16 * s + 4 * hh, c1 = c0 + 8;
        const float4 v0 = ld_bf4((const u16*)(R0 + sw256(t, c0 >> 3) + (c0 & 7) * 2));
        const float4 v1 = ld_bf4((const u16*)(R0 + sw256(t, c1 >> 3) + (c1 & 7) * 2));
        uint4 o; o.x = pk2(v0.x * sc, v0.y * sc); o.y = pk2(v0.z * sc, v0.w * sc); o.z = pk2(v1.x * sc, v1.y * sc); o.w = pk2(v1.z * sc, v1.w * sc);
        *(uint4*)(Qg + t * 128 + 8 * chn) = o;
      }
      {
        const int dk = q >> 3, chn = q & 7, s = chn >> 1, hh = chn & 1;
        const int ta = 16 * s + 4 * hh, tb = ta + 8;
        const float4 v0 = ld_bf4((const u16*)(R2 + sw128(dk, ta >> 3) + (ta & 7) * 2));
        const float4 v1 = ld_bf4((const u16*)(R2 + sw128(dk, tb >> 3) + (tb & 7) * 2));
        float sa[4], sb[4];
#pragma unroll
        for (int r = 0; r < 4; ++r) { sa[r] = rsqrtf(sNk[ta + r] + EPS) * __expf(glc - sGc[ta + r]); sb[r] = rsqrtf(sNk[tb + r] + EPS) * __expf(glc - sGc[tb + r]); }
        uint4 o; o.x = pk2(v0.x * sa[0], v0.y * sa[1]); o.y = pk2(v0.z * sa[2], v0.w * sa[3]); o.z = pk2(v1.x * sb[0], v1.y * sb[1]); o.w = pk2(v1.z * sb[2], v1.w * sb[3]);
        *(uint4*)(Kg + dk * 64 + 8 * chn) = o;
      }
    }
    if (tid == 0) ((float*)(p.ws + GL_OFF))[it] = __expf(glc);
  }
  __syncthreads();
  dconv_store(p, l, c, 2048 + h * 128 + ch, ch, half, nullptr, R0, cqo);
  {
    u16* L21b = (u16*)(smem + 66560); u16* T11t = (u16*)(smem + 68608); u16* T22b = (u16*)(smem + 70656);
    if (wid < 2) {
      const int blk = wid, cc = 32 * blk + lr;
      float tc[32];
#pragma unroll
      for (int i = 0; i < 32; ++i) tc[i] = 0.f;
#pragma unroll
      for (int i = 0; i < 32; ++i) {
        float sacc = (i == lr) ? 1.f : 0.f;
#pragma unroll
        for (int j4 = 0; j4 < i; j4 += 4) {
          const float4 lv = *(const float4*)(Lm + (32 * blk + i) * 64 + 32 * blk + j4);
          sacc -= lv.x * tc[j4]; sacc -= lv.y * tc[j4 + 1]; sacc -= lv.z * tc[j4 + 2]; sacc -= lv.w * tc[j4 + 3];
        }
        tc[i] = sacc;
      }
      if (lh == 0) {
        const float b1 = sBeta[cc], c1 = b1 * rsqrtf(sNk[cc] + EPS) * __expf(sGc[cc]);
#pragma unroll
        for (int i = 0; i < 32; ++i) {
          const int off = sw128(32 * blk + i, cc >> 3) + (cc & 7) * 2;
          *(u16*)(R1 + off) = f2bf(tc[i] * c1);
          *(u16*)(R1 + 8192 + off) = f2bf(tc[i] * b1);
        }
        if (blk == 0) {
#pragma unroll
          for (int q = 0; q < 4; ++q) {
            u32x4 v; v[0] = pk2(tc[8 * q], tc[8 * q + 1]); v[1] = pk2(tc[8 * q + 2], tc[8 * q + 3]); v[2] = pk2(tc[8 * q + 4], tc[8 * q + 5]); v[3] = pk2(tc[8 * q + 6], tc[8 * q + 7]);
            *(u32x4*)(T11t + lr * 32 + 8 * q) = v;
          }
        } else {
#pragma unroll
          for (int i = 0; i < 32; ++i) T22b[i * 32 + lr] = f2bf(tc[i]);
        }
      }
    } else {
#pragma unroll
      for (int i = 0; i < 2; ++i) {
        const int idx = (tid - 128) + 128 * i, mat = idx >> 7, rc = idx & 127;
        u32x4 z; z[0] = 0u; z[1] = 0u; z[2] = 0u; z[3] = 0u;
        *(u32x4*)(R1 + mat * 8192 + sw128(rc >> 2, 4 + (rc & 3))) = z;
      }
    }
    __syncthreads();
    if (wid == 0) {
      f32x16 Mx, D2;
      zero16(Mx); zero16(D2);
#pragma unroll
      for (int ks = 0; ks < 2; ++ks) {
        const bf16x8 xf = *(const bf16x8*)(L21b + lr * 32 + (2 * ks + lh) * 8);
        const bf16x8 yf = *(const bf16x8*)(T11t + lr * 32 + (2 * ks + lh) * 8);
        Mx = MFMA(xf, yf, Mx);
      }
#pragma unroll
      for (int sx = 0; sx < 2; ++sx) {
        const bf16x8 yp = sx ? pack8<1>(Mx) : pack8<0>(Mx);
        const uint2 lo = *(const uint2*)(T22b + lr * 32 + 16 * sx + 4 * lh);
        const uint2 hi = *(const uint2*)(T22b + lr * 32 + 16 * sx + 8 + 4 * lh);
        u32x4 xv; xv[0] = lo.x; xv[1] = lo.y; xv[2] = hi.x; xv[3] = hi.y;
        D2 = MFMA(__builtin_bit_cast(bf16x8, xv), yp, D2);
      }
      const float b1 = sBeta[lr], c1 = b1 * rsqrtf(sNk[lr] + EPS) * __expf(sGc[lr]);
#pragma unroll
      for (int r = 0; r < 16; ++r) {
        const int off = sw128(32 + crow(r, lh), lr >> 3) + (lr & 7) * 2;
        *(u16*)(R1 + off) = f2bf(-D2[r] * c1);
        *(u16*)(R1 + 8192 + off) = f2bf(-D2[r] * b1);
      }
    }
  }
  __syncthreads();
  {
    u16* Wg = (u16*)(p.ws + WW_OFF) + itb * 8192;
    u16* Ug = (u16*)(p.ws + UT_OFF) + itb * 8192;
    f32x16 aw[2], au[2];
    zero16(aw[0]); zero16(aw[1]); zero16(au[0]); zero16(au[1]);
#pragma unroll
    for (int ks = 0; ks < 4; ++ks) {
      const bf16x8 kT = ldsfrag(R2, sw128(32 * wid + lr, 2 * ks + lh));
      const bf16x8 vT = ldsfrag(R0, sw128(32 * wid + lr, 2 * ks + lh));
#pragma unroll
      for (int bb = 0; bb < 2; ++bb) {
        const bf16x8 t1 = ldsfrag(R1, sw128(32 * bb + lr, 2 * ks + lh));
        const bf16x8 t2 = ldsfrag(R1 + 8192, sw128(32 * bb + lr, 2 * ks + lh));
        aw[bb] = MFMA(kT, t1, aw[bb]);
        au[bb] = MFMA(t2, vT, au[bb]);
      }
    }
#pragma unroll
    for (int bb = 0; bb < 2; ++bb)
#pragma unroll
      for (int b = 0; b < 4; ++b) {
        st_bf4(Wg + (32 * bb + lr) * 128 + 32 * wid + 16 * (b >> 1) + 8 * lh + 4 * (b & 1), aw[bb][4 * b], aw[bb][4 * b + 1], aw[bb][4 * b + 2], aw[bb][4 * b + 3]);
        st_bf4(Ug + (32 * wid + lr) * 64 + 32 * bb + 8 * b + 4 * lh, au[bb][4 * b], au[bb][4 * b + 1], au[bb][4 * b + 2], au[bb][4 * b + 3]);
      }
  }
}

DI void delta_seq_item(const Params& p, int l, int item, char* smem) {
  const int stream = item >> 3, h = item & 7;
  const int tid = otid(), lane = tid & 63, wid = tid >> 6, lr = lane & 31, lh = lane >> 5;
  const int dv = 32 * wid + lr;
  u16* P = (u16*)(p.ws + P_OFF);
  f32x16 S[4];
  float* Sout;
  int nchunk, ci0;
  if (stream < 8) {
#pragma unroll
    for (int m = 0; m < 4; ++m) zero16(S[m]);
    Sout = p.out + O_PS + ((size_t)(l * 8 + stream) * 8 + h) * 16384;
    nchunk = 33; ci0 = stream * 33;
  } else {
    const float* S0 = p.in[2] + ((size_t)(l * 16 + (stream - 8)) * 8 + h) * 16384;
    const float* sp = S0 + (4 * lh) * 128 + dv;
#pragma unroll
    for (int m = 0; m < 4; ++m)
#pragma unroll
      for (int b = 0; b < 4; ++b) {
#pragma unroll
        for (int r = 0; r < 4; ++r) S[m][4 * b + r] = sp[r * 128];
        sp += 8 * 128;
        __builtin_amdgcn_sched_barrier(0);
      }
    Sout = p.out + O_SS + ((size_t)(l * 16 + (stream - 8)) * 8 + h) * 16384;
    nchunk = 1; ci0 = 264 + (stream - 8);
  }
  for (int k = 0; k < nchunk; ++k) {
    const int ci = ci0 + k;
    const CI c = chunk_info(ci);
    const size_t it = (size_t)ci * 8 + h;
    const u16* Wg = (const u16*)(p.ws + WW_OFF) + it * 8192;
    const u16* Qg = (const u16*)(p.ws + QD_OFF) + it * 8192;
    const u16* Kg = (const u16*)(p.ws + KD_OFF) + it * 8192;
    const u16* Ag = (const u16*)(p.ws + A_OFF) + it * 4096;
    const u16* Ug = (const u16*)(p.ws + UT_OFF) + it * 8192;
    const float gl = ((const float*)(p.ws + GL_OFF))[it];
    __syncthreads();
#pragma unroll
    for (int ii = 0; ii < 4; ++ii) {
      const int q = tid + 256 * ii;
      *(uint4*)(smem + sw256(q >> 4, q & 15)) = *(const uint4*)(Wg + q * 8);
      *(uint4*)(smem + 16384 + sw256(q >> 4, q & 15)) = *(const uint4*)(Qg + q * 8);
      *(uint4*)(smem + 32768 + sw128(q >> 3, q & 7)) = *(const uint4*)(Kg + q * 8);
    }
#pragma unroll
    for (int ii = 0; ii < 2; ++ii) {
      const int q = tid + 256 * ii;
      *(uint4*)(smem + 49152 + sw128(q >> 3, q & 7)) = *(const uint4*)(Ag + q * 8);
    }
    float4 uv[2][4];
#pragma unroll
    for (int m = 0; m < 2; ++m)
#pragma unroll
      for (int b = 0; b < 4; ++b) uv[m][b] = ld_bf4(Ug + dv * 64 + 32 * m + 8 * b + 4 * lh);
    __syncthreads();
    f32x16 M1[2], M2[2];
    zero16(M1[0]); zero16(M1[1]); zero16(M2[0]); zero16(M2[1]);
#pragma unroll
    for (int mt = 0; mt < 4; ++mt) {
#pragma unroll
      for (int s = 0; s < 2; ++s) {
        const int ks = 2 * mt + s;
        const bf16x8 Sp = s ? pack8<1>(S[mt]) : pack8<0>(S[mt]);
#pragma unroll
        for (int m = 0; m < 2; ++m) {
          const bf16x8 wf = ldsfrag(smem, sw256(32 * m + lr, 2 * ks + lh));
          const bf16x8 qf = ldsfrag(smem + 16384, sw256(32 * m + lr, 2 * ks + lh));
          M1[m] = MFMA(wf, Sp, M1[m]);
          M2[m] = MFMA(qf, Sp, M2[m]);
        }
      }
    }
#pragma unroll
    for (int m = 0; m < 2; ++m)
#pragma unroll
      for (int b = 0; b < 4; ++b) {
        M1[m][4 * b] = uv[m][b].x - M1[m][4 * b]; M1[m][4 * b + 1] = uv[m][b].y - M1[m][4 * b + 1];
        M1[m][4 * b + 2] = uv[m][b].z - M1[m][4 * b + 2]; M1[m][4 * b + 3] = uv[m][b].w - M1[m][4 * b + 3];
      }
    bf16x8 Vp[4];
    Vp[0] = pack8<0>(M1[0]); Vp[1] = pack8<1>(M1[0]); Vp[2] = pack8<0>(M1[1]); Vp[3] = pack8<1>(M1[1]);
#pragma unroll
    for (int m = 0; m < 2; ++m)
#pragma unroll
      for (int kk = 0; kk < 4; ++kk) {
        const bf16x8 af = ldsfrag(smem + 49152, sw128(32 * m + lr, 2 * kk + lh));
        M2[m] = MFMA(af, Vp[kk], M2[m]);
      }
#pragma unroll
    for (int mt = 0; mt < 4; ++mt) {
#pragma unroll
      for (int r = 0; r < 16; ++r) S[mt][r] *= gl;
#pragma unroll
      for (int kk = 0; kk < 4; ++kk) {
        const bf16x8 kf = ldsfrag(smem + 32768, sw128(32 * mt + lr, 2 * kk + lh));
        S[mt] = MFMA(kf, Vp[kk], S[mt]);
      }
    }
    const int et = tid >> 2, eq = tid & 3, epad = 64 - c.nv;
    const bool erow = (et >= epad);
    const size_t erow_off = (size_t)(c.r0 + (erow ? et - epad : 0)) * PLD + h * 128 + 32 * eq;
    uint2 zr[8];
#pragma unroll
    for (int i = 0; i < 8; ++i) zr[i] = *(const uint2*)(P + erow_off + PC_Z + 4 * i);
    __syncthreads();
    float* ot = (float*)smem;
#pragma unroll
    for (int m = 0; m < 2; ++m)
#pragma unroll
      for (int r = 0; r < 16; ++r) ot[(32 * m + crow(r, lh)) * 128 + dv] = M2[m][r];
    __syncthreads();
    {
      float4 v[8];
      float ss = 0.f;
#pragma unroll
      for (int i = 0; i < 8; ++i) { v[i] = *(const float4*)(ot + et * 128 + 32 * eq + 4 * i); ss += v[i].x * v[i].x + v[i].y * v[i].y + v[i].z * v[i].z + v[i].w * v[i].w; }
      ss += __shfl_xor(ss, 1); ss += __shfl_xor(ss, 2);
      const float rs = rsqrtf(ss * (1.f / 128.f) + EPS);
      if (erow) {
        u16* op = P + erow_off + PC_OA;
        const float* nw = p.in[15] + l * 128 + 32 * eq;
#pragma unroll
        for (int i = 0; i < 8; ++i) {
          const float zx = __uint_as_float(zr[i].x << 16), zy = __uint_as_float(zr[i].x & 0xffff0000u), zz = __uint_as_float(zr[i].y << 16), zw = __uint_as_float(zr[i].y & 0xffff0000u);
          const float4 w4 = *(const float4*)(nw + 4 * i);
          st_bf4(op + 4 * i, v[i].x * rs * w4.x * silu_(zx), v[i].y * rs * w4.y * silu_(zy), v[i].z * rs * w4.z * silu_(zz), v[i].w * rs * w4.w * silu_(zw));
        }
      }
    }
  }
  float* so = Sout + (4 * lh) * 128 + dv;
#pragma unroll
  for (int m = 0; m < 4; ++m)
#pragma unroll
    for (int b = 0; b < 4; ++b) {
#pragma unroll
      for (int r = 0; r < 4; ++r) so[r * 128] = S[m][4 * b + r];
      so += 8 * 128;
      __builtin_amdgcn_sched_barrier(0);
    }
}

struct LT { int r0, nv, first, last, stream; };
DI LT lru_tile(int tl) {
  LT t;
  if (tl < 520) { const int s = tl / 65, j = tl - s * 65; t.stream = s; t.first = (j == 0); t.last = (j == 64); t.nv = j ? 32 : 16; t.r0 = s * 2064 + (j ? 16 + 32 * (j - 1) : 0); }
  else { const int s = tl - 520; t.stream = 8 + s; t.first = 1; t.last = 1; t.nv = 32; t.r0 = 16512 + 32 * s; }
  return t;
}
DI void lru_a_item(const Params& p, int l, int item, char* smem) {
  const int tl = item >> 3, n = item & 7;
  const LT T = lru_tile(tl);
  const int tid = otid(), lane = tid & 63, wid = tid >> 6, lr = lane & 31, lh = lane >> 5;
  u16* P = (u16*)(p.ws + P_OFF);
  u16* Ya = (u16*)(p.out + O_YP);
  const u16* W = (const u16*)(p.ws + W_OFF);
  float* AG = (float*)(p.ws + AG_OFF);
  float* raw = (float*)smem; float* xc = (float*)(smem + 18432); char* xcb = smem + 34816;
  const int ch = tid & 127, rp = tid >> 7;
  const int gc = n * 128 + ch;
  const int d = 32 * wid + lr, gd = n * 128 + d;
  float lyv[16];
#pragma unroll
  for (int r = 0; r < 16; ++r) { const int t = crow(r, lh); lyv[r] = (t < T.nv) ? bf2f(P[(size_t)(T.r0 + t) * PLD + PC_LY + gd]) : 0.f; }
  bf16x8 wrf[8], wif[8];
#pragma unroll
  for (int ks = 0; ks < 8; ++ks) {
    wrf[ks] = *(const bf16x8*)(W + WB_WR + n * 16384 + d * 128 + (2 * ks + lh) * 8);
    wif[ks] = *(const bf16x8*)(W + WB_WI + n * 16384 + d * 128 + (2 * ks + lh) * 8);
  }
  const float* cwp = p.in[16] + (size_t)l * 4 * 1024 + gc;
  const float cw0 = cwp[0], cw1 = cwp[1024], cw2 = cwp[2048], cw3 = cwp[3072], cb = p.in[17][l * 1024 + gc];
  const float br = p.in[19][l * 1024 + gd], bi = p.in[21][l * 1024 + gd];
  const float c8 = -8.f * softplus_(-p.in[22][l * 1024 + gd]);
  __syncthreads();
#pragma unroll
  for (int i = 0; i < 18; ++i) {
    const int rr = rp + 2 * i;
    if (rr < 3 + T.nv) {
      float v;
      if (rr >= 3 || !T.first) v = bf2f(P[(size_t)(T.r0 + rr - 3) * PLD + PC_LX + gc]);
      else v = (T.stream >= 8) ? p.in[5][((size_t)(l * 16 + (T.stream - 8)) * 3 + rr) * 1024 + gc] : 0.f;
      raw[rr * 128 + ch] = v;
    }
  }
  __syncthreads();
#pragma unroll 4
  for (int t = rp; t < 32; t += 2) {
    float v = 0.f;
    if (t < T.nv) v = cb + raw[t * 128 + ch] * cw0 + raw[(t + 1) * 128 + ch] * cw1 + raw[(t + 2) * 128 + ch] * cw2 + raw[(t + 3) * 128 + ch] * cw3;
    xc[t * 128 + ch] = v;
    *(u16*)(xcb + sw256(t, ch >> 3) + (ch & 7) * 2) = f2bf(v);
  }
  if (T.last && tid < 128) {
    float* ocx = (T.stream < 8) ? p.out + O_PCX + (size_t)(l * 8 + T.stream) * 3 * 1024 : p.out + O_SCX + (size_t)(l * 16 + (T.stream - 8)) * 3 * 1024;
    ocx[gc] = raw[T.nv * 128 + ch]; ocx[1024 + gc] = raw[(T.nv + 1) * 128 + ch]; ocx[2048 + gc] = raw[(T.nv + 2) * 128 + ch];
  }
  __syncthreads();
  f32x16 aR, aI;
  zero16(aR); zero16(aI);
#pragma unroll
  for (int ks = 0; ks < 8; ++ks) {
    const bf16x8 af = ldsfrag(xcb, sw256(lr, 2 * ks + lh));
    aR = MFMA(af, wrf[ks], aR);
    aI = MFMA(af, wif[ks], aI);
  }
  float av[16], bv[16], hv[16], pv[16];
#pragma unroll
  for (int r = 0; r < 16; ++r) {
    const int t = crow(r, lh);
    const float rr = sigmoid_(aR[r] + br), ig = sigmoid_(aI[r] + bi);
    const float la = c8 * rr;
    const float a = __expf(la), mult = sqrtf(fmaxf(1.f - __expf(2.f * la), 0.f));
    const float xv = xc[t * 128 + d];
    av[r] = (t < T.nv) ? a : 1.f;
    bv[r] = (t < T.nv) ? mult * ig * xv : 0.f;
  }
  float hc = 0.f, pc = 1.f;
#pragma unroll
  for (int b = 0; b < 4; ++b) {
    float cA = hc, qA = pc, tA[4], uA[4], tB[4], uB[4];
#pragma unroll
    for (int r = 0; r < 4; ++r) { cA = av[4 * b + r] * cA + bv[4 * b + r]; qA = av[4 * b + r] * qA; tA[r] = cA; uA[r] = qA; }
    hc = __shfl(cA, lr); pc = __shfl(qA, lr);
    float cB = hc, qB = pc;
#pragma unroll
    for (int r = 0; r < 4; ++r) { cB = av[4 * b + r] * cB + bv[4 * b + r]; qB = av[4 * b + r] * qB; tB[r] = cB; uB[r] = qB; }
    hc = __shfl(cB, lr + 32); pc = __shfl(qB, lr + 32);
#pragma unroll
    for (int r = 0; r < 4; ++r) { hv[4 * b + r] = lh ? tB[r] : tA[r]; pv[4 * b + r] = lh ? uB[r] : uA[r]; }
  }
#pragma unroll
  for (int r = 0; r < 16; ++r) {
    const int t = crow(r, lh);
    if (t < T.nv) {
      const float g = gelu_tanh_(lyv[r]);
      P[(size_t)(T.r0 + t) * PLD + PC_LY + gd] = f2bf(hv[r] * g);
      Ya[(size_t)(T.r0 + t) * 1024 + gd] = f2bf(pv[r] * g);
    }
  }
  if (lh == 0) { AG[(size_t)(tl * 2) * 1024 + gd] = pc; AG[(size_t)(tl * 2 + 1) * 1024 + gd] = hc; }
}

DI void lru_b_item(const Params& p, int l, int item, char* smem) {
  const int tid = otid();
  u16* P = (u16*)(p.ws + P_OFF);
  const u16* Ya = (const u16*)(p.out + O_YP);
  const float* AG = (const float*)(p.ws + AG_OFF);
  float* cin = (float*)smem;
  int stream, n, qtr, ntile, tl0, rbase, L;
  if (item < 256) { stream = item >> 5; n = (item >> 2) & 7; qtr = item & 3; ntile = 65; tl0 = stream * 65; rbase = stream * 2064; L = 2064; }
  else { const int q = item - 256; stream = 8 + (q >> 3); n = q & 7; qtr = -1; ntile = 1; tl0 = 520 + (stream - 8); rbase = 16512 + 32 * (stream - 8); L = 32; }
  __syncthreads();
  if (tid < 128) {
    const int gd = n * 128 + tid;
    float c = (stream >= 8) ? p.in[4][(size_t)(l * 16 + (stream - 8)) * 1024 + gd] : 0.f;
#pragma unroll 13
    for (int j = 0; j < ntile; ++j) {
      const float a = AG[(size_t)((tl0 + j) * 2) * 1024 + gd], h = AG[(size_t)((tl0 + j) * 2 + 1) * 1024 + gd];
      cin[j * 128 + tid] = c;
      c = a * c + h;
    }
    if (qtr <= 0) {
      float* oh = (stream < 8) ? p.out + O_PH + (size_t)(l * 8 + stream) * 1024 : p.out + O_SH + (size_t)(l * 16 + (stream - 8)) * 1024;
      oh[gd] = c;
    }
  }
  __syncthreads();
  const int ck = tid & 15, rsub = tid >> 4;
  int pb = 0, pe = L;
  if (qtr >= 0) { pb = 516 * qtr; pe = pb + 516; }
  for (int pr0 = pb + rsub; pr0 < pe; pr0 += 64) {
    u32x4 yl[4], ya[4];
#pragma unroll
    for (int u = 0; u < 4; ++u) {
      const int pr = pr0 + 16 * u;
      if (pr < pe) {
        const size_t row = (size_t)(rbase + pr);
        yl[u] = *(const u32x4*)(P + row * PLD + PC_LY + n * 128 + 8 * ck);
        ya[u] = *(const u32x4*)(Ya + row * 1024 + n * 128 + 8 * ck);
      }
    }
#pragma unroll
    for (int u = 0; u < 4; ++u) {
      const int pr = pr0 + 16 * u;
      if (pr < pe) {
        const int j = (stream < 8) ? (pr < 16 ? 0 : 1 + ((pr - 16) >> 5)) : 0;
        const size_t row = (size_t)(rbase + pr);
        const float* cp = cin + j * 128 + 8 * ck;
        u32x4 o;
#pragma unroll
        for (int e = 0; e < 4; ++e) {
          const float y0 = __uint_as_float(yl[u][e] << 16) + __uint_as_float(ya[u][e] << 16) * cp[2 * e];
          const float y1 = __uint_as_float(yl[u][e] & 0xffff0000u) + __uint_as_float(ya[u][e] & 0xffff0000u) * cp[2 * e + 1];
          o[e] = pk2(y0, y1);
        }
        *(u32x4*)(P + row * PLD + PC_Y + n * 128 + 8 * ck) = o;
      }
    }
  }
}

#define XB_TMO      128
#define XB_XCNT(j)  (256  + 64 * (j))
#define XB_XSUB(j)  (1280 + 64 * (j))
#define XB_XGEN(j)  (2304 + 64 * (j))
#define XB_TOP      3328
#define XB_TOPGEN   3392
#define XCD_BAR_WORDS 3456
#define XB_SPIN_CAP (1u << 22)
DI unsigned xb_ld(unsigned* p) { return __hip_atomic_load(p, __ATOMIC_RELAXED, __HIP_MEMORY_SCOPE_AGENT); }
DI unsigned xb_add(unsigned* p, unsigned v) { return __hip_atomic_fetch_add(p, v, __ATOMIC_RELAXED, __HIP_MEMORY_SCOPE_AGENT); }
DI unsigned xb_xcc_id() { return (unsigned)__builtin_amdgcn_s_getreg((3 << 11) | 20) & 0xFu; }
#define XB_SPIN(cond, bar) do { unsigned _sp = 0; while (cond) { __builtin_amdgcn_s_sleep(1); \
    if ((++_sp & 255u) == 0u) { if (xb_ld(&(bar)[XB_TMO])) break; if (_sp > XB_SPIN_CAP) { atomicAdd(&(bar)[XB_TMO], 1u); break; } } } } while (0)
struct XcdBarrier { unsigned* bar; unsigned x; volatile unsigned* st; };
DI XcdBarrier xcd_barrier_post(unsigned* bar, volatile unsigned* st) {
  XcdBarrier b; b.bar = bar; b.x = xb_xcc_id(); b.st = st;
  if (threadIdx.x == 0) (void)xb_add(&bar[XB_XCNT(b.x)], 1u);
  return b;
}
DI void xcd_barrier_complete(unsigned* bar, unsigned x, unsigned& nloc, unsigned& nx) {
  const unsigned G = gridDim.x * gridDim.y * gridDim.z;
  unsigned sum, cnt, mine, sp = 0u;
  for (;;) {
    sum = 0u; cnt = 0u; mine = 0u;
#pragma unroll
    for (unsigned j = 0; j < 16; ++j) { const unsigned c = xb_ld(&bar[XB_XCNT(j)]); sum += c; cnt += (c > 0u) ? 1u : 0u; mine = (j == x) ? c : mine; }
    if (sum == G) break;
    __builtin_amdgcn_s_sleep(1);
    if ((++sp & 255u) == 0u) { if (xb_ld(&bar[XB_TMO])) break; if (sp > XB_SPIN_CAP) { atomicAdd(&bar[XB_TMO], 1u); break; } }
  }
  nloc = mine > 0u ? mine : 1u; nx = cnt > 0u ? cnt : 1u;
}
DI void xcd_barrier(const XcdBarrier& b) {
  asm volatile("s_waitcnt vmcnt(0)" ::: "memory");
  __syncthreads();
  if (threadIdx.x == 0) {
    unsigned* bar = b.bar;
    __builtin_amdgcn_s_waitcnt(0);
    unsigned nloc = b.st[0], nx = b.st[1];
    if (nloc == 0u) { xcd_barrier_complete(bar, b.x, nloc, nx); b.st[0] = nloc; b.st[1] = nx; }
    const unsigned old = xb_add(&bar[XB_XSUB(b.x)], 1u);
    const unsigned gen = old / nloc;
    if (old + 1u == (gen + 1u) * nloc) {
      __builtin_amdgcn_fence(__ATOMIC_RELEASE, "agent");
      asm volatile("s_waitcnt vmcnt(0)" ::: "memory");
      const unsigned og = xb_add(&bar[XB_TOP], 1u);
      const unsigned tg = og / nx;
      if (og + 1u == (tg + 1u) * nx) xb_add(&bar[XB_TOPGEN], 1u);
      else XB_SPIN(xb_ld(&bar[XB_TOPGEN]) == tg, bar);
      __builtin_amdgcn_fence(__ATOMIC_ACQUIRE, "agent");
      xb_add(&bar[XB_XGEN(b.x)], 1u);
      asm volatile("s_waitcnt vmcnt(0)" ::: "memory");
    } else {
      XB_SPIN(xb_ld(&bar[XB_XGEN(b.x)]) == gen, bar);
      __builtin_amdgcn_fence(__ATOMIC_ACQUIRE, "agent");
      asm volatile("s_waitcnt vmcnt(0)" ::: "memory");
    }
  }
  __syncthreads();
}

__global__ void __launch_bounds__(256, 2) mega(Params p, int lo, int hi) {
  extern __shared__ __attribute__((aligned(16))) char smem[];
  const u16* xb = (const u16*)(p.ws + XB_OFF);
  const u16* P = (const u16*)(p.ws + P_OFF);
  const u16* W = (const u16*)(p.ws + W_OFF);
  volatile unsigned* bst = (volatile unsigned*)(smem + 73728);
  if (threadIdx.x == 0) { bst[0] = 0u; bst[1] = 0u; }
  __syncthreads();
  const XcdBarrier gb = xcd_barrier_post((unsigned*)(p.ws + BAR_OFF), bst);
  if (lo < 0) cg::this_grid().sync();
#define GRID_SYNC() xcd_barrier(gb)
  int ph = 0;
#ifndef PROBE_MASK
#define PROBE_MASK 0
#endif
#define PH(body) { if (ph >= lo && ph < hi) { if (ph > lo) GRID_SYNC(); body } ++ph; }
#define PHX(bit, body, rep) { if (ph >= lo && ph < hi) { if (ph > lo) GRID_SYNC(); body if (PROBE_MASK & (bit)) { GRID_SYNC(); rep } } ++ph; }
  PH({
    for (int w = blockIdx.x; w < 3744 + 2128; w += gridDim.x) {
      if (w < 3744) wconv_tile(p, 0, w < 3680 ? w : 7072 + (w - 3680), smem); else gather_item(p, w - 3744, smem);
    }
  })
#pragma unroll 1
  for (int l = 0; l < 4; ++l) {
    PHX(1, gemm_phase<EPI_GU>(p, xb, DM, W + WB_GU1, DM, DM, 44, 0.f, smem);, gemm_phase<EPI_GU>(p, xb, DM, W + WB_GU1, DM, DM, 44, 0.f, smem);)
    PHX(1, gemm_phase<EPI_DOWN>(p, P, DFF, W + WB_DN1, DFF, DFF, 8, 0.5f, smem);, gemm_phase<EPI_DOWN>(p, P, DFF, W + WB_DN1, DFF, DFF, 8, 0.f, smem);)
    PHX(1, gemm_phase<EPI_WIN>(p, xb, DM, W + WB_WIN, DM, DM, 49, 0.f, smem);, gemm_phase<EPI_WIN>(p, xb, DM, W + WB_WIN, DM, DM, 49, 0.f, smem);)
    PHX(2, {
      for (int w = blockIdx.x; w < NITEM + NLT * 8; w += gridDim.x) { if (w < NITEM) delta_pre_item(p, l, w, smem); else lru_a_item(p, l, w - NITEM, smem); }
    }, { for (int w = blockIdx.x; w < NITEM; w += gridDim.x) delta_pre_item(p, l, w, smem); })
    PHX(4, {
      for (int w = blockIdx.x; w < 192 + 384; w += gridDim.x) {
        if (w < 192) delta_seq_item(p, l, w, smem);
        else lru_b_item(p, l, w - 192, smem);
      }
      if (blockIdx.x >= 64) {
        const int ntot = 3392 + (l < 3 ? 3744 : 0);
        for (int q = blockIdx.x - 64; q < ntot; q += gridDim.x - 64) {
          if (q < 3392) wconv_tile(p, l, 3680 + q, smem);
          else { const int e = q - 3392; wconv_tile(p, l + 1, e < 3680 ? e : 7072 + (e - 3680), smem); }
        }
      }
    }, {
      for (int w = blockIdx.x; w < 192 + 384; w += gridDim.x) {
        if (w < 192) delta_seq_item(p, l, w, smem);
        else lru_b_item(p, l, w - 192, smem);
      }
    })
    PHX(1, merge_phase(p, smem);, merge_phase(p, smem);)
    PHX(1, gemm_phase<EPI_DOWN>(p, P + PC_MRG, PLD, W + WB_WO, DM, DM, 8, 1.f, smem);, gemm_phase<EPI_DOWN>(p, P + PC_MRG, PLD, W + WB_WO, DM, DM, 8, 0.f, smem);)
    PHX(1, gemm_phase<EPI_GU>(p, xb, DM, W + WB_GU2, DM, DM, 44, 0.f, smem);, gemm_phase<EPI_GU>(p, xb, DM, W + WB_GU2, DM, DM, 44, 0.f, smem);)
    PHX(1, gemm_phase<EPI_DOWN>(p, P, DFF, W + WB_DN2, DFF, DFF, 8, 0.5f, smem);, gemm_phase<EPI_DOWN>(p, P, DFF, W + WB_DN2, DFF, DFF, 8, 0.f, smem);)
  }
  PH(final_phase(p);)
}

extern "C" void kernel_launch(void* const* d_in, const int* in_sizes, int n_in, void* d_out, int out_size, void* d_ws, size_t ws_size,
                              hipStream_t stream) {
  if (ws_size < WS_NEED || n_in < 30) { fprintf(stderr, "workspace too small: %zu < %zu\n", ws_size, (size_t)WS_NEED); return; }
  static int grid_blocks = 0;
  if (!grid_blocks) {
    hipFuncSetAttribute((const void*)mega, hipFuncAttributeMaxDynamicSharedMemorySize, LDS_BYTES);
    int dev = 0, cus = 0, per_cu = 0;
    hipGetDevice(&dev);
    hipDeviceGetAttribute(&cus, hipDeviceAttributeMultiprocessorCount, dev);
    hipOccupancyMaxActiveBlocksPerMultiprocessor(&per_cu, mega, 256, LDS_BYTES);
    if (per_cu > 2) per_cu = 2;
    grid_blocks = cus * per_cu;
  }
  Params p{};
  for (int i = 0; i < 30; ++i) p.in[i] = (const float*)d_in[i];
  p.out = (float*)d_out;
  p.ws = (char*)d_ws;
  hipMemsetAsync((char*)d_ws + BAR_OFF, 0, XCD_BAR_WORDS * 4, stream);
#ifdef MK_MULTI
  for (int ph = 0; ph < 38; ++ph) {
    int lo = ph, hi = ph + 1;
    hipLaunchKernelGGL(mega, dim3(grid_blocks), dim3(256), LDS_BYTES, stream, p, lo, hi);
  }
#else
  int lo = 0, hi = 38;
  void* args[] = {&p, &lo, &hi};
  hipError_t e = hipLaunchCooperativeKernel((void*)mega, dim3(grid_blocks), dim3(256), args, LDS_BYTES, stream);
  if (e != hipSuccess) fprintf(stderr, "cooperative launch failed: %s (grid %d)\n", hipGetErrorString(e), grid_blocks);
#endif
}
```

```cpp
#include <hip/hip_runtime.h>
#include <hip/hip_cooperative_groups.h>
#include <cstdio>
namespace cg = cooperative_groups;

typedef unsigned short u16;
typedef short bf16x8 __attribute__((ext_vector_type(8)));
typedef float f32x16 __attribute__((ext_vector_type(16)));
typedef unsigned u32x4 __attribute__((ext_vector_type(4)));
typedef __bf16 bf2_t __attribute__((ext_vector_type(2)));
typedef float f2_t __attribute__((ext_vector_type(2)));
#define DI __device__ __forceinline__
#define MFMA(a, b, c) __builtin_amdgcn_mfma_f32_32x32x16_bf16((a), (b), (c), 0, 0, 0)

constexpr int T_TOK = 17024;
constexpr int DM = 1024, DFF = 2816, PLD = 6272;
constexpr int NMT = 133;
constexpr int PC_Z = 3072, PC_LX = 4096, PC_LY = 5120, PC_BETA = 6144, PC_ALPHA = 6152;
constexpr int PC_OA = 0, PC_Y = 1024, PC_MRG = 2048;
constexpr int NLT = 536;
constexpr float EPS = 1e-6f;
constexpr int LDS_BYTES = 73744;
constexpr int NITEM = 2240;

constexpr size_t WB_GU1 = 0, WB_DN1 = 5767168, WB_WIN = 8650752, WB_WG = 15073280, WB_BA = 17170432, WB_BB = 18219008,
                 WB_WO = 19267584, WB_GU2 = 20316160, WB_DN2 = 26083328, WB_WR = 28966912, WB_WI = 29097984;
constexpr size_t X_OFF = 0, XB_OFF = 69730304, SSQ_OFF = 104595456, W_OFF = 105684992, P_OFF = 164143104,
                 QD_OFF = 377692160, WW_OFF = 414392320, KD_OFF = 451092480, UT_OFF = 487792640, A_OFF = 524492800,
                 GL_OFF = 542842880, BAR_OFF = 542851840, AG_OFF = 542868224, WS_NEED = 542868224 + 4390912;
constexpr size_t O_YP = 0, O_YS = 16777216, O_PS = 17301504, O_PCQ = 21495808, O_PH = 21790720, O_PCX = 21823488,
                 O_SS = 21921792, O_SCQ = 30310400, O_SH = 30900224, O_SCX = 30965760;

struct Params {
  const float* in[30];
  float* out;
  char* ws;
};

DI unsigned pk2(float a, float b) { f2_t v = {a, b}; bf2_t r = __builtin_convertvector(v, bf2_t); return __builtin_bit_cast(unsigned, r); }
DI u16 f2bf(float x) { __bf16 b = (__bf16)x; return __builtin_bit_cast(u16, b); }
DI float bf2f(u16 v) { return __uint_as_float(((unsigned)v) << 16); }
DI float4 ld_bf4(const u16* p) {
  uint2 v = *(const uint2*)p;
  return make_float4(__uint_as_float(v.x << 16), __uint_as_float(v.x & 0xffff0000u), __uint_as_float(v.y << 16), __uint_as_float(v.y & 0xffff0000u));
}
DI void st_bf4(u16* p, float a, float b, float c, float d) { uint2 v; v.x = pk2(a, b); v.y = pk2(c, d); *(uint2*)p = v; }
DI float sigmoid_(float x) { return __builtin_amdgcn_rcpf(1.f + __expf(-x)); }
DI float silu_(float x) { return x * __builtin_amdgcn_rcpf(1.f + __expf(-x)); }
DI float softplus_(float x) { return fmaxf(x, 0.f) + log1pf(__expf(-fabsf(x))); }
DI float gelu_tanh_(float x) { float u = 0.7978845608028654f * (x + 0.044715f * x * x * x); return x * __builtin_amdgcn_rcpf(1.f + __expf(-2.f * u)); }
DI int otid() { int t = threadIdx.x; asm volatile("" : "+v"(t)); return t; }
DI int crow(int reg, int h) { return (reg & 3) + 8 * (reg >> 2) + 4 * h; }
DI bf16x8 ldsfrag(const char* base, int off) { return *(const bf16x8*)(base + off); }
DI int sw128(int row, int ch) { return row * 128 + ((ch ^ ((row >> 1) & 7)) << 4); }
DI int sw256(int row, int ch) { return row * 256 + ((ch ^ (row & 15)) << 4); }
template <int S> DI bf16x8 pack8(const f32x16& x) {
  u32x4 u;
  u[0] = pk2(x[8 * S + 0], x[8 * S + 1]); u[1] = pk2(x[8 * S + 2], x[8 * S + 3]);
  u[2] = pk2(x[8 * S + 4], x[8 * S + 5]); u[3] = pk2(x[8 * S + 6], x[8 * S + 7]);
  return __builtin_bit_cast(bf16x8, u);
}
DI void zero16(f32x16& a) {
#pragma unroll
  for (int i = 0; i < 16; ++i) a[i] = 0.f;
}
DI float row_rs(const float* ssq, int row) {
  const float4* q = (const float4*)(ssq + (size_t)row * 16);
  float4 a = q[0], b = q[1], c = q[2], d = q[3];
  float s = (a.x + a.y + a.z + a.w) + (b.x + b.y + b.z + b.w) + (c.x + c.y + c.z + c.w) + (d.x + d.y + d.z + d.w);
  return rsqrtf(s * (1.f / 1024.f) + EPS);
}

typedef __attribute__((address_space(3))) unsigned lds_u32;
DI void stage_tile(const u16* __restrict__ g, int ld, char* lds, int tid) {
#pragma unroll
  for (int i = 0; i < 4; ++i) {
    const int pos = tid + 256 * i, row = pos >> 3, ch = (pos & 7) ^ ((row >> 1) & 7);
    __builtin_amdgcn_global_load_lds((const unsigned*)(g + (size_t)row * ld + ch * 8), (lds_u32*)(lds + pos * 16), 16, 0, 0);
  }
}
struct NoHook { DI void operator()() const {} };
template <class Hook = NoHook>
DI void gemm_core(const u16* __restrict__ A, int lda, const u16* __restrict__ Bt, int ldb, int K, char* smem, f32x16 (&acc)[2][2], Hook hook = Hook()) {
  const int tid = otid(), lane = tid & 63, wid = tid >> 6, wm = wid >> 1, wn = wid & 1;
  const int lr = lane & 31, lh = lane >> 5;
#pragma unroll
  for (int i = 0; i < 2; ++i)
#pragma unroll
    for (int j = 0; j < 2; ++j) zero16(acc[i][j]);
  __syncthreads();
  stage_tile(A, lda, smem, tid);
  stage_tile(Bt, ldb, smem + 16384, tid);
  const int nk = K >> 6;
  for (int kt = 0; kt < nk; ++kt) {
    const char* sa = smem + (kt & 1) * 32768;
    const char* sb = sa + 16384;
    asm volatile("s_waitcnt vmcnt(0)" ::: "memory");
    __syncthreads();
    if (kt + 1 < nk) {
      char* da = smem + ((kt + 1) & 1) * 32768;
      stage_tile(A + (kt + 1) * 64, lda, da, tid);
      stage_tile(Bt + (kt + 1) * 64, ldb, da + 16384, tid);
    }
    if (kt == nk - 2) hook();
#pragma unroll
    for (int ks = 0; ks < 4; ++ks) {
      bf16x8 a0 = ldsfrag(sa, sw128(64 * wm + lr, 2 * ks + lh));
      bf16x8 a1 = ldsfrag(sa, sw128(64 * wm + 32 + lr, 2 * ks + lh));
      bf16x8 b0 = ldsfrag(sb, sw128(64 * wn + lr, 2 * ks + lh));
      bf16x8 b1 = ldsfrag(sb, sw128(64 * wn + 32 + lr, 2 * ks + lh));
      acc[0][0] = MFMA(b0, a0, acc[0][0]);
      acc[0][1] = MFMA(b1, a0, acc[0][1]);
      acc[1][0] = MFMA(b0, a1, acc[1][0]);
      acc[1][1] = MFMA(b1, a1, acc[1][1]);
    }
  }
}

DI bool tile_of(int it, int NT, int& mt, int& nt) {
  const int G = gridDim.x, b = blockIdx.x;
  const int rb = ((G & 7) == 0) ? ((b & 7) * (G >> 3) + (b >> 3)) : b;
  const int L = it * G + rb;
  if (L >= NMT * NT) return false;
  const int nig = 8 * NT, gid = L / nig, fm = gid * 8, gsz = (NMT - fm) < 8 ? (NMT - fm) : 8, w = L - gid * nig;
  mt = fm + (w % gsz); nt = w / gsz;
  return true;
}
DI int num_rounds(int NT) { return (NMT * NT + gridDim.x - 1) / gridDim.x; }

enum { EPI_GU = 0, EPI_DOWN = 1, EPI_WIN = 2 };

template <int EPI>
DI void gemm_phase(const Params& p, const u16* A, int lda, const u16* Bt, int ldb, int K, int NT, float f, char* smem) {
  float* x = (float*)(p.ws + X_OFF);
  u16* xb = (u16*)(p.ws + XB_OFF);
  float* ssq = (float*)(p.ws + SSQ_OFF);
  u16* P = (u16*)(p.ws + P_OFF);
  const int tid_ = otid(), lane = tid_ & 63, wid = tid_ >> 6, wm = wid >> 1, wn = wid & 1, lr = lane & 31, lh = lane >> 5;
  const int nr = num_rounds(NT);
  for (int it = 0; it < nr; ++it) {
    int mt, nt;
    if (!tile_of(it, NT, mt, nt)) break;
    f32x16 acc[2][2];
    float rsv[2] = {0.f, 0.f};
    float4 xo[2][2][4];
    if (EPI != EPI_DOWN) {
#pragma unroll
      for (int mi = 0; mi < 2; ++mi) rsv[mi] = row_rs(ssq, mt * 128 + 64 * wm + 32 * mi + lr);
      gemm_core(A + (size_t)(mt * 128) * lda, lda, Bt + (size_t)(nt * 128) * ldb, ldb, K, smem, acc);
    } else {
      const float* xbase = x + (size_t)(mt * 128 + 64 * wm + lr) * DM + nt * 128 + 64 * wn + 4 * lh;
      gemm_core(A + (size_t)(mt * 128) * lda, lda, Bt + (size_t)(nt * 128) * ldb, ldb, K, smem, acc, [&]() {
#pragma unroll
        for (int mi = 0; mi < 2; ++mi)
#pragma unroll
          for (int ni = 0; ni < 2; ++ni)
#pragma unroll
            for (int b = 0; b < 4; ++b) xo[mi][ni][b] = *(const float4*)(xbase + (size_t)(32 * mi) * DM + 32 * ni + 8 * b);
      });
    }
#pragma unroll
    for (int mi = 0; mi < 2; ++mi) {
      const int row = mt * 128 + 64 * wm + 32 * mi + lr;
      if (EPI == EPI_GU) {
        const float rs = rsv[mi];
        u16* hrow = P + (size_t)row * DFF + 32 * (2 * nt + wn) + 4 * lh;
#pragma unroll
        for (int b = 0; b < 4; ++b) {
          float hv[4];
#pragma unroll
          for (int r = 0; r < 4; ++r) { float g = acc[mi][0][4 * b + r] * rs, u = acc[mi][1][4 * b + r] * rs; hv[r] = silu_(g) * u; }
          st_bf4(hrow + 8 * b, hv[0], hv[1], hv[2], hv[3]);
        }
      } else if (EPI == EPI_WIN) {
        const float rs = rsv[mi];
#pragma unroll
        for (int ni = 0; ni < 2; ++ni)
#pragma unroll
          for (int b = 0; b < 4; ++b) {
            const int col = nt * 128 + 64 * wn + 32 * ni + 8 * b + 4 * lh;
            st_bf4(P + (size_t)row * PLD + col, acc[mi][ni][4 * b] * rs, acc[mi][ni][4 * b + 1] * rs, acc[mi][ni][4 * b + 2] * rs, acc[mi][ni][4 * b + 3] * rs);
          }
      } else {
        float ss = 0.f;
#pragma unroll
        for (int ni = 0; ni < 2; ++ni)
#pragma unroll
          for (int b = 0; b < 4; ++b) {
            const int col = nt * 128 + 64 * wn + 32 * ni + 8 * b + 4 * lh;
            float4 v = xo[mi][ni][b];
            v.x += f * acc[mi][ni][4 * b]; v.y += f * acc[mi][ni][4 * b + 1]; v.z += f * acc[mi][ni][4 * b + 2]; v.w += f * acc[mi][ni][4 * b + 3];
            *(float4*)(x + (size_t)row * DM + col) = v;
            st_bf4(xb + (size_t)row * DM + col, v.x, v.y, v.z, v.w);
            ss += v.x * v.x + v.y * v.y + v.z * v.z + v.w * v.w;
          }
        ss += __shfl_xor(ss, 32);
        if (lh == 0) ssq[(size_t)row * 16 + 2 * nt + wn] = ss;
      }
    }
  }
}

DI void merge_phase(const Params& p, char* smem) {
  const u16* xb = (const u16*)(p.ws + XB_OFF);
  const float* ssq = (const float*)(p.ws + SSQ_OFF);
  u16* P = (u16*)(p.ws + P_OFF);
  const u16* W = (const u16*)(p.ws + W_OFF);
  const int tid_ = otid(), lane = tid_ & 63, wid = tid_ >> 6, wm = wid >> 1, wn = wid & 1, lr = lane & 31, lh = lane >> 5;
  const int nr = num_rounds(8);
  for (int it = 0; it < nr; ++it) {
    int mt, nt;
    if (!tile_of(it, 8, mt, nt)) break;
    for (int pass = 0; pass < 2; ++pass) {
      f32x16 acc[2][2];
      unsigned Gp[2][2][8];
      float rsv[2];
#pragma unroll
      for (int mi = 0; mi < 2; ++mi) rsv[mi] = row_rs(ssq, mt * 128 + 64 * wm + 32 * mi + lr);
      gemm_core(xb + (size_t)(mt * 128) * DM, DM, W + WB_WG + (size_t)(pass * 1024 + nt * 128) * DM, DM, DM, smem, acc);
#pragma unroll
      for (int mi = 0; mi < 2; ++mi) {
        const float rs = rsv[mi];
#pragma unroll
        for (int ni = 0; ni < 2; ++ni)
#pragma unroll
          for (int r = 0; r < 8; ++r) Gp[mi][ni][r] = pk2(sigmoid_(acc[mi][ni][2 * r] * rs), sigmoid_(acc[mi][ni][2 * r + 1] * rs));
      }
      gemm_core(P + (size_t)(mt * 128) * PLD + (pass ? PC_Y : PC_OA), PLD, W + (pass ? WB_BB : WB_BA) + (size_t)(nt * 128) * DM, DM, DM, smem, acc);
#pragma unroll
      for (int mi = 0; mi < 2; ++mi) {
        const int row = mt * 128 + 64 * wm + 32 * mi + lr;
        float4 prev[2][4];
#pragma unroll
        for (int ni = 0; ni < 2; ++ni)
#pragma unroll
          for (int b = 0; b < 4; ++b) {
            prev[ni][b] = make_float4(0.f, 0.f, 0.f, 0.f);
            if (pass) prev[ni][b] = ld_bf4(P + (size_t)row * PLD + PC_MRG + nt * 128 + 64 * wn + 32 * ni + 8 * b + 4 * lh);
          }
#pragma unroll
        for (int ni = 0; ni < 2; ++ni)
#pragma unroll
          for (int b = 0; b < 4; ++b) {
            u16* op = P + (size_t)row * PLD + PC_MRG + nt * 128 + 64 * wn + 32 * ni + 8 * b + 4 * lh;
            const unsigned g0 = Gp[mi][ni][2 * b], g1 = Gp[mi][ni][2 * b + 1];
            st_bf4(op, prev[ni][b].x + __uint_as_float(g0 << 16) * acc[mi][ni][4 * b], prev[ni][b].y + __uint_as_float(g0 & 0xffff0000u) * acc[mi][ni][4 * b + 1],
                   prev[ni][b].z + __uint_as_float(g1 << 16) * acc[mi][ni][4 * b + 2], prev[ni][b].w + __uint_as_float(g1 & 0xffff0000u) * acc[mi][ni][4 * b + 3]);
          }
      }
    }
  }
}

DI void wconv_tile(const Params& p, int l, int t, char* smem) {
  u16* W = (u16*)(p.ws + W_OFF);
  const float* src; const float* fold = nullptr; int ld, K, map = 0; u16* dst; int tn, tk;
  if (t < 7072) {
    int ntk;
    if (t < 1408) { src = p.in[8] + (size_t)l * 1024 * 5632; ld = 5632; K = 1024; fold = p.in[7] + l * 1024; map = 1; dst = W + WB_GU1; }
    else if (t < 2112) { t -= 1408; src = p.in[9] + (size_t)l * 2816 * 1024; ld = 1024; K = 2816; dst = W + WB_DN1; }
    else if (t < 3680) { t -= 2112; src = p.in[11] + (size_t)l * 1024 * 8208; ld = 8208; K = 1024; fold = p.in[10] + l * 1024; map = 2; dst = W + WB_WIN; }
    else if (t < 4192) { t -= 3680; src = p.in[11] + (size_t)l * 1024 * 8208 + 6160; ld = 8208; K = 1024; fold = p.in[10] + l * 1024; dst = W + WB_WG; }
    else if (t < 4448) { t -= 4192; src = p.in[23] + (size_t)l * 1048576; ld = 1024; K = 1024; dst = W + WB_BA; }
    else if (t < 4704) { t -= 4448; src = p.in[24] + (size_t)l * 1048576; ld = 1024; K = 1024; dst = W + WB_BB; }
    else if (t < 4960) { t -= 4704; src = p.in[25] + (size_t)l * 1048576; ld = 1024; K = 1024; dst = W + WB_WO; }
    else if (t < 6368) { t -= 4960; src = p.in[27] + (size_t)l * 1024 * 5632; ld = 5632; K = 1024; fold = p.in[26] + l * 1024; map = 1; dst = W + WB_GU2; }
    else { t -= 6368; src = p.in[28] + (size_t)l * 2816 * 1024; ld = 1024; K = 2816; dst = W + WB_DN2; }
    ntk = K >> 6; tn = t / ntk; tk = t - tn * ntk;
  } else {
    t -= 7072;
    const int mat = t >> 5, n = (t >> 2) & 7;
    src = p.in[mat ? 20 : 18] + (size_t)l * 131072 + n * 16384; ld = 128; K = 128;
    dst = W + (mat ? WB_WI : WB_WR) + n * 16384; tn = (t >> 1) & 1; tk = t & 1;
  }
  u16* tl = (u16*)smem;
  const int tid = otid(), nl = tid & 63, kl = tid >> 6;
  const int np = tn * 64 + nl;
  int sc = np;
  if (map == 1) sc = ((np >> 5) & 1) * 2816 + 32 * (np >> 6) + (np & 31);
  else if (map == 2) sc = np < 4096 ? np : (np < 6144 ? np + 16 : (np < 6152 ? 4096 + (np - 6144) : (np < 6160 ? 4104 + (np - 6152) : -1)));
  __syncthreads();
#pragma unroll
  for (int i = 0; i < 16; ++i) {
    const int k = tk * 64 + kl + 4 * i;
    float v = 0.f;
    if (sc >= 0) { v = src[(size_t)k * ld + sc]; if (fold) v *= fold[k]; }
    tl[nl * 66 + kl + 4 * i] = f2bf(v);
  }
  __syncthreads();
  const int n = tid >> 2, kq = tid & 3;
  const unsigned* rp = (const unsigned*)(tl + n * 66 + 16 * kq);
  uint4 o0, o1;
  o0.x = rp[0]; o0.y = rp[1]; o0.z = rp[2]; o0.w = rp[3]; o1.x = rp[4]; o1.y = rp[5]; o1.z = rp[6]; o1.w = rp[7];
  uint4* dp = (uint4*)(dst + (size_t)(tn * 64 + n) * K + tk * 64 + 16 * kq);
  dp[0] = o0; dp[1] = o1;
}

DI void gather_item(const Params& p, int item, char* smem) {
  float* x = (float*)(p.ws + X_OFF);
  u16* xb = (u16*)(p.ws + XB_OFF);
  float* ssq = (float*)(p.ws + SSQ_OFF);
  float* red = (float*)smem;
  const int tid = otid();
  for (int rr = 0; rr < 8; ++rr) {
    const int row = item * 8 + rr;
    const float* src;
    if (row < 16512) { const int s = row / 2064, pos = row - s * 2064; src = pos < 16 ? p.in[6] + pos * 1024 : p.in[0] + ((size_t)s * 2048 + (pos - 16)) * 1024; }
    else src = p.in[1] + (size_t)(row - 16512) * 1024;
    float4 v = ((const float4*)src)[tid];
    ((float4*)(x + (size_t)row * DM))[tid] = v;
    st_bf4(xb + (size_t)row * DM + 4 * tid, v.x, v.y, v.z, v.w);
    float ss = v.x * v.x + v.y * v.y + v.z * v.z + v.w * v.w;
#pragma unroll
    for (int o = 32; o > 0; o >>= 1) ss += __shfl_xor(ss, o);
    __syncthreads();
    if ((tid & 63) == 0) red[tid >> 6] = ss;
    __syncthreads();
    if (tid < 16) ssq[(size_t)row * 16 + tid] = (tid == 0) ? (red[0] + red[1] + red[2] + red[3]) : 0.f;
  }
}

DI void final_phase(const Params& p) {
  const float* x = (const float*)(p.ws + X_OFF);
  const float* ssq = (const float*)(p.ws + SSQ_OFF);
  const int tid = otid();
  const float4 fw = ((const float4*)p.in[29])[tid];
  for (int row = blockIdx.x; row < T_TOK; row += gridDim.x) {
    float* dst;
    if (row < 16512) { const int s = row / 2064, pos = row - s * 2064; if (pos < 16) continue; dst = p.out + O_YP + ((size_t)s * 2048 + (pos - 16)) * 1024; }
    else dst = p.out + O_YS + (size_t)(row - 16512) * 1024;
    const float rs = row_rs(ssq, row);
    float4 v = ((const float4*)(x + (size_t)row * DM))[tid];
    v.x *= rs * fw.x; v.y *= rs * fw.y; v.z *= rs * fw.z; v.w *= rs * fw.w;
    ((float4*)dst)[tid] = v;
  }
}

struct CI { int r0, nv, sbase, stream, last, sample; };
DI CI chunk_info(int ci) {
  CI c;
  if (ci < 264) {
    const int s = ci / 33, k = ci - s * 33;
    c.stream = s; c.sbase = s * 2064; c.sample = 0;
    if (k == 0) { c.r0 = c.sbase; c.nv = 16; } else { c.r0 = c.sbase + 16 + 64 * (k - 1); c.nv = 64; }
    c.last = (k == 32);
  } else {
    const int s = ci - 264;
    c.stream = 8 + s; c.sbase = 16512 + 32 * s; c.r0 = c.sbase; c.nv = 32; c.last = 1; c.sample = 1;
  }
  return c;
}

DI void dconv_store(const Params& p, int l, const CI& c, int cc, int ch, int half, char* RM, char* RT, float* cqo) {
  const u16* P = (const u16*)(p.ws + P_OFF);
  const float* cwp = p.in[12] + (size_t)l * 4 * 3072 + cc;
  const float w0 = cwp[0], w1 = cwp[3072], w2 = cwp[2 * 3072], w3 = cwp[3 * 3072];
  const int pad = 64 - c.nv, t0 = 32 * half;
  float r[35];
  const int rowb = c.r0 + t0 - 3 - pad;
#pragma unroll
  for (int i = 0; i < 35; ++i) {
    int rowu = rowb + i;
    rowu = rowu < c.sbase ? c.sbase : rowu;
    r[i] = bf2f(P[(unsigned)rowu * (unsigned)PLD + (unsigned)cc]);
  }
  float hist[3] = {0.f, 0.f, 0.f};
  if (c.sample) {
#pragma unroll
    for (int j = 0; j < 3; ++j) hist[j] = p.in[3][((size_t)(l * 16 + (c.stream - 8)) * 3 + j) * 3072 + cc];
  }
#pragma unroll
  for (int i = 0; i < 35; ++i) {
    const int u = t0 - 3 + i, rowu = rowb + i;
    if (u < pad - 3) r[i] = 0.f;
    else if (rowu < c.sbase) { const int j = 3 + rowu - c.sbase; r[i] = (j == 0) ? hist[0] : (j == 1 ? hist[1] : hist[2]); }
  }
#pragma unroll
  for (int q = 0; q < 4; ++q) {
    const int tq = t0 + 8 * q;
    float o[8];
#pragma unroll
    for (int i = 0; i < 8; ++i) {
      const float sv = r[8 * q + i] * w0 + r[8 * q + i + 1] * w1 + r[8 * q + i + 2] * w2 + r[8 * q + i + 3] * w3;
      o[i] = (tq + i >= pad) ? silu_(sv) : 0.f;
    }
    if (RM) {
#pragma unroll
      for (int i = 0; i < 8; ++i) *(u16*)(RM + sw256(tq + i, ch >> 3) + (ch & 7) * 2) = f2bf(o[i]);
    }
    if (RT) {
      u32x4 v; v[0] = pk2(o[0], o[1]); v[1] = pk2(o[2], o[3]); v[2] = pk2(o[4], o[5]); v[3] = pk2(o[6], o[7]);
      *(u32x4*)(RT + sw128(ch, 4 * half + q)) = v;
    }
  }
  if (half && c.last) { cqo[cc] = r[32]; cqo[3072 + cc] = r[33]; cqo[6144 + cc] = r[34]; }
}

DI void delta_pre_item(const Params& p, int l, int it, char* smem) {
  const int ci = it >> 3, h = it & 7;
  const CI c = chunk_info(ci);
  const u16* P = (const u16*)(p.ws + P_OFF);
  char* R0 = smem; char* R1 = smem + 16384; char* R2 = smem + 32768; float* Lm = (float*)(smem + 49152);
  float* sBeta = (float*)(smem + 65536); float* sGc = sBeta + 64; float* sNk = sBeta + 128; float* sNq = sBeta + 192;
  const int tid = otid(), lane = tid & 63, wid = tid >> 6, lr = lane & 31, lh = lane >> 5;
  const int ch = tid & 127, half = tid >> 7, t0 = 32 * half;
  const int pad = 64 - c.nv;
  float* cqo = p.out + (c.sample ? O_SCQ + ((size_t)(l * 16 + (c.stream - 8)) * 3) * 3072 : O_PCQ + ((size_t)(l * 8 + c.stream) * 3) * 3072);
  __syncthreads();
  dconv_store(p, l, c, h * 128 + ch, ch, half, R0, nullptr, cqo);
  dconv_store(p, l, c, 1024 + h * 128 + ch, ch, half, R1, R2, cqo);
  if (tid < 64) {
    float beta = 0.f, g = 0.f;
    if (tid >= pad) {
      const size_t row = (size_t)(c.r0 + tid - pad);
      beta = sigmoid_(bf2f(P[row * PLD + PC_BETA + h]));
      g = -__expf(p.in[13][l * 8 + h]) * softplus_(bf2f(P[row * PLD + PC_ALPHA + h]) + p.in[14][l * 8 + h]);
    }
#pragma unroll
    for (int o = 1; o < 64; o <<= 1) { const float v = __shfl_up(g, o); if (lane >= o) g += v; }
    sBeta[tid] = beta; sGc[tid] = g;
  }
  __syncthreads();
  const int ti = wid >> 1, tj = wid & 1;
  f32x16 aQK, aKK, aQQ;
  zero16(aQK); zero16(aKK); zero16(aQQ);
#pragma unroll
  for (int ks = 0; ks < 8; ++ks) {
    const bf16x8 kf = ldsfrag(R1, sw256(32 * tj + lr, 2 * ks + lh));
    const bf16x8 qf = ldsfrag(R0, sw256(32 * ti + lr, 2 * ks + lh));
    const bf16x8 kif = ldsfrag(R1, sw256(32 * ti + lr, 2 * ks + lh));
    aQK = MFMA(kf, qf, aQK);
    aKK = MFMA(kf, kif, aKK);
    if (ti == tj) aQQ = MFMA(qf, qf, aQQ);
  }
  if (ti == tj && (((lr >> 2) & 1) == lh)) {
    float vk = 0.f, vq = 0.f;
#pragma unroll
    for (int reg = 0; reg < 16; ++reg) if (crow(reg, lh) == lr) { vk = aKK[reg]; vq = aQQ[reg]; }
    sNk[32 * ti + lr] = vk; sNq[32 * ti + lr] = vq;
  }
  __syncthreads();
  const size_t itb = (size_t)it;
  {
    u16* Ag = (u16*)(p.ws + A_OFF) + itb * 4096;
    const int i = 32 * ti + lr;
    const float gi = sGc[i], rqi = rsqrtf(sNq[i] + EPS) * 0.08838834764831845f, bki = sBeta[i] * rsqrtf(sNk[i] + EPS);
#pragma unroll
    for (int b = 0; b < 4; ++b) {
      float av[4], lv[4];
#pragma unroll
      for (int r = 0; r < 4; ++r) {
        const int j = 32 * tj + 8 * b + 4 * lh + r;
        const float rkj = rsqrtf(sNk[j] + EPS);
        const float dec = (j <= i) ? __expf(gi - sGc[j]) : 0.f;
        av[r] = rqi * rkj * aQK[4 * b + r] * dec;
        lv[r] = (j < i) ? bki * rkj * aKK[4 * b + r] * dec : 0.f;
      }
      st_bf4(Ag + i * 64 + 16 * (2 * tj + (b >> 1)) + 8 * lh + 4 * (b & 1), av[0], av[1], av[2], av[3]);
      *(float4*)(Lm + i * 64 + 32 * tj + 8 * b + 4 * lh) = make_float4(lv[0], lv[1], lv[2], lv[3]);
      if (wid == 2) st_bf4((u16*)(smem + 66560) + lr * 32 + 8 * b + 4 * lh, lv[0], lv[1], lv[2], lv[3]);
    }
    u16* Qg = (u16*)(p.ws + QD_OFF) + itb * 8192;
    u16* Kg = (u16*)(p.ws + KD_OFF) + itb * 8192;
    const float glc = sGc[63];
#pragma unroll
    for (int ii = 0; ii < 4; ++ii) {
      const int q = tid + 256 * ii;
      {
        const int t = q >> 4, chn = q & 15, s = chn >> 1, hh = chn & 1;
        const float sc = rsqrtf(sNq[t] + EPS) * 0.08838834764831845f * __expf(sGc[t]);
        const int c0 = 16 * s + 4 * hh, c1 = c0 + 8;
        const float4 v0 = ld_bf4((const u16*)(R0 + sw256(t, c0 >> 3) + (c0 & 7) * 2));
        const float4 v1 = ld_bf4((const u16*)(R0 + sw256(t, c1 >> 3) + (c1 & 7) * 2));
        uint4 o; o.x = pk2(v0.x * sc, v0.y * sc); o.y = pk2(v0.z * sc, v0.w * sc); o.z = pk2(v1.x * sc, v1.y * sc); o.w = pk2(v1.z * sc, v1.w * sc);
        *(uint4*)(Qg + t * 128 + 8 * chn) = o;
      }
      {
        const int dk = q >> 3, chn = q & 7, s = chn >> 1, hh = chn & 1;
        const int ta = 16 * s + 4 * hh, tb = ta + 8;
        const float4 v0 = ld_bf4((const u16*)(R2 + sw128(dk, ta >> 3) + (ta & 7) * 2));
        const float4 v1 = ld_bf4((const u16*)(R2 + sw128(dk, tb >> 3) + (tb & 7) * 2));
        float sa[4], sb[4];
#pragma unroll
        for (int r = 0; r < 4; ++r) { sa[r] = rsqrtf(sNk[ta + r] + EPS) * __expf(glc - sGc[ta + r]); sb[r] = rsqrtf(sNk[tb + r] + EPS) * __expf(glc - sGc[tb + r]); }
        uint4 o; o.x = pk2(v0.x * sa[0], v0.y * sa[1]); o.y = pk2(v0.z * sa[2], v0.w * sa[3]); o.z = pk2(v1.x * sb[0], v1.y * sb[1]); o.w = pk2(v1.z * sb[2], v1.w * sb[3]);
        *(uint4*)(Kg + dk * 64 + 8 * chn) = o;
      }
    }
    if (tid == 0) ((float*)(p.ws + GL_OFF))[it] = __expf(glc);
  }
  __syncthreads();
  dconv_store(p, l, c, 2048 + h * 128 + ch, ch, half, nullptr, R0, cqo);
  {
    u16* L21b = (u16*)(smem + 66560); u16* T11t = (u16*)(smem + 68608); u16* T22b = (u16*)(smem + 70656);
    if (wid < 2) {
      const int blk = wid, cc = 32 * blk + lr;
      float tc[32];
#pragma unroll
      for (int i = 0; i < 32; ++i) tc[i] = 0.f;
#pragma unroll
      for (int i = 0; i < 32; ++i) {
        float sacc = (i == lr) ? 1.f : 0.f;
#pragma unroll
        for (int j4 = 0; j4 < i; j4 += 4) {
          const float4 lv = *(const float4*)(Lm + (32 * blk + i) * 64 + 32 * blk + j4);
          sacc -= lv.x * tc[j4]; sacc -= lv.y * tc[j4 + 1]; sacc -= lv.z * tc[j4 + 2]; sacc -= lv.w * tc[j4 + 3];
        }
        tc[i] = sacc;
      }
      if (lh == 0) {
        const float b1 = sBeta[cc], c1 = b1 * rsqrtf(sNk[cc] + EPS) * __expf(sGc[cc]);
#pragma unroll
        for (int i = 0; i < 32; ++i) {
          const int off = sw128(32 * blk + i, cc >> 3) + (cc & 7) * 2;
          *(u16*)(R1 + off) = f2bf(tc[i] * c1);
          *(u16*)(R1 + 8192 + off) = f2bf(tc[i] * b1);
        }
        if (blk == 0) {
#pragma unroll
          for (int q = 0; q < 4; ++q) {
            u32x4 v; v[0] = pk2(tc[8 * q], tc[8 * q + 1]); v[1] = pk2(tc[8 * q + 2], tc[8 * q + 3]); v[2] = pk2(tc[8 * q + 4], tc[8 * q + 5]); v[3] = pk2(tc[8 * q + 6], tc[8 * q + 7]);
            *(u32x4*)(T11t + lr * 32 + 8 * q) = v;
          }
        } else {
#pragma unroll
          for (int i = 0; i < 32; ++i) T22b[i * 32 + lr] = f2bf(tc[i]);
        }
      }
    } else {
#pragma unroll
      for (int i = 0; i < 2; ++i) {
        const int idx = (tid - 128) + 128 * i, mat = idx >> 7, rc = idx & 127;
        u32x4 z; z[0] = 0u; z[1] = 0u; z[2] = 0u; z[3] = 0u;
        *(u32x4*)(R1 + mat * 8192 + sw128(rc >> 2, 4 + (rc & 3))) = z;
      }
    }
    __syncthreads();
    if (wid == 0) {
      f32x16 Mx, D2;
      zero16(Mx); zero16(D2);
#pragma unroll
      for (int ks = 0; ks < 2; ++ks) {
        const bf16x8 xf = *(const bf16x8*)(L21b + lr * 32 + (2 * ks + lh) * 8);
        const bf16x8 yf = *(const bf16x8*)(T11t + lr * 32 + (2 * ks + lh) * 8);
        Mx = MFMA(xf, yf, Mx);
      }
#pragma unroll
      for (int sx = 0; sx < 2; ++sx) {
        const bf16x8 yp = sx ? pack8<1>(Mx) : pack8<0>(Mx);
        const uint2 lo = *(const uint2*)(T22b + lr * 32 + 16 * sx + 4 * lh);
        const uint2 hi = *(const uint2*)(T22b + lr * 32 + 16 * sx + 8 + 4 * lh);
        u32x4 xv; xv[0] = lo.x; xv[1] = lo.y; xv[2] = hi.x; xv[3] = hi.y;
        D2 = MFMA(__builtin_bit_cast(bf16x8, xv), yp, D2);
      }
      const float b1 = sBeta[lr], c1 = b1 * rsqrtf(sNk[lr] + EPS) * __expf(sGc[lr]);
#pragma unroll
      for (int r = 0; r < 16; ++r) {
        const int off = sw128(32 + crow(r, lh), lr >> 3) + (lr & 7) * 2;
        *(u16*)(R1 + off) = f2bf(-D2[r] * c1);
        *(u16*)(R1 + 8192 + off) = f2bf(-D2[r] * b1);
      }
    }
  }
  __syncthreads();
  {
    u16* Wg = (u16*)(p.ws + WW_OFF) + itb * 8192;
    u16* Ug = (u16*)(p.ws + UT_OFF) + itb * 8192;
    f32x16 aw[2], au[2];
    zero16(aw[0]); zero16(aw[1]); zero16(au[0]); zero16(au[1]);
#pragma unroll
    for (int ks = 0; ks < 4; ++ks) {
      const bf16x8 kT = ldsfrag(R2, sw128(32 * wid + lr, 2 * ks + lh));
      const bf16x8 vT = ldsfrag(R0, sw128(32 * wid + lr, 2 * ks + lh));
#pragma unroll
      for (int bb = 0; bb < 2; ++bb) {
        const bf16x8 t1 = ldsfrag(R1, sw128(32 * bb + lr, 2 * ks + lh));
        const bf16x8 t2 = ldsfrag(R1 + 8192, sw128(32 * bb + lr, 2 * ks + lh));
        aw[bb] = MFMA(kT, t1, aw[bb]);
        au[bb] = MFMA(t2, vT, au[bb]);
      }
    }
#pragma unroll
    for (int bb = 0; bb < 2; ++bb)
#pragma unroll
      for (int b = 0; b < 4; ++b) {
        st_bf4(Wg + (32 * bb + lr) * 128 + 32 * wid + 16 * (b >> 1) + 8 * lh + 4 * (b & 1), aw[bb][4 * b], aw[bb][4 * b + 1], aw[bb][4 * b + 2], aw[bb][4 * b + 3]);
        st_bf4(Ug + (32 * wid + lr) * 64 + 32 * bb + 8 * b + 4 * lh, au[bb][4 * b], au[bb][4 * b + 1], au[bb][4 * b + 2], au[bb][4 * b + 3]);
      }
  }
}

DI void delta_seq_item(const Params& p, int l, int item, char* smem) {
  const int stream = item >> 3, h = item & 7;
  const int tid = otid(), lane = tid & 63, wid = tid >> 6, lr = lane & 31, lh = lane >> 5;
  const int dv = 32 * wid + lr;
  u16* P = (u16*)(p.ws + P_OFF);
  f32x16 S[4];
  float* Sout;
  int nchunk, ci0;
  if (stream < 8) {
#pragma unroll
    for (int m = 0; m < 4; ++m) zero16(S[m]);
    Sout = p.out + O_PS + ((size_t)(l * 8 + stream) * 8 + h) * 16384;
    nchunk = 33; ci0 = stream * 33;
  } else {
    const float* S0 = p.in[2] + ((size_t)(l * 16 + (stream - 8)) * 8 + h) * 16384;
    const float* sp = S0 + (4 * lh) * 128 + dv;
#pragma unroll
    for (int m = 0; m < 4; ++m)
#pragma unroll
      for (int b = 0; b < 4; ++b) {
#pragma unroll
        for (int r = 0; r < 4; ++r) S[m][4 * b + r] = sp[r * 128];
        sp += 8 * 128;
        __builtin_amdgcn_sched_barrier(0);
      }
    Sout = p.out + O_SS + ((size_t)(l * 16 + (stream - 8)) * 8 + h) * 16384;
    nchunk = 1; ci0 = 264 + (stream - 8);
  }
  char* sW = smem; char* sQ = smem + 16384; char* sK = smem + 32768; char* sA = smem + 49152; char* sO = smem + 57344;
#define DMA256(gbase, lbase) { _Pragma("unroll") for (int ii = 0; ii < 4; ++ii) { const int pos = tid + 256 * ii, row = pos >> 4, chn = (pos & 15) ^ (row & 15); \
    __builtin_amdgcn_global_load_lds((const unsigned*)((gbase) + row * 128 + chn * 8), (lds_u32*)((lbase) + pos * 16), 16, 0, 0); } }
#define DMA128(gbase, lbase, n) { _Pragma("unroll") for (int ii = 0; ii < (n); ++ii) { const int pos = tid + 256 * ii, row = pos >> 3, chn = (pos & 7) ^ ((row >> 1) & 7); \
    __builtin_amdgcn_global_load_lds((const unsigned*)((gbase) + row * 64 + chn * 8), (lds_u32*)((lbase) + pos * 16), 16, 0, 0); } }
  __syncthreads();
  {
    const size_t it = (size_t)ci0 * 8 + h;
    const u16* Wg = (const u16*)(p.ws + WW_OFF) + it * 8192;
    const u16* Qg = (const u16*)(p.ws + QD_OFF) + it * 8192;
    DMA256(Wg, sW); DMA256(Qg, sQ);
  }
  asm volatile("s_waitcnt vmcnt(0)" ::: "memory");
  __syncthreads();
  for (int k = 0; k < nchunk; ++k) {
    const int ci = ci0 + k;
    const CI c = chunk_info(ci);
    const size_t it = (size_t)ci * 8 + h;
    const u16* Kg = (const u16*)(p.ws + KD_OFF) + it * 8192;
    const u16* Ag = (const u16*)(p.ws + A_OFF) + it * 4096;
    const u16* Ug = (const u16*)(p.ws + UT_OFF) + it * 8192;
    const float gl = ((const float*)(p.ws + GL_OFF))[it];
    if (k == 0) { DMA128(Kg, sK, 4); DMA128(Ag, sA, 2); }
    uint2 uvr[2][4];
#pragma unroll
    for (int m = 0; m < 2; ++m)
#pragma unroll
      for (int b = 0; b < 4; ++b) uvr[m][b] = *(const uint2*)(Ug + dv * 64 + 32 * m + 8 * b + 4 * lh);
    const int et = tid >> 2, eq = tid & 3, epad = 64 - c.nv;
    const bool erow = (et >= epad);
    const size_t erow_off = (size_t)(c.r0 + (erow ? et - epad : 0)) * PLD + h * 128 + 32 * eq;
    f32x16 M1[2], M2[2];
    zero16(M1[0]); zero16(M1[1]); zero16(M2[0]); zero16(M2[1]);
#pragma unroll
    for (int mt = 0; mt < 4; ++mt) {
#pragma unroll
      for (int sx = 0; sx < 2; ++sx) {
        const int ks = 2 * mt + sx;
        const bf16x8 Sp = sx ? pack8<1>(S[mt]) : pack8<0>(S[mt]);
#pragma unroll
        for (int m = 0; m < 2; ++m) {
          const bf16x8 wf = ldsfrag(sW, sw256(32 * m + lr, 2 * ks + lh));
          const bf16x8 qf = ldsfrag(sQ, sw256(32 * m + lr, 2 * ks + lh));
          M1[m] = MFMA(wf, Sp, M1[m]);
          M2[m] = MFMA(qf, Sp, M2[m]);
        }
      }
    }
    asm volatile("s_waitcnt vmcnt(0)" ::: "memory");
    __syncthreads();
    const bool more = (k + 1 < nchunk);
    if (more) {
      const u16* Wg = (const u16*)(p.ws + WW_OFF) + (it + 8) * 8192;
      const u16* Qg = (const u16*)(p.ws + QD_OFF) + (it + 8) * 8192;
      DMA256(Wg, sW); DMA256(Qg, sQ);
    }
    uint2 zr[8];
#pragma unroll
    for (int i = 0; i < 8; ++i) zr[i] = *(const uint2*)(P + erow_off + PC_Z + 4 * i);
#pragma unroll
    for (int m = 0; m < 2; ++m)
#pragma unroll
      for (int b = 0; b < 4; ++b) {
        const uint2 u2 = uvr[m][b];
        M1[m][4 * b] = __uint_as_float(u2.x << 16) - M1[m][4 * b]; M1[m][4 * b + 1] = __uint_as_float(u2.x & 0xffff0000u) - M1[m][4 * b + 1];
        M1[m][4 * b + 2] = __uint_as_float(u2.y << 16) - M1[m][4 * b + 2]; M1[m][4 * b + 3] = __uint_as_float(u2.y & 0xffff0000u) - M1[m][4 * b + 3];
      }
    bf16x8 Vp[4];
    Vp[0] = pack8<0>(M1[0]); Vp[1] = pack8<1>(M1[0]); Vp[2] = pack8<0>(M1[1]); Vp[3] = pack8<1>(M1[1]);
#pragma unroll
    for (int mt = 0; mt < 4; ++mt) {
#pragma unroll
      for (int r = 0; r < 16; ++r) S[mt][r] *= gl;
#pragma unroll
      for (int kk = 0; kk < 4; ++kk) {
        const bf16x8 kf = ldsfrag(sK, sw128(32 * mt + lr, 2 * kk + lh));
        S[mt] = MFMA(kf, Vp[kk], S[mt]);
      }
    }
#pragma unroll
    for (int m = 0; m < 2; ++m)
#pragma unroll
      for (int kk = 0; kk < 4; ++kk) {
        const bf16x8 af = ldsfrag(sA, sw128(32 * m + lr, 2 * kk + lh));
        M2[m] = MFMA(af, Vp[kk], M2[m]);
      }
#pragma unroll
    for (int m = 0; m < 2; ++m)
#pragma unroll
      for (int r = 0; r < 16; ++r) *(u16*)(sO + (32 * m + crow(r, lh)) * 256 + dv * 2) = f2bf(M2[m][r]);
    asm volatile("s_waitcnt vmcnt(0)" ::: "memory");
    __syncthreads();
    if (more) { DMA128(Kg + 8 * 8192, sK, 4); DMA128(Ag + 8 * 4096, sA, 2); }
    {
      float ov[32];
      float ss = 0.f;
#pragma unroll
      for (int i = 0; i < 4; ++i) {
        const u32x4 t4 = *(const u32x4*)(sO + et * 256 + 64 * eq + 16 * i);
#pragma unroll
        for (int e = 0; e < 4; ++e) {
          const float a0 = __uint_as_float(t4[e] << 16), a1 = __uint_as_float(t4[e] & 0xffff0000u);
          ov[8 * i + 2 * e] = a0; ov[8 * i + 2 * e + 1] = a1; ss += a0 * a0 + a1 * a1;
        }
      }
      ss += __shfl_xor(ss, 1); ss += __shfl_xor(ss, 2);
      const float rs = rsqrtf(ss * (1.f / 128.f) + EPS);
      if (erow) {
        u16* op = P + erow_off + PC_OA;
        const float* nw = p.in[15] + l * 128 + 32 * eq;
#pragma unroll
        for (int i = 0; i < 8; ++i) {
          const float zx = __uint_as_float(zr[i].x << 16), zy = __uint_as_float(zr[i].x & 0xffff0000u), zz = __uint_as_float(zr[i].y << 16), zw = __uint_as_float(zr[i].y & 0xffff0000u);
          const float4 w4 = *(const float4*)(nw + 4 * i);
          st_bf4(op + 4 * i, ov[4 * i] * rs * w4.x * silu_(zx), ov[4 * i + 1] * rs * w4.y * silu_(zy), ov[4 * i + 2] * rs * w4.z * silu_(zz), ov[4 * i + 3] * rs * w4.w * silu_(zw));
        }
      }
    }
  }
#undef DMA256
#undef DMA128
  float* so = Sout + (4 * lh) * 128 + dv;
#pragma unroll
  for (int m = 0; m < 4; ++m)
#pragma unroll
    for (int b = 0; b < 4; ++b) {
#pragma unroll
      for (int r = 0; r < 4; ++r) so[r * 128] = S[m][4 * b + r];
      so += 8 * 128;
      __builtin_amdgcn_sched_barrier(0);
    }
}

struct LT { int r0, nv, first, last, stream; };
DI LT lru_tile(int tl) {
  LT t;
  if (tl < 520) { const int s = tl / 65, j = tl - s * 65; t.stream = s; t.first = (j == 0); t.last = (j == 64); t.nv = j ? 32 : 16; t.r0 = s * 2064 + (j ? 16 + 32 * (j - 1) : 0); }
  else { const int s = tl - 520; t.stream = 8 + s; t.first = 1; t.last = 1; t.nv = 32; t.r0 = 16512 + 32 * s; }
  return t;
}
DI void lru_a_item(const Params& p, int l, int item, char* smem) {
  const int tl = item >> 3, n = item & 7;
  const LT T = lru_tile(tl);
  const int tid = otid(), lane = tid & 63, wid = tid >> 6, lr = lane & 31, lh = lane >> 5;
  u16* P = (u16*)(p.ws + P_OFF);
  u16* Ya = (u16*)(p.out + O_YP);
  const u16* W = (const u16*)(p.ws + W_OFF);
  float* AG = (float*)(p.ws + AG_OFF);
  float* raw = (float*)smem; float* xc = (float*)(smem + 18432); char* xcb = smem + 34816;
  const int ch = tid & 127, rp = tid >> 7;
  const int gc = n * 128 + ch;
  const int d = 32 * wid + lr, gd = n * 128 + d;
  float lyv[16];
#pragma unroll
  for (int r = 0; r < 16; ++r) { const int t = crow(r, lh); lyv[r] = (t < T.nv) ? bf2f(P[(size_t)(T.r0 + t) * PLD + PC_LY + gd]) : 0.f; }
  bf16x8 wrf[8], wif[8];
#pragma unroll
  for (int ks = 0; ks < 8; ++ks) {
    wrf[ks] = *(const bf16x8*)(W + WB_WR + n * 16384 + d * 128 + (2 * ks + lh) * 8);
    wif[ks] = *(const bf16x8*)(W + WB_WI + n * 16384 + d * 128 + (2 * ks + lh) * 8);
  }
  const float* cwp = p.in[16] + (size_t)l * 4 * 1024 + gc;
  const float cw0 = cwp[0], cw1 = cwp[1024], cw2 = cwp[2048], cw3 = cwp[3072], cb = p.in[17][l * 1024 + gc];
  const float br = p.in[19][l * 1024 + gd], bi = p.in[21][l * 1024 + gd];
  const float c8 = -8.f * softplus_(-p.in[22][l * 1024 + gd]);
  __syncthreads();
#pragma unroll
  for (int i = 0; i < 18; ++i) {
    const int rr = rp + 2 * i;
    if (rr < 3 + T.nv) {
      float v;
      if (rr >= 3 || !T.first) v = bf2f(P[(size_t)(T.r0 + rr - 3) * PLD + PC_LX + gc]);
      else v = (T.stream >= 8) ? p.in[5][((size_t)(l * 16 + (T.stream - 8)) * 3 + rr) * 1024 + gc] : 0.f;
      raw[rr * 128 + ch] = v;
    }
  }
  __syncthreads();
#pragma unroll 4
  for (int t = rp; t < 32; t += 2) {
    float v = 0.f;
    if (t < T.nv) v = cb + raw[t * 128 + ch] * cw0 + raw[(t + 1) * 128 + ch] * cw1 + raw[(t + 2) * 128 + ch] * cw2 + raw[(t + 3) * 128 + ch] * cw3;
    xc[t * 128 + ch] = v;
    *(u16*)(xcb + sw256(t, ch >> 3) + (ch & 7) * 2) = f2bf(v);
  }
  if (T.last && tid < 128) {
    float* ocx = (T.stream < 8) ? p.out + O_PCX + (size_t)(l * 8 + T.stream) * 3 * 1024 : p.out + O_SCX + (size_t)(l * 16 + (T.stream - 8)) * 3 * 1024;
    ocx[gc] = raw[T.nv * 128 + ch]; ocx[1024 + gc] = raw[(T.nv + 1) * 128 + ch]; ocx[2048 + gc] = raw[(T.nv + 2) * 128 + ch];
  }
  __syncthreads();
  f32x16 aR, aI;
  zero16(aR); zero16(aI);
#pragma unroll
  for (int ks = 0; ks < 8; ++ks) {
    const bf16x8 af = ldsfrag(xcb, sw256(lr, 2 * ks + lh));
    aR = MFMA(af, wrf[ks], aR);
    aI = MFMA(af, wif[ks], aI);
  }
  float av[16], bv[16], hv[16], pv[16];
#pragma unroll
  for (int r = 0; r < 16; ++r) {
    const int t = crow(r, lh);
    const float rr = sigmoid_(aR[r] + br), ig = sigmoid_(aI[r] + bi);
    const float la = c8 * rr;
    const float a = __expf(la), mult = sqrtf(fmaxf(1.f - __expf(2.f * la), 0.f));
    const float xv = xc[t * 128 + d];
    av[r] = (t < T.nv) ? a : 1.f;
    bv[r] = (t < T.nv) ? mult * ig * xv : 0.f;
  }
  float hc = 0.f, pc = 1.f;
#pragma unroll
  for (int b = 0; b < 4; ++b) {
    float cA = hc, qA = pc, tA[4], uA[4], tB[4], uB[4];
#pragma unroll
    for (int r = 0; r < 4; ++r) { cA = av[4 * b + r] * cA + bv[4 * b + r]; qA = av[4 * b + r] * qA; tA[r] = cA; uA[r] = qA; }
    hc = __shfl(cA, lr); pc = __shfl(qA, lr);
    float cB = hc, qB = pc;
#pragma unroll
    for (int r = 0; r < 4; ++r) { cB = av[4 * b + r] * cB + bv[4 * b + r]; qB = av[4 * b + r] * qB; tB[r] = cB; uB[r] = qB; }
    hc = __shfl(cB, lr + 32); pc = __shfl(qB, lr + 32);
#pragma unroll
    for (int r = 0; r < 4; ++r) { hv[4 * b + r] = lh ? tB[r] : tA[r]; pv[4 * b + r] = lh ? uB[r] : uA[r]; }
  }
#pragma unroll
  for (int r = 0; r < 16; ++r) {
    const int t = crow(r, lh);
    if (t < T.nv) {
      const float g = gelu_tanh_(lyv[r]);
      P[(size_t)(T.r0 + t) * PLD + PC_LY + gd] = f2bf(hv[r] * g);
      Ya[(size_t)(T.r0 + t) * 1024 + gd] = f2bf(pv[r] * g);
    }
  }
  if (lh == 0) { AG[(size_t)(tl * 2) * 1024 + gd] = pc; AG[(size_t)(tl * 2 + 1) * 1024 + gd] = hc; }
}

DI void lru_b_item(const Params& p, int l, int item, char* smem) {
  const int tid = otid();
  u16* P = (u16*)(p.ws + P_OFF);
  const u16* Ya = (const u16*)(p.out + O_YP);
  const float* AG = (const float*)(p.ws + AG_OFF);
  float* cin = (float*)smem;
  int stream, n, qtr, ntile, tl0, rbase, L;
  if (item < 256) { stream = item >> 5; n = (item >> 2) & 7; qtr = item & 3; ntile = 65; tl0 = stream * 65; rbase = stream * 2064; L = 2064; }
  else { const int q = item - 256; stream = 8 + (q >> 3); n = q & 7; qtr = -1; ntile = 1; tl0 = 520 + (stream - 8); rbase = 16512 + 32 * (stream - 8); L = 32; }
  __syncthreads();
  if (tid < 128) {
    const int gd = n * 128 + tid;
    float c = (stream >= 8) ? p.in[4][(size_t)(l * 16 + (stream - 8)) * 1024 + gd] : 0.f;
#pragma unroll 13
    for (int j = 0; j < ntile; ++j) {
      const float a = AG[(size_t)((tl0 + j) * 2) * 1024 + gd], h = AG[(size_t)((tl0 + j) * 2 + 1) * 1024 + gd];
      cin[j * 128 + tid] = c;
      c = a * c + h;
    }
    if (qtr <= 0) {
      float* oh = (stream < 8) ? p.out + O_PH + (size_t)(l * 8 + stream) * 1024 : p.out + O_SH + (size_t)(l * 16 + (stream - 8)) * 1024;
      oh[gd] = c;
    }
  }
  __syncthreads();
  const int ck = tid & 15, rsub = tid >> 4;
  int pb = 0, pe = L;
  if (qtr >= 0) { pb = 516 * qtr; pe = pb + 516; }
  for (int pr0 = pb + rsub; pr0 < pe; pr0 += 64) {
    u32x4 yl[4], ya[4];
#pragma unroll
    for (int u = 0; u < 4; ++u) {
      const int pr = pr0 + 16 * u;
      if (pr < pe) {
        const size_t row = (size_t)(rbase + pr);
        yl[u] = *(const u32x4*)(P + row * PLD + PC_LY + n * 128 + 8 * ck);
        ya[u] = *(const u32x4*)(Ya + row * 1024 + n * 128 + 8 * ck);
      }
    }
#pragma unroll
    for (int u = 0; u < 4; ++u) {
      const int pr = pr0 + 16 * u;
      if (pr < pe) {
        const int j = (stream < 8) ? (pr < 16 ? 0 : 1 + ((pr - 16) >> 5)) : 0;
        const size_t row = (size_t)(rbase + pr);
        const float* cp = cin + j * 128 + 8 * ck;
        u32x4 o;
#pragma unroll
        for (int e = 0; e < 4; ++e) {
          const float y0 = __uint_as_float(yl[u][e] << 16) + __uint_as_float(ya[u][e] << 16) * cp[2 * e];
          const float y1 = __uint_as_float(yl[u][e] & 0xffff0000u) + __uint_as_float(ya[u][e] & 0xffff0000u) * cp[2 * e + 1];
          o[e] = pk2(y0, y1);
        }
        *(u32x4*)(P + row * PLD + PC_Y + n * 128 + 8 * ck) = o;
      }
    }
  }
}

#define XB_TMO      128
#define XB_XCNT(j)  (256  + 64 * (j))
#define XB_XSUB(j)  (1280 + 64 * (j))
#define XB_XGEN(j)  (2304 + 64 * (j))
#define XB_TOP      3328
#define XB_TOPGEN   3392
#define XCD_BAR_WORDS 3456
#define XB_SPIN_CAP (1u << 22)
DI unsigned xb_ld(unsigned* p) { return __hip_atomic_load(p, __ATOMIC_RELAXED, __HIP_MEMORY_SCOPE_AGENT); }
DI unsigned xb_add(unsigned* p, unsigned v) { return __hip_atomic_fetch_add(p, v, __ATOMIC_RELAXED, __HIP_MEMORY_SCOPE_AGENT); }
DI unsigned xb_xcc_id() { return (unsigned)__builtin_amdgcn_s_getreg((3 << 11) | 20) & 0xFu; }
#define XB_SPIN(cond, bar) do { unsigned _sp = 0; while (cond) { __builtin_amdgcn_s_sleep(1); \
    if ((++_sp & 255u) == 0u) { if (xb_ld(&(bar)[XB_TMO])) break; if (_sp > XB_SPIN_CAP) { atomicAdd(&(bar)[XB_TMO], 1u); break; } } } } while (0)
struct XcdBarrier { unsigned* bar; unsigned x; volatile unsigned* st; };
DI XcdBarrier xcd_barrier_post(unsigned* bar, volatile unsigned* st) {
  XcdBarrier b; b.bar = bar; b.x = xb_xcc_id(); b.st = st;
  if (threadIdx.x == 0) (void)xb_add(&bar[XB_XCNT(b.x)], 1u);
  return b;
}
DI void xcd_barrier_complete(unsigned* bar, unsigned x, unsigned& nloc, unsigned& nx) {
  const unsigned G = gridDim.x * gridDim.y * gridDim.z;
  unsigned sum, cnt, mine, sp = 0u;
  for (;;) {
    sum = 0u; cnt = 0u; mine = 0u;
#pragma unroll
    for (unsigned j = 0; j < 16; ++j) { const unsigned c = xb_ld(&bar[XB_XCNT(j)]); sum += c; cnt += (c > 0u) ? 1u : 0u; mine = (j == x) ? c : mine; }
    if (sum == G) break;
    __builtin_amdgcn_s_sleep(1);
    if ((++sp & 255u) == 0u) { if (xb_ld(&bar[XB_TMO])) break; if (sp > XB_SPIN_CAP) { atomicAdd(&bar[XB_TMO], 1u); break; } }
  }
  nloc = mine > 0u ? mine : 1u; nx = cnt > 0u ? cnt : 1u;
}
DI void xcd_barrier(const XcdBarrier& b) {
  asm volatile("s_waitcnt vmcnt(0)" ::: "memory");
  __syncthreads();
  if (threadIdx.x == 0) {
    unsigned* bar = b.bar;
    __builtin_amdgcn_s_waitcnt(0);
    unsigned nloc = b.st[0], nx = b.st[1];
    if (nloc == 0u) { xcd_barrier_complete(bar, b.x, nloc, nx); b.st[0] = nloc; b.st[1] = nx; }
    const unsigned old = xb_add(&bar[XB_XSUB(b.x)], 1u);
    const unsigned gen = old / nloc;
    if (old + 1u == (gen + 1u) * nloc) {
      __builtin_amdgcn_fence(__ATOMIC_RELEASE, "agent");
      asm volatile("s_waitcnt vmcnt(0)" ::: "memory");
      const unsigned og = xb_add(&bar[XB_TOP], 1u);
      const unsigned tg = og / nx;
      if (og + 1u == (tg + 1u) * nx) xb_add(&bar[XB_TOPGEN], 1u);
      else XB_SPIN(xb_ld(&bar[XB_TOPGEN]) == tg, bar);
      __builtin_amdgcn_fence(__ATOMIC_ACQUIRE, "agent");
      xb_add(&bar[XB_XGEN(b.x)], 1u);
      asm volatile("s_waitcnt vmcnt(0)" ::: "memory");
    } else {
      XB_SPIN(xb_ld(&bar[XB_XGEN(b.x)]) == gen, bar);
      __builtin_amdgcn_fence(__ATOMIC_ACQUIRE, "agent");
      asm volatile("s_waitcnt vmcnt(0)" ::: "memory");
    }
  }
  __syncthreads();
}

__global__ void __launch_bounds__(256, 2) mega(Params p, int lo, int hi) {
  extern __shared__ __attribute__((aligned(16))) char smem[];
  const u16* xb = (const u16*)(p.ws + XB_OFF);
  const u16* P = (const u16*)(p.ws + P_OFF);
  const u16* W = (const u16*)(p.ws + W_OFF);
  volatile unsigned* bst = (volatile unsigned*)(smem + 73728);
  if (threadIdx.x == 0) { bst[0] = 0u; bst[1] = 0u; }
  __syncthreads();
  const XcdBarrier gb = xcd_barrier_post((unsigned*)(p.ws + BAR_OFF), bst);
  if (lo < 0) cg::this_grid().sync();
#define GRID_SYNC() xcd_barrier(gb)
  int ph = 0;
#ifndef PROBE_MASK
#define PROBE_MASK 0
#endif
#define PH(body) { if (ph >= lo && ph < hi) { if (ph > lo) GRID_SYNC(); body } ++ph; }
#define PHX(bit, body, rep) { if (ph >= lo && ph < hi) { if (ph > lo) GRID_SYNC(); body if (PROBE_MASK & (bit)) { GRID_SYNC(); rep } } ++ph; }
  PH({
    for (int w = blockIdx.x; w < 3744 + 2128; w += gridDim.x) {
      if (w < 3744) wconv_tile(p, 0, w < 3680 ? w : 7072 + (w - 3680), smem); else gather_item(p, w - 3744, smem);
    }
  })
#pragma unroll 1
  for (int l = 0; l < 4; ++l) {
    PHX(1, gemm_phase<EPI_GU>(p, xb, DM, W + WB_GU1, DM, DM, 44, 0.f, smem);, gemm_phase<EPI_GU>(p, xb, DM, W + WB_GU1, DM, DM, 44, 0.f, smem);)
    PHX(1, gemm_phase<EPI_DOWN>(p, P, DFF, W + WB_DN1, DFF, DFF, 8, 0.5f, smem);, gemm_phase<EPI_DOWN>(p, P, DFF, W + WB_DN1, DFF, DFF, 8, 0.f, smem);)
    PHX(1, gemm_phase<EPI_WIN>(p, xb, DM, W + WB_WIN, DM, DM, 49, 0.f, smem);, gemm_phase<EPI_WIN>(p, xb, DM, W + WB_WIN, DM, DM, 49, 0.f, smem);)
    PHX(2, {
      for (int w = blockIdx.x; w < NITEM + NLT * 8; w += gridDim.x) { if (w < NITEM) delta_pre_item(p, l, w, smem); else lru_a_item(p, l, w - NITEM, smem); }
    }, { for (int w = blockIdx.x; w < NITEM; w += gridDim.x) delta_pre_item(p, l, w, smem); })
    PHX(4, {
      for (int w = blockIdx.x; w < 192 + 384; w += gridDim.x) {
        if (w < 192) delta_seq_item(p, l, w, smem);
        else lru_b_item(p, l, w - 192, smem);
      }
      if (blockIdx.x >= 64) {
        const int ntot = 3392 + (l < 3 ? 3744 : 0);
        for (int q = blockIdx.x - 64; q < ntot; q += gridDim.x - 64) {
          if (q < 3392) wconv_tile(p, l, 3680 + q, smem);
          else { const int e = q - 3392; wconv_tile(p, l + 1, e < 3680 ? e : 7072 + (e - 3680), smem); }
        }
      }
    }, {
      for (int w = blockIdx.x; w < 192 + 384; w += gridDim.x) {
        if (w < 192) delta_seq_item(p, l, w, smem);
        else lru_b_item(p, l, w - 192, smem);
      }
    })
    PHX(1, merge_phase(p, smem);, merge_phase(p, smem);)
    PHX(1, gemm_phase<EPI_DOWN>(p, P + PC_MRG, PLD, W + WB_WO, DM, DM, 8, 1.f, smem);, gemm_phase<EPI_DOWN>(p, P + PC_MRG, PLD, W + WB_WO, DM, DM, 8, 0.f, smem);)
    PHX(1, gemm_phase<EPI_GU>(p, xb, DM, W + WB_GU2, DM, DM, 44, 0.f, smem);, gemm_phase<EPI_GU>(p, xb, DM, W + WB_GU2, DM, DM, 44, 0.f, smem);)
    PHX(1, gemm_phase<EPI_DOWN>(p, P, DFF, W + WB_DN2, DFF, DFF, 8, 0.5f, smem);, gemm_phase<EPI_DOWN>(p, P, DFF, W + WB_DN2, DFF, DFF, 8, 0.f, smem);)
  }
  PH(final_phase(p);)
}

extern "C" void kernel_launch(void* const* d_in, const int* in_sizes, int n_in, void* d_out, int out_size, void* d_ws, size_t ws_size,
                              hipStream_t stream) {
  if (ws_size < WS_NEED || n_in < 30) { fprintf(stderr, "workspace too small: %zu < %zu\n", ws_size, (size_t)WS_NEED); return; }
  static int grid_blocks = 0;
  if (!grid_blocks) {
    hipFuncSetAttribute((const void*)mega, hipFuncAttributeMaxDynamicSharedMemorySize, LDS_BYTES);
    int dev = 0, cus = 0, per_cu = 0;
    hipGetDevice(&dev);
    hipDeviceGetAttribute(&cus, hipDeviceAttributeMultiprocessorCount, dev);
    hipOccupancyMaxActiveBlocksPerMultiprocessor(&per_cu, mega, 256, LDS_BYTES);
    if (per_cu > 2) per_cu = 2;
    grid_blocks = cus * per_cu;
  }
  Params p{};
  for (int i = 0; i < 30; ++i) p.in[i] = (const float*)d_in[i];
  p.out = (float*)d_out;
  p.ws = (char*)d_ws;
  hipMemsetAsync((char*)d_ws + BAR_OFF, 0, XCD_BAR_WORDS * 4, stream);
#ifdef MK_MULTI
  for (int ph = 0; ph < 38; ++ph) {
    int lo = ph, hi = ph + 1;
    hipLaunchKernelGGL(mega, dim3(grid_blocks), dim3(256), LDS_BYTES, stream, p, lo, hi);
  }
#else
  int lo = 0, hi = 38;
  void* args[] = {&p, &lo, &hi};
  hipError_t e = hipLaunchCooperativeKernel((void*)mega, dim3(grid_blocks), dim3(256), args, LDS_BYTES, stream);
  if (e != hipSuccess) fprintf(stderr, "cooperative launch failed: %s (grid %d)\n", hipGetErrorString(e), grid_blocks);
#endif
}
```

```cpp
#include <hip/hip_runtime.h>
#include <hip/hip_cooperative_groups.h>
#include <cstdio>
namespace cg = cooperative_groups;

typedef unsigned short u16;
typedef short bf16x8 __attribute__((ext_vector_type(8)));
typedef float f32x16 __attribute__((ext_vector_type(16)));
typedef unsigned u32x4 __attribute__((ext_vector_type(4)));
typedef __bf16 bf2_t __attribute__((ext_vector_type(2)));
typedef float f2_t __attribute__((ext_vector_type(2)));
#define DI __device__ __forceinline__
#define MFMA(a, b, c) __builtin_amdgcn_mfma_f32_32x32x16_bf16((a), (b), (c), 0, 0, 0)

constexpr int T_TOK = 17024;
constexpr int DM = 1024, DFF = 2816, PLD = 6400;
constexpr int T_PAD = 17152;
constexpr int NMT = 67;
constexpr int PC_Z = 3072, PC_LX = 4096, PC_LY = 5120, PC_BETA = 6144, PC_ALPHA = 6152;
constexpr int PC_OA = 0, PC_Y = 1024, PC_MRG = 2048;
constexpr int NLT = 536;
constexpr float EPS = 1e-6f;
constexpr int HALF_LDS = 73728;
constexpr int LDS_BYTES = 147472;
constexpr int NITEM = 2240;

constexpr size_t WB_GU1 = 0, WB_DN1 = 5767168, WB_WIN = 8650752, WB_WG = 15204352, WB_BA = 17301504, WB_BB = 18350080,
                 WB_WO = 19398656, WB_GU2 = 20447232, WB_DN2 = 26214400, WB_WR = 29097984, WB_WI = 29229056;
constexpr size_t X_OFF = 0, XB_OFF = 69730304, SSQ_OFF = 104857600, W_OFF = 105947136, P_OFF = 164667392,
                 QD_OFF = 384212992, WW_OFF = 420913152, KD_OFF = 457613312, UT_OFF = 494313472, A_OFF = 531013632,
                 GL_OFF = 549363712, BAR_OFF = 549380096, AG_OFF = 549396480, WS_NEED = 549396480 + 4390912;
constexpr size_t O_YP = 0, O_YS = 16777216, O_PS = 17301504, O_PCQ = 21495808, O_PH = 21790720, O_PCX = 21823488,
                 O_SS = 21921792, O_SCQ = 30310400, O_SH = 30900224, O_SCX = 30965760;

struct Params {
  const float* in[30];
  float* out;
  char* ws;
};

DI unsigned pk2(float a, float b) { f2_t v = {a, b}; bf2_t r = __builtin_convertvector(v, bf2_t); return __builtin_bit_cast(unsigned, r); }
DI u16 f2bf(float x) { __bf16 b = (__bf16)x; return __builtin_bit_cast(u16, b); }
DI float bf2f(u16 v) { return __uint_as_float(((unsigned)v) << 16); }
DI float4 ld_bf4(const u16* p) {
  uint2 v = *(const uint2*)p;
  return make_float4(__uint_as_float(v.x << 16), __uint_as_float(v.x & 0xffff0000u), __uint_as_float(v.y << 16), __uint_as_float(v.y & 0xffff0000u));
}
DI void st_bf4(u16* p, float a, float b, float c, float d) { uint2 v; v.x = pk2(a, b); v.y = pk2(c, d); *(uint2*)p = v; }
DI float sigmoid_(float x) { return __builtin_amdgcn_rcpf(1.f + __expf(-x)); }
DI float silu_(float x) { return x * __builtin_amdgcn_rcpf(1.f + __expf(-x)); }
DI float softplus_(float x) { return fmaxf(x, 0.f) + log1pf(__expf(-fabsf(x))); }
DI float gelu_tanh_(float x) { float u = 0.7978845608028654f * (x + 0.044715f * x * x * x); return x * __builtin_amdgcn_rcpf(1.f + __expf(-2.f * u)); }
DI int otid() { int t = threadIdx.x & 255; asm volatile("" : "+v"(t)); return t; }
DI int otid512() { int t = threadIdx.x; asm volatile("" : "+v"(t)); return t; }
DI int crow(int reg, int h) { return (reg & 3) + 8 * (reg >> 2) + 4 * h; }
DI bf16x8 ldsfrag(const char* base, int off) { return *(const bf16x8*)(base + off); }
DI int sw128(int row, int ch) { return row * 128 + ((ch ^ ((row >> 1) & 7)) << 4); }
DI int sw256(int row, int ch) { return row * 256 + ((ch ^ (row & 15)) << 4); }
template <int S> DI bf16x8 pack8(const f32x16& x) {
  u32x4 u;
  u[0] = pk2(x[8 * S + 0], x[8 * S + 1]); u[1] = pk2(x[8 * S + 2], x[8 * S + 3]);
  u[2] = pk2(x[8 * S + 4], x[8 * S + 5]); u[3] = pk2(x[8 * S + 6], x[8 * S + 7]);
  return __builtin_bit_cast(bf16x8, u);
}
DI void zero16(f32x16& a) {
#pragma unroll
  for (int i = 0; i < 16; ++i) a[i] = 0.f;
}
DI float row_rs(const float* ssq, int row) {
  const float4* q = (const float4*)(ssq + (size_t)row * 16);
  float4 a = q[0], b = q[1], c = q[2], d = q[3];
  float s = (a.x + a.y + a.z + a.w) + (b.x + b.y + b.z + b.w) + (c.x + c.y + c.z + c.w) + (d.x + d.y + d.z + d.w);
  return rsqrtf(s * (1.f / 1024.f) + EPS);
}

typedef __attribute__((address_space(3))) unsigned lds_u32;
enum { EPI_GU = 0, EPI_DOWN = 1, EPI_WIN = 2 };
DI void stage_tile_h(const u16* __restrict__ g, int ld, char* lds, int tid) {
#pragma unroll
  for (int i = 0; i < 4; ++i) {
    const int pos = tid + 256 * i, row = pos >> 3, ch = (pos & 7) ^ ((row >> 1) & 7);
    __builtin_amdgcn_global_load_lds((const unsigned*)(g + (size_t)row * ld + ch * 8), (lds_u32*)(lds + pos * 16), 16, 0, 0);
  }
}
struct NoHookH { DI void operator()() const {} };
template <class Hook = NoHookH>
DI void gemm_core_h(const u16* __restrict__ A, int lda, const u16* __restrict__ Bt, int ldb, int K, char* smem, f32x16 (&acc)[2][2], Hook hook = Hook()) {
  const int tid = otid(), lane = tid & 63, wid = tid >> 6, wm = wid >> 1, wn = wid & 1;
  const int lr = lane & 31, lh = lane >> 5;
#pragma unroll
  for (int i = 0; i < 2; ++i)
#pragma unroll
    for (int j = 0; j < 2; ++j) zero16(acc[i][j]);
  __syncthreads();
  stage_tile_h(A, lda, smem, tid);
  stage_tile_h(Bt, ldb, smem + 16384, tid);
  const int nk = K >> 6;
  for (int kt = 0; kt < nk; ++kt) {
    const char* sa = smem + (kt & 1) * 32768;
    const char* sb = sa + 16384;
    asm volatile("s_waitcnt vmcnt(0)" ::: "memory");
    __syncthreads();
    if (kt + 1 < nk) {
      char* da = smem + ((kt + 1) & 1) * 32768;
      stage_tile_h(A + (kt + 1) * 64, lda, da, tid);
      stage_tile_h(Bt + (kt + 1) * 64, ldb, da + 16384, tid);
    }
    if (kt == nk - 2) hook();
#pragma unroll
    for (int ks = 0; ks < 4; ++ks) {
      bf16x8 a0 = ldsfrag(sa, sw128(64 * wm + lr, 2 * ks + lh));
      bf16x8 a1 = ldsfrag(sa, sw128(64 * wm + 32 + lr, 2 * ks + lh));
      bf16x8 b0 = ldsfrag(sb, sw128(64 * wn + lr, 2 * ks + lh));
      bf16x8 b1 = ldsfrag(sb, sw128(64 * wn + 32 + lr, 2 * ks + lh));
      acc[0][0] = MFMA(b0, a0, acc[0][0]);
      acc[0][1] = MFMA(b1, a0, acc[0][1]);
      acc[1][0] = MFMA(b0, a1, acc[1][0]);
      acc[1][1] = MFMA(b1, a1, acc[1][1]);
    }
  }
}

DI bool tile_of_h(int it, int NT, int& mt, int& nt) {
  const int G = gridDim.x, b = blockIdx.x;
  const int rb = ((G & 7) == 0) ? ((b & 7) * (G >> 3) + (b >> 3)) : b;
  const int hid = __builtin_amdgcn_readfirstlane((int)(threadIdx.x >> 8));
  const int L = it * 2 * G + 2 * rb + hid;
  if (L >= 133 * NT) return false;
  const int nig = 8 * NT, gid = L / nig, fm = gid * 8, gsz = (133 - fm) < 8 ? (133 - fm) : 8, w = L - gid * nig;
  mt = fm + (w % gsz); nt = w / gsz;
  return true;
}
DI int num_rounds_h(int NT) { return (133 * NT + 2 * gridDim.x - 1) / (2 * gridDim.x); }


template <int EPI>
DI void gemm_phase_h(const Params& p, const u16* A, int lda, const u16* Bt, int ldb, int K, int NT, float f, char* smem) {
  float* x = (float*)(p.ws + X_OFF);
  u16* xb = (u16*)(p.ws + XB_OFF);
  float* ssq = (float*)(p.ws + SSQ_OFF);
  u16* P = (u16*)(p.ws + P_OFF);
  const int tid_ = otid(), lane = tid_ & 63, wid = tid_ >> 6, wm = wid >> 1, wn = wid & 1, lr = lane & 31, lh = lane >> 5;
  const int nr = num_rounds_h(NT);
  for (int it = 0; it < nr; ++it) {
    int mt, nt;
    if (!tile_of_h(it, NT, mt, nt)) break;
    f32x16 acc[2][2];
    float rsv[2] = {0.f, 0.f};
    float4 xo[2][2][4];
    if (EPI != EPI_DOWN) {
#pragma unroll
      for (int mi = 0; mi < 2; ++mi) rsv[mi] = row_rs(ssq, mt * 128 + 64 * wm + 32 * mi + lr);
      gemm_core_h(A + (size_t)(mt * 128) * lda, lda, Bt + (size_t)(nt * 128) * ldb, ldb, K, smem, acc);
    } else {
      const float* xbase = x + (size_t)(mt * 128 + 64 * wm + lr) * DM + nt * 128 + 64 * wn + 4 * lh;
      gemm_core_h(A + (size_t)(mt * 128) * lda, lda, Bt + (size_t)(nt * 128) * ldb, ldb, K, smem, acc, [&]() {
#pragma unroll
        for (int mi = 0; mi < 2; ++mi)
#pragma unroll
          for (int ni = 0; ni < 2; ++ni)
#pragma unroll
            for (int b = 0; b < 4; ++b) xo[mi][ni][b] = *(const float4*)(xbase + (size_t)(32 * mi) * DM + 32 * ni + 8 * b);
      });
    }
#pragma unroll
    for (int mi = 0; mi < 2; ++mi) {
      const int row = mt * 128 + 64 * wm + 32 * mi + lr;
      if (EPI == EPI_GU) {
        const float rs = rsv[mi];
        u16* hrow = P + (size_t)row * DFF + 32 * (2 * nt + wn) + 4 * lh;
#pragma unroll
        for (int b = 0; b < 4; ++b) {
          float hv[4];
#pragma unroll
          for (int r = 0; r < 4; ++r) { float g = acc[mi][0][4 * b + r] * rs, u = acc[mi][1][4 * b + r] * rs; hv[r] = silu_(g) * u; }
          st_bf4(hrow + 8 * b, hv[0], hv[1], hv[2], hv[3]);
        }
      } else if (EPI == EPI_WIN) {
        const float rs = rsv[mi];
#pragma unroll
        for (int ni = 0; ni < 2; ++ni)
#pragma unroll
          for (int b = 0; b < 4; ++b) {
            const int col = nt * 128 + 64 * wn + 32 * ni + 8 * b + 4 * lh;
            st_bf4(P + (size_t)row * PLD + col, acc[mi][ni][4 * b] * rs, acc[mi][ni][4 * b + 1] * rs, acc[mi][ni][4 * b + 2] * rs, acc[mi][ni][4 * b + 3] * rs);
          }
      } else {
        float ss = 0.f;
#pragma unroll
        for (int ni = 0; ni < 2; ++ni)
#pragma unroll
          for (int b = 0; b < 4; ++b) {
            const int col = nt * 128 + 64 * wn + 32 * ni + 8 * b + 4 * lh;
            float4 v = xo[mi][ni][b];
            v.x += f * acc[mi][ni][4 * b]; v.y += f * acc[mi][ni][4 * b + 1]; v.z += f * acc[mi][ni][4 * b + 2]; v.w += f * acc[mi][ni][4 * b + 3];
            *(float4*)(x + (size_t)row * DM + col) = v;
            st_bf4(xb + (size_t)row * DM + col, v.x, v.y, v.z, v.w);
            ss += v.x * v.x + v.y * v.y + v.z * v.z + v.w * v.w;
          }
        ss += __shfl_xor(ss, 32);
        if (lh == 0) ssq[(size_t)row * 16 + 2 * nt + wn] = ss;
      }
    }
  }
}

DI void merge_phase_h(const Params& p, char* smem) {
  const u16* xb = (const u16*)(p.ws + XB_OFF);
  const float* ssq = (const float*)(p.ws + SSQ_OFF);
  u16* P = (u16*)(p.ws + P_OFF);
  const u16* W = (const u16*)(p.ws + W_OFF);
  const int tid_ = otid(), lane = tid_ & 63, wid = tid_ >> 6, wm = wid >> 1, wn = wid & 1, lr = lane & 31, lh = lane >> 5;
  const int nr = num_rounds_h(8);
  for (int it = 0; it < nr; ++it) {
    int mt, nt;
    if (!tile_of_h(it, 8, mt, nt)) break;
    for (int pass = 0; pass < 2; ++pass) {
      f32x16 acc[2][2];
      unsigned Gp[2][2][8];
      float rsv[2];
#pragma unroll
      for (int mi = 0; mi < 2; ++mi) rsv[mi] = row_rs(ssq, mt * 128 + 64 * wm + 32 * mi + lr);
      gemm_core_h(xb + (size_t)(mt * 128) * DM, DM, W + WB_WG + (size_t)(pass * 1024 + nt * 128) * DM, DM, DM, smem, acc);
#pragma unroll
      for (int mi = 0; mi < 2; ++mi) {
        const float rs = rsv[mi];
#pragma unroll
        for (int ni = 0; ni < 2; ++ni)
#pragma unroll
          for (int r = 0; r < 8; ++r) Gp[mi][ni][r] = pk2(sigmoid_(acc[mi][ni][2 * r] * rs), sigmoid_(acc[mi][ni][2 * r + 1] * rs));
      }
      gemm_core_h(P + (size_t)(mt * 128) * PLD + (pass ? PC_Y : PC_OA), PLD, W + (pass ? WB_BB : WB_BA) + (size_t)(nt * 128) * DM, DM, DM, smem, acc);
#pragma unroll
      for (int mi = 0; mi < 2; ++mi) {
        const int row = mt * 128 + 64 * wm + 32 * mi + lr;
        float4 prev[2][4];
#pragma unroll
        for (int ni = 0; ni < 2; ++ni)
#pragma unroll
          for (int b = 0; b < 4; ++b) {
            prev[ni][b] = make_float4(0.f, 0.f, 0.f, 0.f);
            if (pass) prev[ni][b] = ld_bf4(P + (size_t)row * PLD + PC_MRG + nt * 128 + 64 * wn + 32 * ni + 8 * b + 4 * lh);
          }
#pragma unroll
        for (int ni = 0; ni < 2; ++ni)
#pragma unroll
          for (int b = 0; b < 4; ++b) {
            u16* op = P + (size_t)row * PLD + PC_MRG + nt * 128 + 64 * wn + 32 * ni + 8 * b + 4 * lh;
            const unsigned g0 = Gp[mi][ni][2 * b], g1 = Gp[mi][ni][2 * b + 1];
            st_bf4(op, prev[ni][b].x + __uint_as_float(g0 << 16) * acc[mi][ni][4 * b], prev[ni][b].y + __uint_as_float(g0 & 0xffff0000u) * acc[mi][ni][4 * b + 1],
                   prev[ni][b].z + __uint_as_float(g1 << 16) * acc[mi][ni][4 * b + 2], prev[ni][b].w + __uint_as_float(g1 & 0xffff0000u) * acc[mi][ni][4 * b + 3]);
          }
      }
    }
  }
}

DI void stage_tile(const u16* __restrict__ g, int ld, char* lds, int tid) {
#pragma unroll
  for (int i = 0; i < 4; ++i) {
    const int pos = tid + 512 * i, row = pos >> 3, ch = (pos & 7) ^ ((row >> 1) & 7);
    __builtin_amdgcn_global_load_lds((const unsigned*)(g + (size_t)row * ld + ch * 8), (lds_u32*)(lds + pos * 16), 16, 0, 0);
  }
}
DI void gemm_core(const u16* __restrict__ A, int lda, const u16* __restrict__ Bt, int ldb, int K, char* smem, f32x16 (&acc)[4][2]) {
  const int tid = otid512(), lane = tid & 63, wid = tid >> 6, wm = wid >> 2, wn = wid & 3;
  const int lr = lane & 31, lh = lane >> 5;
#pragma unroll
  for (int i = 0; i < 4; ++i)
#pragma unroll
    for (int j = 0; j < 2; ++j) zero16(acc[i][j]);
  __syncthreads();
  stage_tile(A, lda, smem, tid);
  stage_tile(Bt, ldb, smem + 32768, tid);
  const int nk = K >> 6;
  for (int kt = 0; kt < nk; ++kt) {
    const char* sa = smem + (kt & 1) * 65536;
    const char* sb = sa + 32768;
    asm volatile("s_waitcnt vmcnt(0)" ::: "memory");
    __syncthreads();
    if (kt + 1 < nk) {
      char* da = smem + ((kt + 1) & 1) * 65536;
      stage_tile(A + (kt + 1) * 64, lda, da, tid);
      stage_tile(Bt + (kt + 1) * 64, ldb, da + 32768, tid);
    }
#pragma unroll
    for (int ks = 0; ks < 4; ++ks) {
      bf16x8 a[4], b[2];
#pragma unroll
      for (int mi = 0; mi < 4; ++mi) a[mi] = ldsfrag(sa, sw128(128 * wm + 32 * mi + lr, 2 * ks + lh));
#pragma unroll
      for (int ni = 0; ni < 2; ++ni) b[ni] = ldsfrag(sb, sw128(64 * wn + 32 * ni + lr, 2 * ks + lh));
#pragma unroll
      for (int mi = 0; mi < 4; ++mi)
#pragma unroll
        for (int ni = 0; ni < 2; ++ni) acc[mi][ni] = MFMA(b[ni], a[mi], acc[mi][ni]);
    }
  }
}

DI bool tile_of(int it, int NT, int& mt, int& nt) {
  const int G = gridDim.x, b = blockIdx.x;
  const int rb = ((G & 7) == 0) ? ((b & 7) * (G >> 3) + (b >> 3)) : b;
  const int L = it * G + rb;
  if (L >= NMT * NT) return false;
  const int nig = 8 * NT, gid = L / nig, fm = gid * 8, gsz = (NMT - fm) < 8 ? (NMT - fm) : 8, w = L - gid * nig;
  mt = fm + (w % gsz); nt = w / gsz;
  return true;
}

template <int EPI>
DI void gemm_phase(const Params& p, const u16* A, int lda, const u16* Bt, int ldb, int K, int NT, float f, char* smem) {
  float* x = (float*)(p.ws + X_OFF);
  u16* xb = (u16*)(p.ws + XB_OFF);
  float* ssq = (float*)(p.ws + SSQ_OFF);
  u16* P = (u16*)(p.ws + P_OFF);
  const int tid_ = otid512(), lane = tid_ & 63, wid = tid_ >> 6, wm = wid >> 2, wn = wid & 3, lr = lane & 31, lh = lane >> 5;
  for (int it = 0;; ++it) {
    int mt, nt;
    if (!tile_of(it, NT, mt, nt)) break;
    f32x16 acc[4][2];
    gemm_core(A + (size_t)(mt * 256) * lda, lda, Bt + (size_t)(nt * 256) * ldb, ldb, K, smem, acc);
#pragma unroll
    for (int mi = 0; mi < 4; ++mi) {
      const int row = mt * 256 + 128 * wm + 32 * mi + lr;
      const bool valid = row < T_TOK;
      const int rowc = valid ? row : 0;
      if (EPI == EPI_GU) {
        const float rs = row_rs(ssq, rowc);
        u16* hrow = P + (size_t)rowc * DFF + 32 * (4 * nt + wn) + 4 * lh;
#pragma unroll
        for (int b = 0; b < 4; ++b) {
          float hv[4];
#pragma unroll
          for (int r = 0; r < 4; ++r) { float g = acc[mi][0][4 * b + r] * rs, u = acc[mi][1][4 * b + r] * rs; hv[r] = silu_(g) * u; }
          if (valid) st_bf4(hrow + 8 * b, hv[0], hv[1], hv[2], hv[3]);
        }
      } else if (EPI == EPI_WIN) {
        const float rs = row_rs(ssq, rowc);
#pragma unroll
        for (int ni = 0; ni < 2; ++ni)
#pragma unroll
          for (int b = 0; b < 4; ++b) {
            const int col = nt * 256 + 64 * wn + 32 * ni + 8 * b + 4 * lh;
            if (valid) st_bf4(P + (size_t)row * PLD + col, acc[mi][ni][4 * b] * rs, acc[mi][ni][4 * b + 1] * rs, acc[mi][ni][4 * b + 2] * rs, acc[mi][ni][4 * b + 3] * rs);
          }
      } else {
        float ss = 0.f;
        float4 xo[2][4];
#pragma unroll
        for (int ni = 0; ni < 2; ++ni)
#pragma unroll
          for (int b = 0; b < 4; ++b) xo[ni][b] = *(const float4*)(x + (size_t)rowc * DM + nt * 256 + 64 * wn + 32 * ni + 8 * b + 4 * lh);
#pragma unroll
        for (int ni = 0; ni < 2; ++ni)
#pragma unroll
          for (int b = 0; b < 4; ++b) {
            const int col = nt * 256 + 64 * wn + 32 * ni + 8 * b + 4 * lh;
            float4 v = xo[ni][b];
            v.x += f * acc[mi][ni][4 * b]; v.y += f * acc[mi][ni][4 * b + 1]; v.z += f * acc[mi][ni][4 * b + 2]; v.w += f * acc[mi][ni][4 * b + 3];
            if (valid) {
              *(float4*)(x + (size_t)row * DM + col) = v;
              st_bf4(xb + (size_t)row * DM + col, v.x, v.y, v.z, v.w);
            }
            ss += v.x * v.x + v.y * v.y + v.z * v.z + v.w * v.w;
          }
        ss += __shfl_xor(ss, 32);
        if (lh == 0 && valid) ssq[(size_t)row * 16 + 4 * nt + wn] = ss;
      }
    }
  }
}

DI void merge_phase(const Params& p, char* smem) {
  const u16* xb = (const u16*)(p.ws + XB_OFF);
  const float* ssq = (const float*)(p.ws + SSQ_OFF);
  u16* P = (u16*)(p.ws + P_OFF);
  const u16* W = (const u16*)(p.ws + W_OFF);
  for (int it = 0;; ++it) {
    int mt, nt;
    if (!tile_of(it, 4, mt, nt)) break;
#pragma unroll 1
    for (int pass = 0; pass < 2; ++pass) {
      f32x16 acc[4][2];
      const int tmpc = pass ? PC_Z : PC_MRG;
      gemm_core(P + (size_t)(mt * 256) * PLD + (pass ? PC_Y : PC_OA), PLD, W + (pass ? WB_BB : WB_BA) + (size_t)(nt * 256) * DM, DM, DM, smem, acc);
      {
      const int t2 = otid512(), lane = t2 & 63, wid = t2 >> 6, wm = wid >> 2, wn = wid & 3, lr = lane & 31, lh = lane >> 5;
#pragma unroll
      for (int mi = 0; mi < 4; ++mi) {
        const int row = mt * 256 + 128 * wm + 32 * mi + lr;
        if (row < T_TOK) {
#pragma unroll
          for (int ni = 0; ni < 2; ++ni)
#pragma unroll
            for (int b = 0; b < 4; ++b)
              st_bf4(P + (size_t)row * PLD + tmpc + nt * 256 + 64 * wn + 32 * ni + 8 * b + 4 * lh, acc[mi][ni][4 * b], acc[mi][ni][4 * b + 1], acc[mi][ni][4 * b + 2], acc[mi][ni][4 * b + 3]);
        }
      }
      }
      gemm_core(xb + (size_t)(mt * 256) * DM, DM, W + WB_WG + (size_t)(pass * 1024 + nt * 256) * DM, DM, DM, smem, acc);
      const int t3 = otid512(), lane = t3 & 63, wid = t3 >> 6, wm = wid >> 2, wn = wid & 3, lr = lane & 31, lh = lane >> 5;
#pragma unroll
      for (int mi = 0; mi < 4; ++mi) {
        const int row = mt * 256 + 128 * wm + 32 * mi + lr;
        const bool valid = row < T_TOK;
        const int rowc = valid ? row : 0;
        const float rs = row_rs(ssq, rowc);
        uint2 mainr[2][4], prevr[2][4];
#pragma unroll
        for (int ni = 0; ni < 2; ++ni)
#pragma unroll
          for (int b = 0; b < 4; ++b) {
            const size_t off = (size_t)rowc * PLD + nt * 256 + 64 * wn + 32 * ni + 8 * b + 4 * lh;
            mainr[ni][b] = *(const uint2*)(P + off + tmpc);
            prevr[ni][b] = make_uint2(0u, 0u);
            if (pass) prevr[ni][b] = *(const uint2*)(P + off + PC_MRG);
          }
        float4 mainv[2][4], prev[2][4];
#pragma unroll
        for (int ni = 0; ni < 2; ++ni)
#pragma unroll
          for (int b = 0; b < 4; ++b) {
            const uint2 a = mainr[ni][b], c = prevr[ni][b];
            mainv[ni][b] = make_float4(__uint_as_float(a.x << 16), __uint_as_float(a.x & 0xffff0000u), __uint_as_float(a.y << 16), __uint_as_float(a.y & 0xffff0000u));
            prev[ni][b] = make_float4(__uint_as_float(c.x << 16), __uint_as_float(c.x & 0xffff0000u), __uint_as_float(c.y << 16), __uint_as_float(c.y & 0xffff0000u));
          }
#pragma unroll
        for (int ni = 0; ni < 2; ++ni)
#pragma unroll
          for (int b = 0; b < 4; ++b) {
            u16* op = P + (size_t)rowc * PLD + PC_MRG + nt * 256 + 64 * wn + 32 * ni + 8 * b + 4 * lh;
            if (valid)
              st_bf4(op, prev[ni][b].x + sigmoid_(acc[mi][ni][4 * b] * rs) * mainv[ni][b].x, prev[ni][b].y + sigmoid_(acc[mi][ni][4 * b + 1] * rs) * mainv[ni][b].y,
                     prev[ni][b].z + sigmoid_(acc[mi][ni][4 * b + 2] * rs) * mainv[ni][b].z, prev[ni][b].w + sigmoid_(acc[mi][ni][4 * b + 3] * rs) * mainv[ni][b].w);
          }
        __builtin_amdgcn_sched_barrier(0);
      }
    }
  }
}

DI void wconv_tile(const Params& p, int l, int t, char* smem) {
  u16* W = (u16*)(p.ws + W_OFF);
  const float* src; const float* fold = nullptr; int ld, K, map = 0; u16* dst; int tn, tk;
  if (t < 7104) {
    int ntk;
    if (t < 1408) { src = p.in[8] + (size_t)l * 1024 * 5632; ld = 5632; K = 1024; fold = p.in[7] + l * 1024; map = 1; dst = W + WB_GU1; }
    else if (t < 2112) { t -= 1408; src = p.in[9] + (size_t)l * 2816 * 1024; ld = 1024; K = 2816; dst = W + WB_DN1; }
    else if (t < 3712) { t -= 2112; src = p.in[11] + (size_t)l * 1024 * 8208; ld = 8208; K = 1024; fold = p.in[10] + l * 1024; map = 2; dst = W + WB_WIN; }
    else if (t < 4224) { t -= 3712; src = p.in[11] + (size_t)l * 1024 * 8208 + 6160; ld = 8208; K = 1024; fold = p.in[10] + l * 1024; dst = W + WB_WG; }
    else if (t < 4480) { t -= 4224; src = p.in[23] + (size_t)l * 1048576; ld = 1024; K = 1024; dst = W + WB_BA; }
    else if (t < 4736) { t -= 4480; src = p.in[24] + (size_t)l * 1048576; ld = 1024; K = 1024; dst = W + WB_BB; }
    else if (t < 4992) { t -= 4736; src = p.in[25] + (size_t)l * 1048576; ld = 1024; K = 1024; dst = W + WB_WO; }
    else if (t < 6400) { t -= 4992; src = p.in[27] + (size_t)l * 1024 * 5632; ld = 5632; K = 1024; fold = p.in[26] + l * 1024; map = 1; dst = W + WB_GU2; }
    else { t -= 6400; src = p.in[28] + (size_t)l * 2816 * 1024; ld = 1024; K = 2816; dst = W + WB_DN2; }
    ntk = K >> 6; tn = t / ntk; tk = t - tn * ntk;
  } else {
    t -= 7104;
    const int mat = t >> 5, n = (t >> 2) & 7;
    src = p.in[mat ? 20 : 18] + (size_t)l * 131072 + n * 16384; ld = 128; K = 128;
    dst = W + (mat ? WB_WI : WB_WR) + n * 16384; tn = (t >> 1) & 1; tk = t & 1;
  }
  u16* tl = (u16*)smem;
  const int tid = otid(), nl = tid & 63, kl = tid >> 6;
  const int np = tn * 64 + nl;
  int sc = np;
  if (map == 1) sc = ((np >> 5) & 1) * 2816 + 32 * (np >> 6) + (np & 31);
  else if (map == 2) sc = np < 4096 ? np : (np < 6144 ? np + 16 : (np < 6152 ? 4096 + (np - 6144) : (np < 6160 ? 4104 + (np - 6152) : -1)));
  __syncthreads();
#pragma unroll
  for (int i = 0; i < 16; ++i) {
    const int k = tk * 64 + kl + 4 * i;
    float v = 0.f;
    if (sc >= 0) { v = src[(size_t)k * ld + sc]; if (fold) v *= fold[k]; }
    tl[nl * 66 + kl + 4 * i] = f2bf(v);
  }
  __syncthreads();
  const int n = tid >> 2, kq = tid & 3;
  const unsigned* rp = (const unsigned*)(tl + n * 66 + 16 * kq);
  uint4 o0, o1;
  o0.x = rp[0]; o0.y = rp[1]; o0.z = rp[2]; o0.w = rp[3]; o1.x = rp[4]; o1.y = rp[5]; o1.z = rp[6]; o1.w = rp[7];
  uint4* dp = (uint4*)(dst + (size_t)(tn * 64 + n) * K + tk * 64 + 16 * kq);
  dp[0] = o0; dp[1] = o1;
}

DI void gather_item(const Params& p, int item, char* smem) {
  float* x = (float*)(p.ws + X_OFF);
  u16* xb = (u16*)(p.ws + XB_OFF);
  float* ssq = (float*)(p.ws + SSQ_OFF);
  float* red = (float*)smem;
  const int tid = otid();
  for (int rr = 0; rr < 8; ++rr) {
    const int row = item * 8 + rr;
    const float* src;
    if (row < 16512) { const int s = row / 2064, pos = row - s * 2064; src = pos < 16 ? p.in[6] + pos * 1024 : p.in[0] + ((size_t)s * 2048 + (pos - 16)) * 1024; }
    else src = p.in[1] + (size_t)(row - 16512) * 1024;
    float4 v = ((const float4*)src)[tid];
    ((float4*)(x + (size_t)row * DM))[tid] = v;
    st_bf4(xb + (size_t)row * DM + 4 * tid, v.x, v.y, v.z, v.w);
    float ss = v.x * v.x + v.y * v.y + v.z * v.z + v.w * v.w;
#pragma unroll
    for (int o = 32; o > 0; o >>= 1) ss += __shfl_xor(ss, o);
    __syncthreads();
    if ((tid & 63) == 0) red[tid >> 6] = ss;
    __syncthreads();
    if (tid < 16) ssq[(size_t)row * 16 + tid] = (tid == 0) ? (red[0] + red[1] + red[2] + red[3]) : 0.f;
  }
}

DI void final_phase(const Params& p, int vb, int nvb) {
  const float* x = (const float*)(p.ws + X_OFF);
  const float* ssq = (const float*)(p.ws + SSQ_OFF);
  const int tid = otid();
  const float4 fw = ((const float4*)p.in[29])[tid];
  for (int row = vb; row < T_TOK; row += nvb) {
    float* dst;
    if (row < 16512) { const int s = row / 2064, pos = row - s * 2064; if (pos < 16) continue; dst = p.out + O_YP + ((size_t)s * 2048 + (pos - 16)) * 1024; }
    else dst = p.out + O_YS + (size_t)(row - 16512) * 1024;
    const float rs = row_rs(ssq, row);
    float4 v = ((const float4*)(x + (size_t)row * DM))[tid];
    v.x *= rs * fw.x; v.y *= rs * fw.y; v.z *= rs * fw.z; v.w *= rs * fw.w;
    ((float4*)dst)[tid] = v;
  }
}

struct CI { int r0, nv, sbase, stream, last, sample; };
DI CI chunk_info(int ci) {
  CI c;
  if (ci < 264) {
    const int s = ci / 33, k = ci - s * 33;
    c.stream = s; c.sbase = s * 2064; c.sample = 0;
    if (k == 0) { c.r0 = c.sbase; c.nv = 16; } else { c.r0 = c.sbase + 16 + 64 * (k - 1); c.nv = 64; }
    c.last = (k == 32);
  } else {
    const int s = ci - 264;
    c.stream = 8 + s; c.sbase = 16512 + 32 * s; c.r0 = c.sbase; c.nv = 32; c.last = 1; c.sample = 1;
  }
  return c;
}

DI void dconv_store(const Params& p, int l, const CI& c, int cc, int ch, int half, char* RM, char* RT, float* cqo) {
  const u16* P = (const u16*)(p.ws + P_OFF);
  const float* cwp = p.in[12] + (size_t)l * 4 * 3072 + cc;
  const float w0 = cwp[0], w1 = cwp[3072], w2 = cwp[2 * 3072], w3 = cwp[3 * 3072];
  const int pad = 64 - c.nv, t0 = 32 * half;
  float r[35];
  const int rowb = c.r0 + t0 - 3 - pad;
#pragma unroll
  for (int i = 0; i < 35; ++i) {
    int rowu = rowb + i;
    rowu = rowu < c.sbase ? c.sbase : rowu;
    r[i] = bf2f(P[(unsigned)rowu * (unsigned)PLD + (unsigned)cc]);
  }
  float hist[3] = {0.f, 0.f, 0.f};
  if (c.sample) {
#pragma unroll
    for (int j = 0; j < 3; ++j) hist[j] = p.in[3][((size_t)(l * 16 + (c.stream - 8)) * 3 + j) * 3072 + cc];
  }
#pragma unroll
  for (int i = 0; i < 35; ++i) {
    const int u = t0 - 3 + i, rowu = rowb + i;
    if (u < pad - 3) r[i] = 0.f;
    else if (rowu < c.sbase) { const int j = 3 + rowu - c.sbase; r[i] = (j == 0) ? hist[0] : (j == 1 ? hist[1] : hist[2]); }
  }
#pragma unroll
  for (int q = 0; q < 4; ++q) {
    const int tq = t0 + 8 * q;
    float o[8];
#pragma unroll
    for (int i = 0; i < 8; ++i) {
      const float sv = r[8 * q + i] * w0 + r[8 * q + i + 1] * w1 + r[8 * q + i + 2] * w2 + r[8 * q + i + 3] * w3;
      o[i] = (tq + i >= pad) ? silu_(sv) : 0.f;
    }
    if (RM) {
#pragma unroll
      for (int i = 0; i < 8; ++i) *(u16*)(RM + sw256(tq + i, ch >> 3) + (ch & 7) * 2) = f2bf(o[i]);
    }
    if (RT) {
      u32x4 v; v[0] = pk2(o[0], o[1]); v[1] = pk2(o[2], o[3]); v[2] = pk2(o[4], o[5]); v[3] = pk2(o[6], o[7]);
      *(u32x4*)(RT + sw128(ch, 4 * half + q)) = v;
    }
  }
  if (half && c.last) { cqo[cc] = r[32]; cqo[3072 + cc] = r[33]; cqo[6144 + cc] = r[34]; }
}

DI void delta_pre_item(const Params& p, int l, int it, char* smem) {
  const int ci = it >> 3, h = it & 7;
  const CI c = chunk_info(ci);
  const u16* P = (const u16*)(p.ws + P_OFF);
  char* R0 = smem; char* R1 = smem + 16384; char* R2 = smem + 32768; float* Lm = (float*)(smem + 49152);
  float* sBeta = (float*)(smem + 65536); float* sGc = sBeta + 64; float* sNk = sBeta + 128; float* sNq = sBeta + 192;
  const int tid = otid(), lane = tid & 63, wid = tid >> 6, lr = lane & 31, lh = lane >> 5;
  const int ch = tid & 127, half = tid >> 7, t0 = 32 * half;
  const int pad = 64 - c.nv;
  float* cqo = p.out + (c.sample ? O_SCQ + ((size_t)(l * 16 + (c.stream - 8)) * 3) * 3072 : O_PCQ + ((size_t)(l * 8 + c.stream) * 3) * 3072);
  __syncthreads();
  dconv_store(p, l, c, h * 128 + ch, ch, half, R0, nullptr, cqo);
  dconv_store(p, l, c, 1024 + h * 128 + ch, ch, half, R1, R2, cqo);
  if (tid < 64) {
    float beta = 0.f, g = 0.f;
    if (tid >= pad) {
      const size_t row = (size_t)(c.r0 + tid - pad);
      beta = sigmoid_(bf2f(P[row * PLD + PC_BETA + h]));
      g = -__expf(p.in[13][l * 8 + h]) * softplus_(bf2f(P[row * PLD + PC_ALPHA + h]) + p.in[14][l * 8 + h]);
    }
#pragma unroll
    for (int o = 1; o < 64; o <<= 1) { const float v = __shfl_up(g, o); if (lane >= o) g += v; }
    sBeta[tid] = beta; sGc[tid] = g;
  }
  __syncthreads();
  const int ti = wid >> 1, tj = wid & 1;
  f32x16 aQK, aKK, aQQ;
  zero16(aQK); zero16(aKK); zero16(aQQ);
#pragma unroll
  for (int ks = 0; ks < 8; ++ks) {
    const bf16x8 kf = ldsfrag(R1, sw256(32 * tj + lr, 2 * ks + lh));
    const bf16x8 qf = ldsfrag(R0, sw256(32 * ti + lr, 2 * ks + lh));
    const bf16x8 kif = ldsfrag(R1, sw256(32 * ti + lr, 2 * ks + lh));
    aQK = MFMA(kf, qf, aQK);
    aKK = MFMA(kf, kif, aKK);
    if (ti == tj) aQQ = MFMA(qf, qf, aQQ);
  }
  if (ti == tj && (((lr >> 2) & 1) == lh)) {
    float vk = 0.f, vq = 0.f;
#pragma unroll
    for (int reg = 0; reg < 16; ++reg) if (crow(reg, lh) == lr) { vk = aKK[reg]; vq = aQQ[reg]; }
    sNk[32 * ti + lr] = vk; sNq[32 * ti + lr] = vq;
  }
  __syncthreads();
  const size_t itb = (size_t)it;
  {
    u16* Ag = (u16*)(p.ws + A_OFF) + itb * 4096;
    const int i = 32 * ti + lr;
    const float gi = sGc[i], rqi = rsqrtf(sNq[i] + EPS) * 0.08838834764831845f, bki = sBeta[i] * rsqrtf(sNk[i] + EPS);
#pragma unroll
    for (int b = 0; b < 4; ++b) {
      float av[4], lv[4];
#pragma unroll
      for (int r = 0; r < 4; ++r) {
        const int j = 32 * tj + 8 * b + 4 * lh + r;
        const float rkj = rsqrtf(sNk[j] + EPS);
        const float dec = (j <= i) ? __expf(gi - sGc[j]) : 0.f;
        av[r] = rqi * rkj * aQK[4 * b + r] * dec;
        lv[r] = (j < i) ? bki * rkj * aKK[4 * b + r] * dec : 0.f;
      }
      st_bf4(Ag + i * 64 + 16 * (2 * tj + (b >> 1)) + 8 * lh + 4 * (b & 1), av[0], av[1], av[2], av[3]);
      *(float4*)(Lm + i * 64 + 32 * tj + 8 * b + 4 * lh) = make_float4(lv[0], lv[1], lv[2], lv[3]);
      if (wid == 2) st_bf4((u16*)(smem + 66560) + lr * 32 + 8 * b + 4 * lh, lv[0], lv[1], lv[2], lv[3]);
    }
    u16* Qg = (u16*)(p.ws + QD_OFF) + itb * 8192;
    u16* Kg = (u16*)(p.ws + KD_OFF) + itb * 8192;
    const float glc = sGc[63];
#pragma unroll
    for (int ii = 0; ii < 4; ++ii) {
      const int q = tid + 256 * ii;
      {
        const int t = q >> 4, chn = q & 15, s = chn >> 1, hh = chn & 1;
        const float sc = rsqrtf(sNq[t] + EPS) * 0.08838834764831845f * __expf(sGc[t]);
        const int c0 = 16 * s + 4 * hh, c1 = c0 + 8;
        const float4 v0 = ld_bf4((const u16*)(R0 + sw256(t, c0 >> 3) + (c0 & 7) * 2));
        const float4 v1 = ld_bf4((const u16*)(R0 + sw256(t, c1 >> 3) + (c1 & 7) * 2));
        uint4 o; o.x = pk2(v0.x * sc, v0.y * sc); o.y = pk2(v0.z * sc, v0.w * sc); o.z = pk2(v1.x * sc, v1.y * sc); o.w = pk2(v1.z * sc, v1.w * sc);
        *(uint4*)(Qg + t * 128 + 8 * chn) = o;
      }
      {
        const int dk = q >> 3, chn = q & 7, s = chn >> 1, hh = chn & 1;
        const int ta = 16 * s + 4 * hh, tb = ta + 8;
        const float4 v0 = ld_bf4((const u16*)(R2 + sw128(dk, ta >> 3) + (ta & 7) * 2));
        const float4 v1 = ld_bf4((const u16*)(R2 + sw128(dk, tb >> 3) + (tb & 7) * 2));
        float sa[4], sb[4];
#pragma unroll
        for (int r = 0; r < 4; ++r) { sa[r] = rsqrtf(sNk[ta + r] + EPS) * __expf(glc - sGc[ta + r]); sb[r] = rsqrtf(sNk[tb + r] + EPS) * __expf(glc - sGc[tb + r]); }
        uint4 o; o.x = pk2(v0.x * sa[0], v0.y * sa[1]); o.y = pk2(v0.z * sa[2], v0.w * sa[3]); o.z = pk2(v1.x * sb[0], v1.y * sb[1]); o.w = pk2(v1.z * sb[2], v1.w * sb[3]);
        *(uint4*)(Kg + dk * 64 + 8 * chn) = o;
      }
    }
    if (tid == 0) ((float*)(p.ws + GL_OFF))[it] = __expf(glc);
  }
  __syncthreads();
  dconv_store(p, l, c, 2048 + h * 128 + ch, ch, half, nullptr, R0, cqo);
  {
    u16* L21b = (u16*)(smem + 66560); u16* T11t = (u16*)(smem + 68608); u16* T22b = (u16*)(smem + 70656);
    if (wid < 2) {
      const int blk = wid, cc = 32 * blk + lr;
      float tc[32];
#pragma unroll
      for (int i = 0; i < 32; ++i) tc[i] = 0.f;
#pragma unroll
      for (int i = 0; i < 32; ++i) {
        float sacc = (i == lr) ? 1.f : 0.f;
#pragma unroll
        for (int j4 = 0; j4 < i; j4 += 4) {
          const float4 lv = *(const float4*)(Lm + (32 * blk + i) * 64 + 32 * blk + j4);
          sacc -= lv.x * tc[j4]; sacc -= lv.y * tc[j4 + 1]; sacc -= lv.z * tc[j4 + 2]; sacc -= lv.w * tc[j4 + 3];
        }
        tc[i] = sacc;
      }
      if (lh == 0) {
        const float b1 = sBeta[cc], c1 = b1 * rsqrtf(sNk[cc] + EPS) * __expf(sGc[cc]);
#pragma unroll
        for (int i = 0; i < 32; ++i) {
          const int off = sw128(32 * blk + i, cc >> 3) + (cc & 7) * 2;
          *(u16*)(R1 + off) = f2bf(tc[i] * c1);
          *(u16*)(R1 + 8192 + off) = f2bf(tc[i] * b1);
        }
        if (blk == 0) {
#pragma unroll
          for (int q = 0; q < 4; ++q) {
            u32x4 v; v[0] = pk2(tc[8 * q], tc[8 * q + 1]); v[1] = pk2(tc[8 * q + 2], tc[8 * q + 3]); v[2] = pk2(tc[8 * q + 4], tc[8 * q + 5]); v[3] = pk2(tc[8 * q + 6], tc[8 * q + 7]);
            *(u32x4*)(T11t + lr * 32 + 8 * q) = v;
          }
        } else {
#pragma unroll
          for (int i = 0; i < 32; ++i) T22b[i * 32 + lr] = f2bf(tc[i]);
        }
      }
    } else {
#pragma unroll
      for (int i = 0; i < 2; ++i) {
        const int idx = (tid - 128) + 128 * i, mat = idx >> 7, rc = idx & 127;
        u32x4 z; z[0] = 0u; z[1] = 0u; z[2] = 0u; z[3] = 0u;
        *(u32x4*)(R1 + mat * 8192 + sw128(rc >> 2, 4 + (rc & 3))) = z;
      }
    }
    __syncthreads();
    if (wid == 0) {
      f32x16 Mx, D2;
      zero16(Mx); zero16(D2);
#pragma unroll
      for (int ks = 0; ks < 2; ++ks) {
        const bf16x8 xf = *(const bf16x8*)(L21b + lr * 32 + (2 * ks + lh) * 8);
        const bf16x8 yf = *(const bf16x8*)(T11t + lr * 32 + (2 * ks + lh) * 8);
        Mx = MFMA(xf, yf, Mx);
      }
#pragma unroll
      for (int sx = 0; sx < 2; ++sx) {
        const bf16x8 yp = sx ? pack8<1>(Mx) : pack8<0>(Mx);
        const uint2 lo = *(const uint2*)(T22b + lr * 32 + 16 * sx + 4 * lh);
        const uint2 hi = *(const uint2*)(T22b + lr * 32 + 16 * sx + 8 + 4 * lh);
        u32x4 xv; xv[0] = lo.x; xv[1] = lo.y; xv[2] = hi.x; xv[3] = hi.y;
        D2 = MFMA(__builtin_bit_cast(bf16x8, xv), yp, D2);
      }
      const float b1 = sBeta[lr], c1 = b1 * rsqrtf(sNk[lr] + EPS) * __expf(sGc[lr]);
#pragma unroll
      for (int r = 0; r < 16; ++r) {
        const int off = sw128(32 + crow(r, lh), lr >> 3) + (lr & 7) * 2;
        *(u16*)(R1 + off) = f2bf(-D2[r] * c1);
        *(u16*)(R1 + 8192 + off) = f2bf(-D2[r] * b1);
      }
    }
  }
  __syncthreads();
  {
    u16* Wg = (u16*)(p.ws + WW_OFF) + itb * 8192;
    u16* Ug = (u16*)(p.ws + UT_OFF) + itb * 8192;
    f32x16 aw[2], au[2];
    zero16(aw[0]); zero16(aw[1]); zero16(au[0]); zero16(au[1]);
#pragma unroll
    for (int ks = 0; ks < 4; ++ks) {
      const bf16x8 kT = ldsfrag(R2, sw128(32 * wid + lr, 2 * ks + lh));
      const bf16x8 vT = ldsfrag(R0, sw128(32 * wid + lr, 2 * ks + lh));
#pragma unroll
      for (int bb = 0; bb < 2; ++bb) {
        const bf16x8 t1 = ldsfrag(R1, sw128(32 * bb + lr, 2 * ks + lh));
        const bf16x8 t2 = ldsfrag(R1 + 8192, sw128(32 * bb + lr, 2 * ks + lh));
        aw[bb] = MFMA(kT, t1, aw[bb]);
        au[bb] = MFMA(t2, vT, au[bb]);
      }
    }
#pragma unroll
    for (int bb = 0; bb < 2; ++bb)
#pragma unroll
      for (int b = 0; b < 4; ++b) {
        st_bf4(Wg + (32 * bb + lr) * 128 + 32 * wid + 16 * (b >> 1) + 8 * lh + 4 * (b & 1), aw[bb][4 * b], aw[bb][4 * b + 1], aw[bb][4 * b + 2], aw[bb][4 * b + 3]);
        st_bf4(Ug + (32 * wid + lr) * 64 + 32 * bb + 8 * b + 4 * lh, au[bb][4 * b], au[bb][4 * b + 1], au[bb][4 * b + 2], au[bb][4 * b + 3]);
      }
  }
}

DI void delta_seq_item(const Params& p, int l, int item, char* smem) {
  const int stream = item >> 3, h = item & 7;
  const int tid = otid(), lane = tid & 63, wid = tid >> 6, lr = lane & 31, lh = lane >> 5;
  const int dv = 32 * wid + lr;
  u16* P = (u16*)(p.ws + P_OFF);
  f32x16 S[4];
  float* Sout;
  int nchunk, ci0;
  if (stream < 8) {
#pragma unroll
    for (int m = 0; m < 4; ++m) zero16(S[m]);
    Sout = p.out + O_PS + ((size_t)(l * 8 + stream) * 8 + h) * 16384;
    nchunk = 33; ci0 = stream * 33;
  } else {
    const float* S0 = p.in[2] + ((size_t)(l * 16 + (stream - 8)) * 8 + h) * 16384;
    const float* sp = S0 + (4 * lh) * 128 + dv;
#pragma unroll
    for (int m = 0; m < 4; ++m)
#pragma unroll
      for (int b = 0; b < 4; ++b) {
#pragma unroll
        for (int r = 0; r < 4; ++r) S[m][4 * b + r] = sp[r * 128];
        sp += 8 * 128;
        __builtin_amdgcn_sched_barrier(0);
      }
    Sout = p.out + O_SS + ((size_t)(l * 16 + (stream - 8)) * 8 + h) * 16384;
    nchunk = 1; ci0 = 264 + (stream - 8);
  }
  char* sW = smem; char* sQ = smem + 16384; char* sK = smem + 32768; char* sA = smem + 49152; char* sO = smem + 57344;
#define DMA256(gbase, lbase) { _Pragma("unroll") for (int ii = 0; ii < 4; ++ii) { const int pos = tid + 256 * ii, row = pos >> 4, chn = (pos & 15) ^ (row & 15); \
    __builtin_amdgcn_global_load_lds((const unsigned*)((gbase) + row * 128 + chn * 8), (lds_u32*)((lbase) + pos * 16), 16, 0, 0); } }
#define DMA128(gbase, lbase, n) { _Pragma("unroll") for (int ii = 0; ii < (n); ++ii) { const int pos = tid + 256 * ii, row = pos >> 3, chn = (pos & 7) ^ ((row >> 1) & 7); \
    __builtin_amdgcn_global_load_lds((const unsigned*)((gbase) + row * 64 + chn * 8), (lds_u32*)((lbase) + pos * 16), 16, 0, 0); } }
  __syncthreads();
  {
    const size_t it = (size_t)ci0 * 8 + h;
    const u16* Wg = (const u16*)(p.ws + WW_OFF) + it * 8192;
    const u16* Qg = (const u16*)(p.ws + QD_OFF) + it * 8192;
    DMA256(Wg, sW); DMA256(Qg, sQ);
  }
  asm volatile("s_waitcnt vmcnt(0)" ::: "memory");
  __syncthreads();
  for (int k = 0; k < nchunk; ++k) {
    const int ci = ci0 + k;
    const CI c = chunk_info(ci);
    const size_t it = (size_t)ci * 8 + h;
    const u16* Kg = (const u16*)(p.ws + KD_OFF) + it * 8192;
    const u16* Ag = (const u16*)(p.ws + A_OFF) + it * 4096;
    const u16* Ug = (const u16*)(p.ws + UT_OFF) + it * 8192;
    const float gl = ((const float*)(p.ws + GL_OFF))[it];
    if (k == 0) { DMA128(Kg, sK, 4); DMA128(Ag, sA, 2); }
    uint2 uvr[2][4];
#pragma unroll
    for (int m = 0; m < 2; ++m)
#pragma unroll
      for (int b = 0; b < 4; ++b) uvr[m][b] = *(const uint2*)(Ug + dv * 64 + 32 * m + 8 * b + 4 * lh);
    const int et = tid >> 2, eq = tid & 3, epad = 64 - c.nv;
    const bool erow = (et >= epad);
    const size_t erow_off = (size_t)(c.r0 + (erow ? et - epad : 0)) * PLD + h * 128 + 32 * eq;
    f32x16 M1[2], M2[2];
    zero16(M1[0]); zero16(M1[1]); zero16(M2[0]); zero16(M2[1]);
#pragma unroll
    for (int mt = 0; mt < 4; ++mt) {
#pragma unroll
      for (int sx = 0; sx < 2; ++sx) {
        const int ks = 2 * mt + sx;
        const bf16x8 Sp = sx ? pack8<1>(S[mt]) : pack8<0>(S[mt]);
#pragma unroll
        for (int m = 0; m < 2; ++m) {
          const bf16x8 wf = ldsfrag(sW, sw256(32 * m + lr, 2 * ks + lh));
          const bf16x8 qf = ldsfrag(sQ, sw256(32 * m + lr, 2 * ks + lh));
          M1[m] = MFMA(wf, Sp, M1[m]);
          M2[m] = MFMA(qf, Sp, M2[m]);
        }
      }
    }
    asm volatile("s_waitcnt vmcnt(0)" ::: "memory");
    __syncthreads();
    const bool more = (k + 1 < nchunk);
    if (more) {
      const u16* Wg = (const u16*)(p.ws + WW_OFF) + (it + 8) * 8192;
      const u16* Qg = (const u16*)(p.ws + QD_OFF) + (it + 8) * 8192;
      DMA256(Wg, sW); DMA256(Qg, sQ);
    }
    uint2 zr[8];
#pragma unroll
    for (int i = 0; i < 8; ++i) zr[i] = *(const uint2*)(P + erow_off + PC_Z + 4 * i);
#pragma unroll
    for (int m = 0; m < 2; ++m)
#pragma unroll
      for (int b = 0; b < 4; ++b) {
        const uint2 u2 = uvr[m][b];
        M1[m][4 * b] = __uint_as_float(u2.x << 16) - M1[m][4 * b]; M1[m][4 * b + 1] = __uint_as_float(u2.x & 0xffff0000u) - M1[m][4 * b + 1];
        M1[m][4 * b + 2] = __uint_as_float(u2.y << 16) - M1[m][4 * b + 2]; M1[m][4 * b + 3] = __uint_as_float(u2.y & 0xffff0000u) - M1[m][4 * b + 3];
      }
    bf16x8 Vp[4];
    Vp[0] = pack8<0>(M1[0]); Vp[1] = pack8<1>(M1[0]); Vp[2] = pack8<0>(M1[1]); Vp[3] = pack8<1>(M1[1]);
#pragma unroll
    for (int mt = 0; mt < 4; ++mt) {
#pragma unroll
      for (int r = 0; r < 16; ++r) S[mt][r] *= gl;
#pragma unroll
      for (int kk = 0; kk < 4; ++kk) {
        const bf16x8 kf = ldsfrag(sK, sw128(32 * mt + lr, 2 * kk + lh));
        S[mt] = MFMA(kf, Vp[kk], S[mt]);
      }
    }
#pragma unroll
    for (int m = 0; m < 2; ++m)
#pragma unroll
      for (int kk = 0; kk < 4; ++kk) {
        const bf16x8 af = ldsfrag(sA, sw128(32 * m + lr, 2 * kk + lh));
        M2[m] = MFMA(af, Vp[kk], M2[m]);
      }
#pragma unroll
    for (int m = 0; m < 2; ++m)
#pragma unroll
      for (int r = 0; r < 16; ++r) *(u16*)(sO + (32 * m + crow(r, lh)) * 256 + dv * 2) = f2bf(M2[m][r]);
    asm volatile("s_waitcnt vmcnt(0)" ::: "memory");
    __syncthreads();
    if (more) { DMA128(Kg + 8 * 8192, sK, 4); DMA128(Ag + 8 * 4096, sA, 2); }
    {
      float ov[32];
      float ss = 0.f;
#pragma unroll
      for (int i = 0; i < 4; ++i) {
        const u32x4 t4 = *(const u32x4*)(sO + et * 256 + 64 * eq + 16 * i);
#pragma unroll
        for (int e = 0; e < 4; ++e) {
          const float a0 = __uint_as_float(t4[e] << 16), a1 = __uint_as_float(t4[e] & 0xffff0000u);
          ov[8 * i + 2 * e] = a0; ov[8 * i + 2 * e + 1] = a1; ss += a0 * a0 + a1 * a1;
        }
      }
      ss += __shfl_xor(ss, 1); ss += __shfl_xor(ss, 2);
      const float rs = rsqrtf(ss * (1.f / 128.f) + EPS);
      if (erow) {
        u16* op = P + erow_off + PC_OA;
        const float* nw = p.in[15] + l * 128 + 32 * eq;
#pragma unroll
        for (int i = 0; i < 8; ++i) {
          const float zx = __uint_as_float(zr[i].x << 16), zy = __uint_as_float(zr[i].x & 0xffff0000u), zz = __uint_as_float(zr[i].y << 16), zw = __uint_as_float(zr[i].y & 0xffff0000u);
          const float4 w4 = *(const float4*)(nw + 4 * i);
          st_bf4(op + 4 * i, ov[4 * i] * rs * w4.x * silu_(zx), ov[4 * i + 1] * rs * w4.y * silu_(zy), ov[4 * i + 2] * rs * w4.z * silu_(zz), ov[4 * i + 3] * rs * w4.w * silu_(zw));
        }
      }
    }
  }
#undef DMA256
#undef DMA128
  float* so = Sout + (4 * lh) * 128 + dv;
#pragma unroll
  for (int m = 0; m < 4; ++m)
#pragma unroll
    for (int b = 0; b < 4; ++b) {
#pragma unroll
      for (int r = 0; r < 4; ++r) so[r * 128] = S[m][4 * b + r];
      so += 8 * 128;
      __builtin_amdgcn_sched_barrier(0);
    }
}

struct LT { int r0, nv, first, last, stream; };
DI LT lru_tile(int tl) {
  LT t;
  if (tl < 520) { const int s = tl / 65, j = tl - s * 65; t.stream = s; t.first = (j == 0); t.last = (j == 64); t.nv = j ? 32 : 16; t.r0 = s * 2064 + (j ? 16 + 32 * (j - 1) : 0); }
  else { const int s = tl - 520; t.stream = 8 + s; t.first = 1; t.last = 1; t.nv = 32; t.r0 = 16512 + 32 * s; }
  return t;
}
DI void lru_a_item(const Params& p, int l, int item, char* smem) {
  const int tl = item >> 3, n = item & 7;
  const LT T = lru_tile(tl);
  const int tid = otid(), lane = tid & 63, wid = tid >> 6, lr = lane & 31, lh = lane >> 5;
  u16* P = (u16*)(p.ws + P_OFF);
  u16* Ya = (u16*)(p.out + O_YP);
  const u16* W = (const u16*)(p.ws + W_OFF);
  float* AG = (float*)(p.ws + AG_OFF);
  float* raw = (float*)smem; float* xc = (float*)(smem + 18432); char* xcb = smem + 34816;
  const int ch = tid & 127, rp = tid >> 7;
  const int gc = n * 128 + ch;
  const int d = 32 * wid + lr, gd = n * 128 + d;
  float lyv[16];
#pragma unroll
  for (int r = 0; r < 16; ++r) { const int t = crow(r, lh); lyv[r] = (t < T.nv) ? bf2f(P[(size_t)(T.r0 + t) * PLD + PC_LY + gd]) : 0.f; }
  bf16x8 wrf[8], wif[8];
#pragma unroll
  for (int ks = 0; ks < 8; ++ks) {
    wrf[ks] = *(const bf16x8*)(W + WB_WR + n * 16384 + d * 128 + (2 * ks + lh) * 8);
    wif[ks] = *(const bf16x8*)(W + WB_WI + n * 16384 + d * 128 + (2 * ks + lh) * 8);
  }
  const float* cwp = p.in[16] + (size_t)l * 4 * 1024 + gc;
  const float cw0 = cwp[0], cw1 = cwp[1024], cw2 = cwp[2048], cw3 = cwp[3072], cb = p.in[17][l * 1024 + gc];
  const float br = p.in[19][l * 1024 + gd], bi = p.in[21][l * 1024 + gd];
  const float c8 = -8.f * softplus_(-p.in[22][l * 1024 + gd]);
  __syncthreads();
#pragma unroll
  for (int i = 0; i < 18; ++i) {
    const int rr = rp + 2 * i;
    if (rr < 3 + T.nv) {
      float v;
      if (rr >= 3 || !T.first) v = bf2f(P[(size_t)(T.r0 + rr - 3) * PLD + PC_LX + gc]);
      else v = (T.stream >= 8) ? p.in[5][((size_t)(l * 16 + (T.stream - 8)) * 3 + rr) * 1024 + gc] : 0.f;
      raw[rr * 128 + ch] = v;
    }
  }
  __syncthreads();
#pragma unroll 4
  for (int t = rp; t < 32; t += 2) {
    float v = 0.f;
    if (t < T.nv) v = cb + raw[t * 128 + ch] * cw0 + raw[(t + 1) * 128 + ch] * cw1 + raw[(t + 2) * 128 + ch] * cw2 + raw[(t + 3) * 128 + ch] * cw3;
    xc[t * 128 + ch] = v;
    *(u16*)(xcb + sw256(t, ch >> 3) + (ch & 7) * 2) = f2bf(v);
  }
  if (T.last && tid < 128) {
    float* ocx = (T.stream < 8) ? p.out + O_PCX + (size_t)(l * 8 + T.stream) * 3 * 1024 : p.out + O_SCX + (size_t)(l * 16 + (T.stream - 8)) * 3 * 1024;
    ocx[gc] = raw[T.nv * 128 + ch]; ocx[1024 + gc] = raw[(T.nv + 1) * 128 + ch]; ocx[2048 + gc] = raw[(T.nv + 2) * 128 + ch];
  }
  __syncthreads();
  f32x16 aR, aI;
  zero16(aR); zero16(aI);
#pragma unroll
  for (int ks = 0; ks < 8; ++ks) {
    const bf16x8 af = ldsfrag(xcb, sw256(lr, 2 * ks + lh));
    aR = MFMA(af, wrf[ks], aR);
    aI = MFMA(af, wif[ks], aI);
  }
  float av[16], bv[16], hv[16], pv[16];
#pragma unroll
  for (int r = 0; r < 16; ++r) {
    const int t = crow(r, lh);
    const float rr = sigmoid_(aR[r] + br), ig = sigmoid_(aI[r] + bi);
    const float la = c8 * rr;
    const float a = __expf(la), mult = sqrtf(fmaxf(1.f - __expf(2.f * la), 0.f));
    const float xv = xc[t * 128 + d];
    av[r] = (t < T.nv) ? a : 1.f;
    bv[r] = (t < T.nv) ? mult * ig * xv : 0.f;
  }
  float hc = 0.f, pc = 1.f;
#pragma unroll
  for (int b = 0; b < 4; ++b) {
    float cA = hc, qA = pc, tA[4], uA[4], tB[4], uB[4];
#pragma unroll
    for (int r = 0; r < 4; ++r) { cA = av[4 * b + r] * cA + bv[4 * b + r]; qA = av[4 * b + r] * qA; tA[r] = cA; uA[r] = qA; }
    hc = __shfl(cA, lr); pc = __shfl(qA, lr);
    float cB = hc, qB = pc;
#pragma unroll
    for (int r = 0; r < 4; ++r) { cB = av[4 * b + r] * cB + bv[4 * b + r]; qB = av[4 * b + r] * qB; tB[r] = cB; uB[r] = qB; }
    hc = __shfl(cB, lr + 32); pc = __shfl(qB, lr + 32);
#pragma unroll
    for (int r = 0; r < 4; ++r) { hv[4 * b + r] = lh ? tB[r] : tA[r]; pv[4 * b + r] = lh ? uB[r] : uA[r]; }
  }
#pragma unroll
  for (int r = 0; r < 16; ++r) {
    const int t = crow(r, lh);
    if (t < T.nv) {
      const float g = gelu_tanh_(lyv[r]);
      P[(size_t)(T.r0 + t) * PLD + PC_LY + gd] = f2bf(hv[r] * g);
      Ya[(size_t)(T.r0 + t) * 1024 + gd] = f2bf(pv[r] * g);
    }
  }
  if (lh == 0) { AG[(size_t)(tl * 2) * 1024 + gd] = pc; AG[(size_t)(tl * 2 + 1) * 1024 + gd] = hc; }
}

DI void lru_b_item(const Params& p, int l, int item, char* smem) {
  const int tid = otid();
  u16* P = (u16*)(p.ws + P_OFF);
  const u16* Ya = (const u16*)(p.out + O_YP);
  const float* AG = (const float*)(p.ws + AG_OFF);
  float* cin = (float*)smem;
  int stream, n, qtr, ntile, tl0, rbase, L;
  if (item < 256) { stream = item >> 5; n = (item >> 2) & 7; qtr = item & 3; ntile = 65; tl0 = stream * 65; rbase = stream * 2064; L = 2064; }
  else { const int q = item - 256; stream = 8 + (q >> 3); n = q & 7; qtr = -1; ntile = 1; tl0 = 520 + (stream - 8); rbase = 16512 + 32 * (stream - 8); L = 32; }
  __syncthreads();
  if (tid < 128) {
    const int gd = n * 128 + tid;
    float c = (stream >= 8) ? p.in[4][(size_t)(l * 16 + (stream - 8)) * 1024 + gd] : 0.f;
#pragma unroll 13
    for (int j = 0; j < ntile; ++j) {
      const float a = AG[(size_t)((tl0 + j) * 2) * 1024 + gd], h = AG[(size_t)((tl0 + j) * 2 + 1) * 1024 + gd];
      cin[j * 128 + tid] = c;
      c = a * c + h;
    }
    if (qtr <= 0) {
      float* oh = (stream < 8) ? p.out + O_PH + (size_t)(l * 8 + stream) * 1024 : p.out + O_SH + (size_t)(l * 16 + (stream - 8)) * 1024;
      oh[gd] = c;
    }
  }
  __syncthreads();
  const int ck = tid & 15, rsub = tid >> 4;
  int pb = 0, pe = L;
  if (qtr >= 0) { pb = 516 * qtr; pe = pb + 516; }
  for (int pr0 = pb + rsub; pr0 < pe; pr0 += 64) {
    u32x4 yl[4], ya[4];
#pragma unroll
    for (int u = 0; u < 4; ++u) {
      const int pr = pr0 + 16 * u;
      if (pr < pe) {
        const size_t row = (size_t)(rbase + pr);
        yl[u] = *(const u32x4*)(P + row * PLD + PC_LY + n * 128 + 8 * ck);
        ya[u] = *(const u32x4*)(Ya + row * 1024 + n * 128 + 8 * ck);
      }
    }
#pragma unroll
    for (int u = 0; u < 4; ++u) {
      const int pr = pr0 + 16 * u;
      if (pr < pe) {
        const int j = (stream < 8) ? (pr < 16 ? 0 : 1 + ((pr - 16) >> 5)) : 0;
        const size_t row = (size_t)(rbase + pr);
        const float* cp = cin + j * 128 + 8 * ck;
        u32x4 o;
#pragma unroll
        for (int e = 0; e < 4; ++e) {
          const float y0 = __uint_as_float(yl[u][e] << 16) + __uint_as_float(ya[u][e] << 16) * cp[2 * e];
          const float y1 = __uint_as_float(yl[u][e] & 0xffff0000u) + __uint_as_float(ya[u][e] & 0xffff0000u) * cp[2 * e + 1];
          o[e] = pk2(y0, y1);
        }
        *(u32x4*)(P + row * PLD + PC_Y + n * 128 + 8 * ck) = o;
      }
    }
  }
}

#define XB_TMO      128
#define XB_XCNT(j)  (256  + 64 * (j))
#define XB_XSUB(j)  (1280 + 64 * (j))
#define XB_XGEN(j)  (2304 + 64 * (j))
#define XB_TOP      3328
#define XB_TOPGEN   3392
#define XCD_BAR_WORDS 3456
#define XB_SPIN_CAP (1u << 22)
DI unsigned xb_ld(unsigned* p) { return __hip_atomic_load(p, __ATOMIC_RELAXED, __HIP_MEMORY_SCOPE_AGENT); }
DI unsigned xb_add(unsigned* p, unsigned v) { return __hip_atomic_fetch_add(p, v, __ATOMIC_RELAXED, __HIP_MEMORY_SCOPE_AGENT); }
DI unsigned xb_xcc_id() { return (unsigned)__builtin_amdgcn_s_getreg((3 << 11) | 20) & 0xFu; }
#define XB_SPIN(cond, bar) do { unsigned _sp = 0; while (cond) { __builtin_amdgcn_s_sleep(1); \
    if ((++_sp & 255u) == 0u) { if (xb_ld(&(bar)[XB_TMO])) break; if (_sp > XB_SPIN_CAP) { atomicAdd(&(bar)[XB_TMO], 1u); break; } } } } while (0)
struct XcdBarrier { unsigned* bar; unsigned x; volatile unsigned* st; };
DI XcdBarrier xcd_barrier_post(unsigned* bar, volatile unsigned* st) {
  XcdBarrier b; b.bar = bar; b.x = xb_xcc_id(); b.st = st;
  if (threadIdx.x == 0) (void)xb_add(&bar[XB_XCNT(b.x)], 1u);
  return b;
}
DI void xcd_barrier_complete(unsigned* bar, unsigned x, unsigned& nloc, unsigned& nx) {
  const unsigned G = gridDim.x * gridDim.y * gridDim.z;
  unsigned sum, cnt, mine, sp = 0u;
  for (;;) {
    sum = 0u; cnt = 0u; mine = 0u;
#pragma unroll
    for (unsigned j = 0; j < 16; ++j) { const unsigned c = xb_ld(&bar[XB_XCNT(j)]); sum += c; cnt += (c > 0u) ? 1u : 0u; mine = (j == x) ? c : mine; }
    if (sum == G) break;
    __builtin_amdgcn_s_sleep(1);
    if ((++sp & 255u) == 0u) { if (xb_ld(&bar[XB_TMO])) break; if (sp > XB_SPIN_CAP) { atomicAdd(&bar[XB_TMO], 1u); break; } }
  }
  nloc = mine > 0u ? mine : 1u; nx = cnt > 0u ? cnt : 1u;
}
DI void xcd_barrier(const XcdBarrier& b) {
  asm volatile("s_waitcnt vmcnt(0)" ::: "memory");
  __syncthreads();
  if (threadIdx.x == 0) {
    unsigned* bar = b.bar;
    __builtin_amdgcn_s_waitcnt(0);
    unsigned nloc = b.st[0], nx = b.st[1];
    if (nloc == 0u) { xcd_barrier_complete(bar, b.x, nloc, nx); b.st[0] = nloc; b.st[1] = nx; }
    const unsigned old = xb_add(&bar[XB_XSUB(b.x)], 1u);
    const unsigned gen = old / nloc;
    if (old + 1u == (gen + 1u) * nloc) {
      __builtin_amdgcn_fence(__ATOMIC_RELEASE, "agent");
      asm volatile("s_waitcnt vmcnt(0)" ::: "memory");
      const unsigned og = xb_add(&bar[XB_TOP], 1u);
      const unsigned tg = og / nx;
      if (og + 1u == (tg + 1u) * nx) xb_add(&bar[XB_TOPGEN], 1u);
      else XB_SPIN(xb_ld(&bar[XB_TOPGEN]) == tg, bar);
      __builtin_amdgcn_fence(__ATOMIC_ACQUIRE, "agent");
      xb_add(&bar[XB_XGEN(b.x)], 1u);
      asm volatile("s_waitcnt vmcnt(0)" ::: "memory");
    } else {
      XB_SPIN(xb_ld(&bar[XB_XGEN(b.x)]) == gen, bar);
      __builtin_amdgcn_fence(__ATOMIC_ACQUIRE, "agent");
      asm volatile("s_waitcnt vmcnt(0)" ::: "memory");
    }
  }
  __syncthreads();
}

__global__ void __launch_bounds__(512, 2) mega(Params p, int lo, int hi) {
  extern __shared__ __attribute__((aligned(16))) char smem[];
  const u16* xb = (const u16*)(p.ws + XB_OFF);
  const u16* P = (const u16*)(p.ws + P_OFF);
  const u16* W = (const u16*)(p.ws + W_OFF);
  volatile unsigned* bst = (volatile unsigned*)(smem + 2 * HALF_LDS);
  if (threadIdx.x == 0) { bst[0] = 0u; bst[1] = 0u; }
  __syncthreads();
  const XcdBarrier gb = xcd_barrier_post((unsigned*)(p.ws + BAR_OFF), bst);
  if (lo < 0) cg::this_grid().sync();
#define GRID_SYNC() xcd_barrier(gb)
  const int hid = __builtin_amdgcn_readfirstlane((int)(threadIdx.x >> 8));
  char* hs = smem + hid * HALF_LDS;
  const int vb = 2 * blockIdx.x + hid;
  const int nvb = 2 * gridDim.x;
  int ph = 0;
#define PH(...) { if (ph >= lo && ph < hi) { if (ph > lo) GRID_SYNC(); __VA_ARGS__ } ++ph; }
  PH({
    for (int w = vb; w < 3776 + 2128; w += nvb) {
      if (w < 3776) wconv_tile(p, 0, w < 3712 ? w : 7104 + (w - 3712), hs); else gather_item(p, w - 3776, hs);
    }
  })
#pragma unroll 1
  for (int l = 0; l < 4; ++l) {
    PH(gemm_phase<EPI_GU>(p, xb, DM, W + WB_GU1, DM, DM, 22, 0.f, smem);)
    PH(gemm_phase_h<EPI_DOWN>(p, P, DFF, W + WB_DN1, DFF, DFF, 8, 0.5f, hs);)
    PH(gemm_phase<EPI_WIN>(p, xb, DM, W + WB_WIN, DM, DM, 25, 0.f, smem);)
    PH({ for (int w = vb; w < NITEM; w += nvb) delta_pre_item(p, l, w, hs); })
    PH({
      if (vb < 64) delta_seq_item(p, l, vb, hs);
      else {
        const int nb = nvb - 64;
        const int b = vb - 64;
        for (int w = b; w < 128 + NLT * 8; w += nb) { if (w < 128) delta_seq_item(p, l, 64 + w, hs); else lru_a_item(p, l, w - 128, hs); }
        const int ntot = 3392 + (l < 3 ? 3712 : 0);
        for (int q = b; q < ntot; q += nb) {
          if (q < 3392) wconv_tile(p, l, 3712 + q, hs);
          else wconv_tile(p, l + 1, q - 3392, hs);
        }
      }
    })
    PH({
      const int nw = 384 + (l < 3 ? 64 : 0);
      for (int w = vb; w < nw; w += nvb) { if (w < 384) lru_b_item(p, l, w, hs); else wconv_tile(p, l + 1, 7104 + (w - 384), hs); }
    })
    PH(merge_phase_h(p, hs);)
    PH(gemm_phase_h<EPI_DOWN>(p, P + PC_MRG, PLD, W + WB_WO, DM, DM, 8, 1.f, hs);)
    PH(gemm_phase<EPI_GU>(p, xb, DM, W + WB_GU2, DM, DM, 22, 0.f, smem);)
    PH(gemm_phase_h<EPI_DOWN>(p, P, DFF, W + WB_DN2, DFF, DFF, 8, 0.5f, hs);)
  }
  PH(final_phase(p, vb, nvb);)
}

extern "C" void kernel_launch(void* const* d_in, const int* in_sizes, int n_in, void* d_out, int out_size, void* d_ws, size_t ws_size,
                              hipStream_t stream) {
  if (ws_size < WS_NEED || n_in < 30) { fprintf(stderr, "workspace too small: %zu < %zu\n", ws_size, (size_t)WS_NEED); return; }
  static int grid_blocks = 0;
  if (!grid_blocks) {
    hipFuncSetAttribute((const void*)mega, hipFuncAttributeMaxDynamicSharedMemorySize, LDS_BYTES);
    int dev = 0, cus = 0, per_cu = 0;
    hipGetDevice(&dev);
    hipDeviceGetAttribute(&cus, hipDeviceAttributeMultiprocessorCount, dev);
    hipOccupancyMaxActiveBlocksPerMultiprocessor(&per_cu, mega, 512, LDS_BYTES);
    per_cu = 1;
    grid_blocks = cus * per_cu;
  }
  Params p{};
  for (int i = 0; i < 30; ++i) p.in[i] = (const float*)d_in[i];
  p.out = (float*)d_out;
  p.ws = (char*)d_ws;
  hipMemsetAsync((char*)d_ws + BAR_OFF, 0, XCD_BAR_WORDS * 4, stream);
#ifdef MK_MULTI
  for (int ph = 0; ph < 42; ++ph) {
    int lo = ph, hi = ph + 1;
    hipLaunchKernelGGL(mega, dim3(grid_blocks), dim3(512), LDS_BYTES, stream, p, lo, hi);
  }
#else
  int lo = 0, hi = 42;
  void* args[] = {&p, &lo, &hi};
  hipError_t e = hipLaunchCooperativeKernel((void*)mega, dim3(grid_blocks), dim3(512), args, LDS_BYTES, stream);
  if (e != hipSuccess) fprintf(stderr, "cooperative launch failed: %s (grid %d)\n", hipGetErrorString(e), grid_blocks);
#endif
}
```

```cpp
#include <hip/hip_runtime.h>
#include <hip/hip_cooperative_groups.h>
#include <cstdio>
namespace cg = cooperative_groups;

typedef unsigned short u16;
typedef short bf16x8 __attribute__((ext_vector_type(8)));
typedef float f32x16 __attribute__((ext_vector_type(16)));
typedef unsigned u32x4 __attribute__((ext_vector_type(4)));
typedef __bf16 bf2_t __attribute__((ext_vector_type(2)));
typedef float f2_t __attribute__((ext_vector_type(2)));
#define DI __device__ __forceinline__
#define MFMA(a, b, c) __builtin_amdgcn_mfma_f32_32x32x16_bf16((a), (b), (c), 0, 0, 0)

constexpr int T_TOK = 17024;
constexpr int DM = 1024, DFF = 2816, PLD = 6400;
constexpr int T_PAD = 17152;
constexpr int NMT = 67;
constexpr int PC_Z = 3072, PC_LX = 4096, PC_LY = 5120, PC_BETA = 6144, PC_ALPHA = 6152;
constexpr int PC_OA = 0, PC_Y = 1024, PC_MRG = 2048;
constexpr int NLT = 536;
constexpr float EPS = 1e-6f;
constexpr int HALF_LDS = 73728;
constexpr int LDS_BYTES = 147472;
constexpr int NITEM = 2240;

constexpr size_t WB_GU1 = 0, WB_DN1 = 5767168, WB_WIN = 8650752, WB_WG = 15204352, WB_BA = 17301504, WB_BB = 18350080,
                 WB_WO = 19398656, WB_GU2 = 20447232, WB_DN2 = 26214400, WB_WR = 29097984, WB_WI = 29229056;
constexpr size_t X_OFF = 0, XB_OFF = 69730304, SSQ_OFF = 104857600, W_OFF = 105947136, P_OFF = 164667392,
                 QD_OFF = 384212992, WW_OFF = 420913152, KD_OFF = 457613312, UT_OFF = 494313472, A_OFF = 531013632,
                 GL_OFF = 549363712, BAR_OFF = 549380096, AG_OFF = 549396480, RSV_OFF = 553787392, WS_NEED = 553787392 + 131072;
constexpr size_t O_YP = 0, O_YS = 16777216, O_PS = 17301504, O_PCQ = 21495808, O_PH = 21790720, O_PCX = 21823488,
                 O_SS = 21921792, O_SCQ = 30310400, O_SH = 30900224, O_SCX = 30965760;

struct Params {
  const float* in[30];
  float* out;
  char* ws;
};

DI unsigned pk2(float a, float b) { f2_t v = {a, b}; bf2_t r = __builtin_convertvector(v, bf2_t); return __builtin_bit_cast(unsigned, r); }
DI u16 f2bf(float x) { __bf16 b = (__bf16)x; return __builtin_bit_cast(u16, b); }
DI float bf2f(u16 v) { return __uint_as_float(((unsigned)v) << 16); }
DI float4 ld_bf4(const u16* p) {
  uint2 v = *(const uint2*)p;
  return make_float4(__uint_as_float(v.x << 16), __uint_as_float(v.x & 0xffff0000u), __uint_as_float(v.y << 16), __uint_as_float(v.y & 0xffff0000u));
}
DI void st_bf4(u16* p, float a, float b, float c, float d) { uint2 v; v.x = pk2(a, b); v.y = pk2(c, d); *(uint2*)p = v; }
DI float sigmoid_(float x) { return __builtin_amdgcn_rcpf(1.f + __expf(-x)); }
DI float silu_(float x) { return x * __builtin_amdgcn_rcpf(1.f + __expf(-x)); }
DI float softplus_(float x) { return fmaxf(x, 0.f) + log1pf(__expf(-fabsf(x))); }
DI float gelu_tanh_(float x) { float u = 0.7978845608028654f * (x + 0.044715f * x * x * x); return x * __builtin_amdgcn_rcpf(1.f + __expf(-2.f * u)); }
DI int otid() { int t = threadIdx.x & 255; asm volatile("" : "+v"(t)); return t; }
DI int otid512() { int t = threadIdx.x; asm volatile("" : "+v"(t)); return t; }
DI int crow(int reg, int h) { return (reg & 3) + 8 * (reg >> 2) + 4 * h; }
DI bf16x8 ldsfrag(const char* base, int off) { return *(const bf16x8*)(base + off); }
DI int sw128(int row, int ch) { return row * 128 + ((ch ^ ((row >> 1) & 7)) << 4); }
DI int sw256(int row, int ch) { return row * 256 + ((ch ^ (row & 15)) << 4); }
template <int S> DI bf16x8 pack8(const f32x16& x) {
  u32x4 u;
  u[0] = pk2(x[8 * S + 0], x[8 * S + 1]); u[1] = pk2(x[8 * S + 2], x[8 * S + 3]);
  u[2] = pk2(x[8 * S + 4], x[8 * S + 5]); u[3] = pk2(x[8 * S + 6], x[8 * S + 7]);
  return __builtin_bit_cast(bf16x8, u);
}
DI void zero16(f32x16& a) {
#pragma unroll
  for (int i = 0; i < 16; ++i) a[i] = 0.f;
}
DI float row_rs(const float* ssq, int row) {
  const float4* q = (const float4*)(ssq + (size_t)row * 16);
  float4 a = q[0], b = q[1], c = q[2], d = q[3];
  float s = (a.x + a.y + a.z + a.w) + (b.x + b.y + b.z + b.w) + (c.x + c.y + c.z + c.w) + (d.x + d.y + d.z + d.w);
  return __builtin_amdgcn_rsqf(s * (1.f / 1024.f) + EPS);
}
DI float row_rs_lean(const float* ssq, int row) {
  const float4* q = (const float4*)(ssq + (size_t)row * 16);
  float s = 0.f;
#pragma unroll
  for (int i = 0; i < 4; ++i) { const float4 a = q[i]; s += (a.x + a.y) + (a.z + a.w); asm volatile("" : "+v"(s)); }
  return __builtin_amdgcn_rsqf(s * (1.f / 1024.f) + EPS);
}

typedef __attribute__((address_space(3))) unsigned lds_u32;
enum { EPI_GU = 0, EPI_DOWN = 1, EPI_WIN = 2 };
DI void stage_tile_h(const u16* __restrict__ g, int ld, char* lds, int tid) {
#pragma unroll
  for (int i = 0; i < 4; ++i) {
    const int pos = tid + 256 * i, row = pos >> 3, ch = (pos & 7) ^ ((row >> 1) & 7);
    __builtin_amdgcn_global_load_lds((const unsigned*)(g + (size_t)row * ld + ch * 8), (lds_u32*)(lds + pos * 16), 16, 0, 0);
  }
}
struct NoHookH { DI void operator()() const {} };
template <class Hook = NoHookH>
DI void gemm_core_h(const u16* __restrict__ A, int lda, const u16* __restrict__ Bt, int ldb, int K, char* smem, f32x16 (&acc)[2][2], Hook hook = Hook()) {
  const int tid = otid(), lane = tid & 63, wid = tid >> 6, wm = wid >> 1, wn = wid & 1;
  const int lr = lane & 31, lh = lane >> 5;
#pragma unroll
  for (int i = 0; i < 2; ++i)
#pragma unroll
    for (int j = 0; j < 2; ++j) zero16(acc[i][j]);
  __syncthreads();
  stage_tile_h(A, lda, smem, tid);
  stage_tile_h(Bt, ldb, smem + 16384, tid);
  const int nk = K >> 6;
  for (int kt = 0; kt < nk; ++kt) {
    const char* sa = smem + (kt & 1) * 32768;
    const char* sb = sa + 16384;
    asm volatile("s_waitcnt vmcnt(0)" ::: "memory");
    __syncthreads();
    if (kt + 1 < nk) {
      char* da = smem + ((kt + 1) & 1) * 32768;
      stage_tile_h(A + (kt + 1) * 64, lda, da, tid);
      stage_tile_h(Bt + (kt + 1) * 64, ldb, da + 16384, tid);
    }
    if (kt == nk - 2) hook();
#pragma unroll
    for (int ks = 0; ks < 4; ++ks) {
      bf16x8 a0 = ldsfrag(sa, sw128(64 * wm + lr, 2 * ks + lh));
      bf16x8 a1 = ldsfrag(sa, sw128(64 * wm + 32 + lr, 2 * ks + lh));
      bf16x8 b0 = ldsfrag(sb, sw128(64 * wn + lr, 2 * ks + lh));
      bf16x8 b1 = ldsfrag(sb, sw128(64 * wn + 32 + lr, 2 * ks + lh));
      acc[0][0] = MFMA(b0, a0, acc[0][0]);
      acc[0][1] = MFMA(b1, a0, acc[0][1]);
      acc[1][0] = MFMA(b0, a1, acc[1][0]);
      acc[1][1] = MFMA(b1, a1, acc[1][1]);
    }
  }
}

DI bool tile_of_h(int it, int NT, int& mt, int& nt, int b) {
  const int G = gridDim.x;
  const int rb = ((G & 7) == 0) ? ((b & 7) * (G >> 3) + (b >> 3)) : b;
  const int hid = __builtin_amdgcn_readfirstlane((int)(threadIdx.x >> 8));
  const int L = it * 2 * G + 2 * rb + hid;
  if (L >= 133 * NT) return false;
  const int nig = 8 * NT, gid = L / nig, fm = gid * 8, gsz = (133 - fm) < 8 ? (133 - fm) : 8, w = L - gid * nig;
  mt = fm + (w % gsz); nt = w / gsz;
  return true;
}
DI int num_rounds_h(int NT) { return (133 * NT + 2 * gridDim.x - 1) / (2 * gridDim.x); }


template <int EPI>
DI void gemm_phase_h(const Params& p, const u16* A, int lda, const u16* Bt, int ldb, int K, int NT, float f, char* smem, int bid) {
  float* x = (float*)(p.ws + X_OFF);
  u16* xb = (u16*)(p.ws + XB_OFF);
  float* ssq = (float*)(p.ws + SSQ_OFF);
  u16* P = (u16*)(p.ws + P_OFF);
  const int tid_ = otid(), lane = tid_ & 63, wid = tid_ >> 6, wm = wid >> 1, wn = wid & 1, lr = lane & 31, lh = lane >> 5;
  const int nr = num_rounds_h(NT);
  for (int it = 0; it < nr; ++it) {
    int mt, nt;
    if (!tile_of_h(it, NT, mt, nt, bid)) break;
    f32x16 acc[2][2];
    float rsv[2] = {0.f, 0.f};
    float4 xo[2][2][4];
    if (EPI != EPI_DOWN) {
#pragma unroll
      for (int mi = 0; mi < 2; ++mi) rsv[mi] = row_rs(ssq, mt * 128 + 64 * wm + 32 * mi + lr);
      gemm_core_h(A + (size_t)(mt * 128) * lda, lda, Bt + (size_t)(nt * 128) * ldb, ldb, K, smem, acc);
    } else {
      const float* xbase = x + (size_t)(mt * 128 + 64 * wm + lr) * DM + nt * 128 + 64 * wn + 4 * lh;
      gemm_core_h(A + (size_t)(mt * 128) * lda, lda, Bt + (size_t)(nt * 128) * ldb, ldb, K, smem, acc, [&]() {
#pragma unroll
        for (int mi = 0; mi < 2; ++mi)
#pragma unroll
          for (int ni = 0; ni < 2; ++ni)
#pragma unroll
            for (int b = 0; b < 4; ++b) xo[mi][ni][b] = *(const float4*)(xbase + (size_t)(32 * mi) * DM + 32 * ni + 8 * b);
      });
    }
#pragma unroll
    for (int mi = 0; mi < 2; ++mi) {
      const int row = mt * 128 + 64 * wm + 32 * mi + lr;
      if (EPI == EPI_GU) {
        const float rs = rsv[mi];
        u16* hrow = P + (size_t)row * DFF + 32 * (2 * nt + wn) + 4 * lh;
#pragma unroll
        for (int b = 0; b < 4; ++b) {
          float hv[4];
#pragma unroll
          for (int r = 0; r < 4; ++r) { float g = acc[mi][0][4 * b + r] * rs, u = acc[mi][1][4 * b + r] * rs; hv[r] = silu_(g) * u; }
          st_bf4(hrow + 8 * b, hv[0], hv[1], hv[2], hv[3]);
        }
      } else if (EPI == EPI_WIN) {
        const float rs = rsv[mi];
#pragma unroll
        for (int ni = 0; ni < 2; ++ni)
#pragma unroll
          for (int b = 0; b < 4; ++b) {
            const int col = nt * 128 + 64 * wn + 32 * ni + 8 * b + 4 * lh;
            st_bf4(P + (size_t)row * PLD + col, acc[mi][ni][4 * b] * rs, acc[mi][ni][4 * b + 1] * rs, acc[mi][ni][4 * b + 2] * rs, acc[mi][ni][4 * b + 3] * rs);
          }
      } else {
        float ss = 0.f;
#pragma unroll
        for (int ni = 0; ni < 2; ++ni)
#pragma unroll
          for (int b = 0; b < 4; ++b) {
            const int col = nt * 128 + 64 * wn + 32 * ni + 8 * b + 4 * lh;
            float4 v = xo[mi][ni][b];
            v.x += f * acc[mi][ni][4 * b]; v.y += f * acc[mi][ni][4 * b + 1]; v.z += f * acc[mi][ni][4 * b + 2]; v.w += f * acc[mi][ni][4 * b + 3];
            *(float4*)(x + (size_t)row * DM + col) = v;
            st_bf4(xb + (size_t)row * DM + col, v.x, v.y, v.z, v.w);
            ss += v.x * v.x + v.y * v.y + v.z * v.z + v.w * v.w;
          }
        ss += __shfl_xor(ss, 32);
        if (lh == 0) ssq[(size_t)row * 16 + 2 * nt + wn] = ss;
      }
    }
  }
}

DI void merge_phase_h(const Params& p, char* smem, int bid) {
  const u16* xb = (const u16*)(p.ws + XB_OFF);
  const float* ssq = (const float*)(p.ws + SSQ_OFF);
  u16* P = (u16*)(p.ws + P_OFF);
  const u16* W = (const u16*)(p.ws + W_OFF);
  const int tid_ = otid(), lane = tid_ & 63, wid = tid_ >> 6, wm = wid >> 1, wn = wid & 1, lr = lane & 31, lh = lane >> 5;
  const int nr = num_rounds_h(8);
  for (int it = 0; it < nr; ++it) {
    int mt, nt;
    if (!tile_of_h(it, 8, mt, nt, bid)) break;
    for (int pass = 0; pass < 2; ++pass) {
      f32x16 acc[2][2];
      unsigned Gp[2][2][8];
      float rsv[2];
#pragma unroll
      for (int mi = 0; mi < 2; ++mi) rsv[mi] = row_rs(ssq, mt * 128 + 64 * wm + 32 * mi + lr);
      gemm_core_h(xb + (size_t)(mt * 128) * DM, DM, W + WB_WG + (size_t)(pass * 1024 + nt * 128) * DM, DM, DM, smem, acc);
#pragma unroll
      for (int mi = 0; mi < 2; ++mi) {
        const float rs = rsv[mi];
#pragma unroll
        for (int ni = 0; ni < 2; ++ni)
#pragma unroll
          for (int r = 0; r < 8; ++r) Gp[mi][ni][r] = pk2(sigmoid_(acc[mi][ni][2 * r] * rs), sigmoid_(acc[mi][ni][2 * r + 1] * rs));
      }
      gemm_core_h(P + (size_t)(mt * 128) * PLD + (pass ? PC_Y : PC_OA), PLD, W + (pass ? WB_BB : WB_BA) + (size_t)(nt * 128) * DM, DM, DM, smem, acc);
#pragma unroll
      for (int mi = 0; mi < 2; ++mi) {
        const int row = mt * 128 + 64 * wm + 32 * mi + lr;
        float4 prev[2][4];
#pragma unroll
        for (int ni = 0; ni < 2; ++ni)
#pragma unroll
          for (int b = 0; b < 4; ++b) {
            prev[ni][b] = make_float4(0.f, 0.f, 0.f, 0.f);
            if (pass) prev[ni][b] = ld_bf4(P + (size_t)row * PLD + PC_MRG + nt * 128 + 64 * wn + 32 * ni + 8 * b + 4 * lh);
          }
#pragma unroll
        for (int ni = 0; ni < 2; ++ni)
#pragma unroll
          for (int b = 0; b < 4; ++b) {
            u16* op = P + (size_t)row * PLD + PC_MRG + nt * 128 + 64 * wn + 32 * ni + 8 * b + 4 * lh;
            const unsigned g0 = Gp[mi][ni][2 * b], g1 = Gp[mi][ni][2 * b + 1];
            st_bf4(op, prev[ni][b].x + __uint_as_float(g0 << 16) * acc[mi][ni][4 * b], prev[ni][b].y + __uint_as_float(g0 & 0xffff0000u) * acc[mi][ni][4 * b + 1],
                   prev[ni][b].z + __uint_as_float(g1 << 16) * acc[mi][ni][4 * b + 2], prev[ni][b].w + __uint_as_float(g1 & 0xffff0000u) * acc[mi][ni][4 * b + 3]);
          }
      }
    }
  }
}

namespace pg8 {
#define PG8_LAS __attribute__((address_space(3)))
typedef unsigned short bf16_t;
typedef short bf16x8 __attribute__((ext_vector_type(8)));
typedef float f32x4 __attribute__((ext_vector_type(4)));
typedef unsigned u32x4 __attribute__((ext_vector_type(4)));
constexpr int BM = 256, BK = 64, HALF = 128, HTB = HALF * BK * 2  , STAGE_BYTES = 8 * HTB, NXCD = 8, WGM = 8;

__host__ __device__ __forceinline__ int lds_byte(int r, int c) { const int st = (r >> 4) * 2 + (c >> 5), rr = r & 15, cc = c & 31, ob = rr * 64 + cc * 2; return st * 1024 + (ob ^ (((ob >> 9) & 1) << 5)); }
__host__ __device__ __forceinline__ void stage_rc(int b, int& R, int& C) { const int st = b / 1024, sb = b % 1024, swz = sb ^ (((sb >> 9) & 1) << 5); R = (st >> 1) * 16 + swz / 64; C = (st & 1) * 32 + (swz % 64) / 2; }
__host__ __device__ __forceinline__ int perm32(int rho) { const int n = rho >> 4, i = rho & 15; return 8 * (i >> 2) + 4 * n + (i & 3); }

struct Unit { int pm, pn, ko, ao, bo; };
struct Gemm { const bf16_t* A; const bf16_t* Bt; int M, N, K, lda, ldb; };

struct StaticOrder {
    int nM, nN, nwg, G, c;
    __host__ __device__ void init(int M, int N, int G_, int c_) { nM = M / BM; nN = N / BM; nwg = nM * nN; G = G_; c = c_; }
    __host__ __device__ bool next(int i, Unit& u) const {
        const long L = (long)i * G + c; if (L >= nwg) return false;
        int wgid = (int)L; { const int q = nwg / NXCD, r = nwg % NXCD, xcd = wgid % NXCD, off = wgid / NXCD; wgid = (xcd < r ? xcd * (q + 1) : r * (q + 1) + (xcd - r) * q) + off; }
        const int nig = WGM * nN, gid = wgid / nig, fm = gid * WGM, gsz = (nM - fm) < WGM ? (nM - fm) : WGM;
        u.pm = fm + ((wgid % nig) % gsz); u.pn = (wgid % nig) / gsz; u.ko = 0; u.ao = 0; u.bo = 0; return true;
    }
    __device__ __forceinline__ void a_ready(const Unit&) const {}
    __device__ __forceinline__ void done(const Unit&) const {}
};

template <class Epi, class Sched, bool STAMP = false>
__device__ __forceinline__ void gemm_phase(PG8_LAS unsigned char* lds, const Gemm g, const Sched& S, const Epi& E, unsigned long long* stamps) {
    const int tid = otid512(), wid = __builtin_amdgcn_readfirstlane(tid >> 6), lane = tid & 63, wr = wid >> 2, wc = wid & 3, fr = lane & 15, fq = lane >> 4;
    const int K = g.K, nt = K / BK;
    int ts_lo = 0, ts_hi = 0, nts = 0; const unsigned long long rt_entry = STAMP ? (unsigned long long)wall_clock64() : 0ull;
#define PG8_STAMP() do { if (STAMP && wid == 0 && nts < 64) { const unsigned long long _c = (unsigned long long)clock64(); \
        ts_lo = (lane == nts) ? (int)(unsigned)_c : ts_lo; ts_hi = (lane == nts) ? (int)(unsigned)(_c >> 32) : ts_hi; ++nts; } } while (0)
    PG8_STAMP();
    unsigned voffA[2], voffB[2];
#pragma unroll
    for (int i = 0; i < 2; ++i) { int R, C; stage_rc(tid * 16 + i * 8192, R, C); const int Rb = Epi::PERM ? ((R & ~31) + perm32(R & 31)) : R;
        voffA[i] = (unsigned)(R * g.lda + C) * 2u; voffB[i] = (unsigned)(Rb * g.ldb + C) * 2u; }
    const size_t kstep = (size_t)(BK * 2);
    const size_t hstep = (size_t)HALF * g.ldb * 2;
    const size_t tstep = 2 * hstep;
    const size_t hstepA = (size_t)HALF * g.lda * 2, tstepA = 2 * hstepA;
    const unsigned ldsw = (unsigned)wid * 1024u;
    const int aoff = lds_byte(wr * 64 + fr, fq * 8), boff = lds_byte(wc * 32 + fr, fq * 8);
#define PG8_SA(b, h) (((b) * 2 + (h)) * HTB)
#define PG8_SB(b, h) ((4 + (b) * 2 + (h)) * HTB)
#define PG8_STAGE(bufoff, gbase, voff) do { _Pragma("unroll") for (int _i = 0; _i < 2; ++_i) \
        __builtin_amdgcn_global_load_lds((const unsigned*)((const char*)(gbase) + (voff)[_i]), (PG8_LAS unsigned*)(lds + (bufoff) + ldsw + _i * 8192), 16, 0, 0); } while (0)
#define PG8_LDA(dst, b, h) do { _Pragma("unroll") for (int m = 0; m < 4; ++m) _Pragma("unroll") for (int k = 0; k < 2; ++k) dst[m][k] = *(const PG8_LAS bf16x8*)(lds + PG8_SA(b, h) + aoff + m * 2048 + k * 1024); } while (0)
#define PG8_LDB(dst, b, h) do { _Pragma("unroll") for (int n = 0; n < 2; ++n) _Pragma("unroll") for (int k = 0; k < 2; ++k) dst[n][k] = *(const PG8_LAS bf16x8*)(lds + PG8_SB(b, h) + boff + n * 2048 + k * 1024); } while (0)
#define PG8_MMA(ai, bj, At, Bt) do { __builtin_amdgcn_s_setprio(1); _Pragma("unroll") for (int m = 0; m < 4; ++m) _Pragma("unroll") for (int n = 0; n < 2; ++n) _Pragma("unroll") for (int k = 0; k < 2; ++k) \
        acc[ai][bj][m][n] = __builtin_amdgcn_mfma_f32_16x16x32_bf16(Bt[n][k], At[m][k], acc[ai][bj][m][n], 0, 0, 0); __builtin_amdgcn_s_setprio(0); } while (0)
#define PG8_WAIT_V(n) asm volatile("s_waitcnt vmcnt(" #n ")" ::: "memory")
#define PG8_WAIT_L(n) asm volatile("s_waitcnt lgkmcnt(" #n ")" ::: "memory")
#define PG8_BAR __builtin_amdgcn_s_barrier()
#define PG8_SCHED __builtin_amdgcn_sched_barrier(0)
    Unit cur, nxt; int ui = 0;
    if (!S.next(0, cur)) return;
    f32x4 acc[2][2][4][2];
#pragma unroll
    for (int a = 0; a < 2; ++a)
#pragma unroll
        for (int b = 0; b < 2; ++b)
#pragma unroll
            for (int m = 0; m < 4; ++m)
#pragma unroll
                for (int n = 0; n < 2; ++n) acc[a][b][m][n] = (f32x4){0.f, 0.f, 0.f, 0.f};
    bf16x8 At[4][2], B0[2][2], B1[2][2];
    const char* cA = (const char*)g.A + (size_t)cur.pm * tstepA + (size_t)cur.ao * 2; const char* cB = (const char*)g.Bt + (size_t)cur.pn * tstep + (size_t)cur.bo * 2;
    S.a_ready(cur);
    PG8_STAGE(PG8_SB(0, 0), cB, voffB); PG8_STAGE(PG8_SA(0, 0), cA, voffA); PG8_STAGE(PG8_SB(0, 1), cB + hstep, voffB); PG8_STAGE(PG8_SA(0, 1), cA + hstepA, voffA);
    if (wr == 1) PG8_BAR;
    PG8_WAIT_V(4); PG8_BAR;
    PG8_STAGE(PG8_SB(1, 0), cB + kstep, voffB); PG8_STAGE(PG8_SA(1, 0), cA + kstep, voffA); PG8_STAGE(PG8_SB(1, 1), cB + hstep + kstep, voffB);
    PG8_WAIT_V(6); PG8_BAR;
    PG8_STAMP();
    for (;;) {
        const bool has_next = S.next(ui + 1, nxt);
        const char* nA = has_next ? (const char*)g.A + (size_t)nxt.pm * tstepA + (size_t)nxt.ao * 2 : cA; const char* nB = has_next ? (const char*)g.Bt + (size_t)nxt.pn * tstep + (size_t)nxt.bo * 2 : cB;
        for (int t = 0; t < nt; t += 2) {
            const bool last = (t == nt - 2);
            const char* a1 = cA + (size_t)(t + 1) * kstep;
            const char* a2 = last ? nA : cA + (size_t)(t + 2) * kstep; const char* b2 = last ? nB : cB + (size_t)(t + 2) * kstep;
            const char* a3 = a2 + kstep; const char* b3 = b2 + kstep;
            if (last && has_next) S.a_ready(nxt);
            PG8_LDB(B0, 0, 0); PG8_SCHED; PG8_LDA(At, 0, 0); PG8_STAGE(PG8_SA(1, 1), a1 + hstepA, voffA);
            PG8_WAIT_L(8); PG8_BAR; PG8_WAIT_L(0); PG8_MMA(0, 0, At, B0); PG8_BAR; PG8_SCHED;
            PG8_LDB(B1, 0, 1); PG8_STAGE(PG8_SB(0, 0), b2, voffB);
            PG8_BAR; PG8_WAIT_L(0); PG8_MMA(0, 1, At, B1); PG8_BAR;
            PG8_LDA(At, 0, 1); PG8_STAGE(PG8_SA(0, 0), a2, voffA);
            PG8_BAR; PG8_WAIT_L(0); PG8_MMA(1, 0, At, B0); PG8_BAR; PG8_SCHED;
            PG8_STAGE(PG8_SB(0, 1), b2 + hstep, voffB);
            PG8_WAIT_V(6); PG8_BAR; PG8_MMA(1, 1, At, B1); PG8_BAR;
            PG8_LDB(B0, 1, 0); PG8_SCHED; PG8_LDA(At, 1, 0); PG8_STAGE(PG8_SA(0, 1), a2 + hstepA, voffA);
            PG8_WAIT_L(8); PG8_BAR; PG8_WAIT_L(0); PG8_MMA(0, 0, At, B0); PG8_BAR; PG8_SCHED;
            PG8_LDB(B1, 1, 1); PG8_STAGE(PG8_SB(1, 0), b3, voffB);
            PG8_BAR; PG8_WAIT_L(0); PG8_MMA(0, 1, At, B1); PG8_BAR;
            PG8_LDA(At, 1, 1); PG8_STAGE(PG8_SA(1, 0), a3, voffA);
            PG8_BAR; PG8_WAIT_L(0); PG8_MMA(1, 0, At, B0); PG8_BAR; PG8_SCHED;
            PG8_STAGE(PG8_SB(1, 1), b3 + hstep, voffB);
            PG8_WAIT_V(6); PG8_BAR; PG8_MMA(1, 1, At, B1); PG8_BAR;
        }
        PG8_STAMP();
        if constexpr (!Epi::AFTER_DRAIN) { E(acc, cur, wr, wc, fr, fq); S.done(cur); }
        PG8_STAMP();
        if (!has_next) break;
#pragma unroll
        for (int a = 0; a < 2; ++a)
#pragma unroll
            for (int b = 0; b < 2; ++b)
#pragma unroll
                for (int m = 0; m < 4; ++m)
#pragma unroll
                    for (int n = 0; n < 2; ++n) acc[a][b][m][n] = (f32x4){0.f, 0.f, 0.f, 0.f};
        cur = nxt; cA = nA; cB = nB; ++ui;
    }
    PG8_WAIT_V(0);
    if (wr == 0) PG8_BAR;
    PG8_BAR;
    if constexpr (Epi::AFTER_DRAIN) { E.fused(acc, cur, wr, wc, fr, fq, lds, wid, lane); S.done(cur); }
    PG8_STAMP();
    if (STAMP && wid == 0) { stamps[lane] = lane < nts ? (((unsigned long long)(unsigned)ts_hi << 32) | (unsigned)ts_lo) : 0ull;
        if (lane == 62) stamps[62] = rt_entry; if (lane == 63) stamps[63] = (unsigned long long)wall_clock64(); }
#undef PG8_STAMP
#undef PG8_SA
#undef PG8_SB
#undef PG8_STAGE
#undef PG8_LDA
#undef PG8_LDB
#undef PG8_MMA
#undef PG8_WAIT_V
#undef PG8_WAIT_L
#undef PG8_BAR
#undef PG8_SCHED
}
}

struct EpiGU {
  static constexpr bool PERM = false, AFTER_DRAIN = false;
  u16* H; const float* rsv;
  DI void operator()(const pg8::f32x4 (&acc)[2][2][4][2], const pg8::Unit& u, int wr, int wc, int fr, int fq) const {
#pragma unroll
    for (int ai = 0; ai < 2; ++ai)
#pragma unroll
      for (int m = 0; m < 4; ++m) {
        const int row = u.pm * 256 + ai * 128 + wr * 64 + m * 16 + fr;
        const bool valid = row < T_TOK;
        const float rs = rsv[valid ? row : 0];
#pragma unroll
        for (int bj = 0; bj < 2; ++bj) {
          const pg8::f32x4 g = acc[ai][bj][m][0] * rs, up = acc[ai][bj][m][1] * rs;
          const int j = 16 * (8 * u.pn + 4 * bj + wc) + 4 * fq;
          if (valid) st_bf4(H + (size_t)row * DFF + j, silu_(g[0]) * up[0], silu_(g[1]) * up[1], silu_(g[2]) * up[2], silu_(g[3]) * up[3]);
        }
      }
  }
};
struct EpiWIN {
  static constexpr bool PERM = true, AFTER_DRAIN = false;
  u16* P; const float* rsv;
  DI void operator()(const pg8::f32x4 (&acc)[2][2][4][2], const pg8::Unit& u, int wr, int wc, int fr, int fq) const {
#pragma unroll
    for (int ai = 0; ai < 2; ++ai)
#pragma unroll
      for (int m = 0; m < 4; ++m) {
        const int row = u.pm * 256 + ai * 128 + wr * 64 + m * 16 + fr;
        const bool valid = row < T_TOK;
        const float rs = rsv[valid ? row : 0];
#pragma unroll
        for (int bj = 0; bj < 2; ++bj) {
          const pg8::f32x4 a = acc[ai][bj][m][0] * rs, b = acc[ai][bj][m][1] * rs;
          u32x4 v; v[0] = pk2(a[0], a[1]); v[1] = pk2(a[2], a[3]); v[2] = pk2(b[0], b[1]); v[3] = pk2(b[2], b[3]);
          if (valid) *(u32x4*)(P + (size_t)row * PLD + u.pn * 256 + bj * 128 + wc * 32 + 8 * fq) = v;
        }
      }
  }
};
struct EpiTMP {
  static constexpr bool PERM = true, AFTER_DRAIN = false;
  u16* T;
  DI void operator()(const pg8::f32x4 (&acc)[2][2][4][2], const pg8::Unit& u, int wr, int wc, int fr, int fq) const {
#pragma unroll
    for (int ai = 0; ai < 2; ++ai)
#pragma unroll
      for (int m = 0; m < 4; ++m) {
        const int row = u.pm * 256 + ai * 128 + wr * 64 + m * 16 + fr;
        if (row < T_TOK) {
#pragma unroll
          for (int bj = 0; bj < 2; ++bj) {
            const pg8::f32x4 a = acc[ai][bj][m][0], b = acc[ai][bj][m][1];
            u32x4 v; v[0] = pk2(a[0], a[1]); v[1] = pk2(a[2], a[3]); v[2] = pk2(b[0], b[1]); v[3] = pk2(b[2], b[3]);
            *(u32x4*)(T + (size_t)row * PLD + u.pn * 256 + bj * 128 + wc * 32 + 8 * fq) = v;
          }
        }
      }
  }
};
struct EpiGATE {
  static constexpr bool PERM = true, AFTER_DRAIN = false;
  const u16* T; u16* M; const float* rsv; int accum;
  DI void operator()(const pg8::f32x4 (&acc)[2][2][4][2], const pg8::Unit& u, int wr, int wc, int fr, int fq) const {
#pragma unroll
    for (int ai = 0; ai < 2; ++ai)
#pragma unroll
      for (int m = 0; m < 4; ++m) {
        const int row = u.pm * 256 + ai * 128 + wr * 64 + m * 16 + fr;
        const bool valid = row < T_TOK;
        const int rowc = valid ? row : 0;
        const float rs = rsv[rowc];
        u32x4 tv[2], pv[2];
#pragma unroll
        for (int bj = 0; bj < 2; ++bj) {
          const size_t off = (size_t)rowc * PLD + u.pn * 256 + bj * 128 + wc * 32 + 8 * fq;
          tv[bj] = *(const u32x4*)(T + off);
          pv[bj][0] = 0u; pv[bj][1] = 0u; pv[bj][2] = 0u; pv[bj][3] = 0u;
          if (accum) pv[bj] = *(const u32x4*)(M + off);
        }
#pragma unroll
        for (int bj = 0; bj < 2; ++bj) {
          const size_t off = (size_t)rowc * PLD + u.pn * 256 + bj * 128 + wc * 32 + 8 * fq;
          u32x4 o;
#pragma unroll
          for (int e = 0; e < 4; ++e) {
            const float g0 = sigmoid_(acc[ai][bj][m][e >> 1][2 * (e & 1)] * rs), g1 = sigmoid_(acc[ai][bj][m][e >> 1][2 * (e & 1) + 1] * rs);
            const float r0 = __uint_as_float(pv[bj][e] << 16) + g0 * __uint_as_float(tv[bj][e] << 16);
            const float r1 = __uint_as_float(pv[bj][e] & 0xffff0000u) + g1 * __uint_as_float(tv[bj][e] & 0xffff0000u);
            o[e] = pk2(r0, r1);
          }
          if (valid) *(u32x4*)(M + off) = o;
        }
      }
  }
};
struct EpiDOWN {
  static constexpr bool PERM = true, AFTER_DRAIN = false;
  float* x; u16* xb; float* ssq; float f;
  DI void operator()(const pg8::f32x4 (&acc)[2][2][4][2], const pg8::Unit& u, int wr, int wc, int fr, int fq) const {
#pragma unroll
    for (int ai = 0; ai < 2; ++ai)
#pragma unroll
      for (int m = 0; m < 4; ++m) {
        const int row = u.pm * 256 + ai * 128 + wr * 64 + m * 16 + fr;
        const bool valid = row < T_TOK;
        const size_t off = (size_t)(valid ? row : 0) * DM + u.pn * 256 + wc * 32 + 8 * fq;
        pg8::f32x4 xo[2][2];
#pragma unroll
        for (int bj = 0; bj < 2; ++bj) { xo[bj][0] = *(const pg8::f32x4*)(x + off + bj * 128); xo[bj][1] = *(const pg8::f32x4*)(x + off + bj * 128 + 4); }
        float ss = 0.f;
#pragma unroll
        for (int bj = 0; bj < 2; ++bj) {
          const pg8::f32x4 a = xo[bj][0] + acc[ai][bj][m][0] * f, b = xo[bj][1] + acc[ai][bj][m][1] * f;
          ss += a[0] * a[0] + a[1] * a[1] + a[2] * a[2] + a[3] * a[3] + b[0] * b[0] + b[1] * b[1] + b[2] * b[2] + b[3] * b[3];
          if (valid) {
            *(pg8::f32x4*)(x + off + bj * 128) = a; *(pg8::f32x4*)(x + off + bj * 128 + 4) = b;
            u32x4 v; v[0] = pk2(a[0], a[1]); v[1] = pk2(a[2], a[3]); v[2] = pk2(b[0], b[1]); v[3] = pk2(b[2], b[3]);
            *(u32x4*)(xb + off + bj * 128) = v;
          }
        }
        ss += __shfl_xor(ss, 16); ss += __shfl_xor(ss, 32);
        if (fq == 0 && valid) ssq[(size_t)row * 16 + 4 * u.pn + wc] = ss;
      }
  }
};
struct SliceOrder {
  int nitem, G, c, nslice, kstep, a2, b2;
  DI bool next(int i, pg8::Unit& u) const {
    const int L = i * G + c; if (L >= nitem) return false;
    const int unit = L / nslice, sl = L - unit * nslice;
    const int g2 = unit / 12, un = unit - g2 * 12;
    u.pm = 64 + (un >> 2); u.pn = un & 3; u.ko = (g2 * nslice + sl) * kstep; u.ao = sl * kstep + g2 * a2; u.bo = sl * kstep + g2 * b2; return true;
  }
  DI void a_ready(const pg8::Unit&) const {}
  DI void done(const pg8::Unit&) const {}
};
constexpr size_t PART_OFF = P_OFF + 104857600;
struct EpiPART {
  static constexpr bool PERM = true, AFTER_DRAIN = false;
  float* part;
  DI void operator()(const pg8::f32x4 (&acc)[2][2][4][2], const pg8::Unit& u, int wr, int wc, int fr, int fq) const {
    float* pb = part + (size_t)(u.ko >> 8) * (768 * 1024);
#pragma unroll
    for (int ai = 0; ai < 2; ++ai)
#pragma unroll
      for (int m = 0; m < 4; ++m) {
        const int rr = (u.pm - 64) * 256 + ai * 128 + wr * 64 + m * 16 + fr;
        float* xp = pb + (size_t)rr * DM + u.pn * 256 + wc * 32 + 8 * fq;
#pragma unroll
        for (int bj = 0; bj < 2; ++bj) { *(pg8::f32x4*)(xp + bj * 128) = acc[ai][bj][m][0]; *(pg8::f32x4*)(xp + bj * 128 + 4) = acc[ai][bj][m][1]; }
      }
  }
};
struct EpiPARTH {
  static constexpr bool PERM = true, AFTER_DRAIN = false;
  u16* part;
  DI void operator()(const pg8::f32x4 (&acc)[2][2][4][2], const pg8::Unit& u, int wr, int wc, int fr, int fq) const {
    u16* pb = part + (size_t)(u.ko >> 9) * (768 * 1024);
#pragma unroll
    for (int ai = 0; ai < 2; ++ai)
#pragma unroll
      for (int m = 0; m < 4; ++m) {
        const int rr = (u.pm - 64) * 256 + ai * 128 + wr * 64 + m * 16 + fr;
        u16* xp = pb + (size_t)rr * DM + u.pn * 256 + wc * 32 + 8 * fq;
#pragma unroll
        for (int bj = 0; bj < 2; ++bj) {
          const pg8::f32x4 a = acc[ai][bj][m][0], b = acc[ai][bj][m][1];
          u32x4 v; v[0] = pk2(a[0], a[1]); v[1] = pk2(a[2], a[3]); v[2] = pk2(b[0], b[1]); v[3] = pk2(b[2], b[3]);
          *(u32x4*)(xp + bj * 128) = v;
        }
      }
  }
};
DI void tail_slices(const u16* A, int lda, int a2, const u16* Bt, int b2, u16* part, char* smem, int bid) {
  int ksl = 512; asm volatile("" : "+s"(ksl));
  pg8::Gemm g; g.A = A; g.Bt = Bt; g.M = T_PAD; g.N = 1024; g.K = ksl; g.lda = lda; g.ldb = DM;
  SliceOrder S; S.nslice = 2; S.kstep = 512; S.a2 = a2; S.b2 = b2; S.nitem = 48; S.G = (int)gridDim.x; S.c = bid;
  EpiPARTH ep; ep.part = part;
  pg8::gemm_phase<EpiPARTH, SliceOrder, false>((PG8_LAS unsigned char*)smem, g, S, ep, nullptr);
  __syncthreads();
}
DI void merge_tail_fix(const Params& p, const u16* part) {
  const int tid = otid512();
  const float* rsv = (const float*)(p.ws + RSV_OFF);
  u16* P = (u16*)(p.ws + P_OFF);
  for (int r = 16384 + (int)blockIdx.x; r < T_TOK; r += (int)gridDim.x) {
    const float rs = rsv[r];
    float v[4][2];
#pragma unroll
    for (int gi = 0; gi < 4; ++gi) {
      const int t0 = (gi & 1) * 4 + (gi >> 1) * 2;
      const unsigned w0 = ((const unsigned*)(part + ((size_t)t0 * 768 + (r - 16384)) * DM))[tid];
      const unsigned w1 = ((const unsigned*)(part + ((size_t)(t0 + 1) * 768 + (r - 16384)) * DM))[tid];
      v[gi][0] = __uint_as_float(w0 << 16) + __uint_as_float(w1 << 16);
      v[gi][1] = __uint_as_float(w0 & 0xffff0000u) + __uint_as_float(w1 & 0xffff0000u);
    }
    const float m0 = sigmoid_(v[1][0] * rs) * v[0][0] + sigmoid_(v[3][0] * rs) * v[2][0];
    const float m1 = sigmoid_(v[1][1] * rs) * v[0][1] + sigmoid_(v[3][1] * rs) * v[2][1];
    ((unsigned*)(P + (size_t)r * PLD + PC_MRG))[tid] = pk2(m0, m1);
  }
}
template <class EpiMain>
DI void resid_gemm(const u16* A, int lda, const u16* Bt, int K, const EpiMain& E, float* part, char* smem, int bid) {
  {
    pg8::Gemm g; g.A = A; g.Bt = Bt; g.M = 16384; g.N = 1024; g.K = K; g.lda = lda; g.ldb = K;
    pg8::StaticOrder S; S.init(16384, 1024, (int)gridDim.x, bid);
    __syncthreads();
    pg8::gemm_phase<EpiMain, pg8::StaticOrder, false>((PG8_LAS unsigned char*)smem, g, S, E, nullptr);
    __syncthreads();
  }
  {
    int ksl = 256; asm volatile("" : "+s"(ksl));
    pg8::Gemm g; g.A = A; g.Bt = Bt; g.M = T_PAD; g.N = 1024; g.K = ksl; g.lda = lda; g.ldb = K;
    SliceOrder S; S.nslice = K >> 8; S.kstep = 256; S.a2 = 0; S.b2 = 0; S.nitem = 12 * S.nslice; S.G = (int)gridDim.x; S.c = bid;
    EpiPART ep; ep.part = part;
    pg8::gemm_phase<EpiPART, SliceOrder, false>((PG8_LAS unsigned char*)smem, g, S, ep, nullptr);
    __syncthreads();
  }
}
DI void rs_pass(const Params& p, char* smem, int nsl, float f, const float* part) {
  const int tid = otid512();
  float* rsv = (float*)(p.ws + RSV_OFF);
  const int row = (int)blockIdx.x * 512 + tid;
  if (row < 16384) rsv[row] = row_rs((const float*)(p.ws + SSQ_OFF), row);
  float* red = (float*)smem;
  for (int r = 16384 + (int)blockIdx.x; r < T_TOK; r += (int)gridDim.x) {
    float2* xr = (float2*)((float*)(p.ws + X_OFF) + (size_t)r * DM);
    float2 v = xr[tid];
    if (nsl) {
      float2 t[11];
#pragma unroll
      for (int sl = 0; sl < 11; ++sl) { t[sl] = make_float2(0.f, 0.f); if (sl < nsl) t[sl] = ((const float2*)(part + ((size_t)sl * 768 + (r - 16384)) * DM))[tid]; }
      float2 a = make_float2(0.f, 0.f);
#pragma unroll
      for (int sl = 0; sl < 11; ++sl) { a.x += t[sl].x; a.y += t[sl].y; }
      v.x += f * a.x; v.y += f * a.y;
      xr[tid] = v;
    }
    ((unsigned*)((u16*)(p.ws + XB_OFF) + (size_t)r * DM))[tid] = pk2(v.x, v.y);
    float ss = v.x * v.x + v.y * v.y;
#pragma unroll
    for (int o = 32; o > 0; o >>= 1) ss += __shfl_xor(ss, o);
    __syncthreads();
    if ((tid & 63) == 0) red[tid >> 6] = ss;
    __syncthreads();
    if (tid == 0) { float t = 0.f; for (int i = 0; i < 8; ++i) t += red[i]; rsv[r] = __builtin_amdgcn_rsqf(t * (1.f / 1024.f) + EPS); }
  }
}
template <class Epi>
DI void wide_gemm(const u16* A, const u16* Bt, int N, int K, const Epi& E, char* smem, int bid, int lda = 0, int M = T_PAD) {
  pg8::Gemm g; g.A = A; g.Bt = Bt; g.M = M; g.N = N; g.K = K; g.lda = lda ? lda : K; g.ldb = K;
  pg8::StaticOrder S; S.init(M, N, (int)gridDim.x, bid);
  __syncthreads();
  pg8::gemm_phase<Epi, pg8::StaticOrder, false>((PG8_LAS unsigned char*)smem, g, S, E, nullptr);
  __syncthreads();
}

DI void wconv_tile(const Params& p, int l, int t, char* smem) {
  u16* W = (u16*)(p.ws + W_OFF);
  const float* src; const float* fold = nullptr; int ld, K, map = 0; unsigned doff; int tn, tk;
  if (t < 7104) {
    int ntk;
    if (t < 1408) { src = p.in[8] + (size_t)l * 1024 * 5632; ld = 5632; K = 1024; fold = p.in[7] + l * 1024; map = 1; doff = (unsigned)WB_GU1; }
    else if (t < 2112) { t -= 1408; src = p.in[9] + (size_t)l * 2816 * 1024; ld = 1024; K = 2816; doff = (unsigned)WB_DN1; }
    else if (t < 3712) { t -= 2112; src = p.in[11] + (size_t)l * 1024 * 8208; ld = 8208; K = 1024; fold = p.in[10] + l * 1024; map = 2; doff = (unsigned)WB_WIN; }
    else if (t < 4224) { t -= 3712; src = p.in[11] + (size_t)l * 1024 * 8208 + 6160; ld = 8208; K = 1024; fold = p.in[10] + l * 1024; doff = (unsigned)WB_WG; }
    else if (t < 4480) { t -= 4224; src = p.in[23] + (size_t)l * 1048576; ld = 1024; K = 1024; doff = (unsigned)WB_BA; }
    else if (t < 4736) { t -= 4480; src = p.in[24] + (size_t)l * 1048576; ld = 1024; K = 1024; doff = (unsigned)WB_BB; }
    else if (t < 4992) { t -= 4736; src = p.in[25] + (size_t)l * 1048576; ld = 1024; K = 1024; doff = (unsigned)WB_WO; }
    else if (t < 6400) { t -= 4992; src = p.in[27] + (size_t)l * 1024 * 5632; ld = 5632; K = 1024; fold = p.in[26] + l * 1024; map = 1; doff = (unsigned)WB_GU2; }
    else { t -= 6400; src = p.in[28] + (size_t)l * 2816 * 1024; ld = 1024; K = 2816; doff = (unsigned)WB_DN2; }
    ntk = K >> 6; tn = t / ntk; tk = t - tn * ntk;
  } else {
    t -= 7104;
    const int mat = t >> 5, n = (t >> 2) & 7;
    src = p.in[mat ? 20 : 18] + (size_t)l * 131072 + n * 16384; ld = 128; K = 128;
    doff = (unsigned)(mat ? WB_WI : WB_WR) + n * 16384; tn = (t >> 1) & 1; tk = t & 1;
  }
  u16* dst = W + doff;
  u16* tl = (u16*)smem;
  const int tid = otid(), nl = tid & 63, kl = tid >> 6;
  const int np = tn * 64 + nl;
  int sc = np;
  if (map == 1) sc = ((np >> 4) & 1) * 2816 + 16 * (np >> 5) + (np & 15);
  else if (map == 2) sc = np < 4096 ? np : (np < 6144 ? np + 16 : (np < 6152 ? 4096 + (np - 6144) : (np < 6160 ? 4104 + (np - 6152) : -1)));
  __syncthreads();
#pragma unroll
  for (int i = 0; i < 16; ++i) {
    const int k = tk * 64 + kl + 4 * i;
    float v = 0.f;
    if (sc >= 0) { v = __builtin_nontemporal_load(src + (size_t)k * ld + sc); if (fold) v *= fold[k]; }
    tl[nl * 66 + kl + 4 * i] = f2bf(v);
  }
  __syncthreads();
  const int n = tid >> 2, kq = tid & 3;
  const unsigned* rp = (const unsigned*)(tl + n * 66 + 16 * kq);
  uint4 o0, o1;
  o0.x = rp[0]; o0.y = rp[1]; o0.z = rp[2]; o0.w = rp[3]; o1.x = rp[4]; o1.y = rp[5]; o1.z = rp[6]; o1.w = rp[7];
  uint4* dp = (uint4*)(dst + (size_t)(tn * 64 + n) * K + tk * 64 + 16 * kq);
  dp[0] = o0; dp[1] = o1;
}

DI void gather_item(const Params& p, int item, char* smem) {
  float* x = (float*)(p.ws + X_OFF);
  u16* xb = (u16*)(p.ws + XB_OFF);
  float* ssq = (float*)(p.ws + SSQ_OFF);
  float* red = (float*)smem;
  const int tid = otid();
  float4 v[8];
#pragma unroll
  for (int rr = 0; rr < 8; ++rr) {
    const int row = item * 8 + rr;
    const float* src;
    if (row < 16512) { const int s = row / 2064, pos = row - s * 2064; src = pos < 16 ? p.in[6] + pos * 1024 : p.in[0] + ((size_t)s * 2048 + (pos - 16)) * 1024; }
    else src = p.in[1] + (size_t)(row - 16512) * 1024;
    v[rr] = ((const float4*)src)[tid];
  }
  __syncthreads();
#pragma unroll
  for (int rr = 0; rr < 8; ++rr) {
    const int row = item * 8 + rr;
    ((float4*)(x + (size_t)row * DM))[tid] = v[rr];
    st_bf4(xb + (size_t)row * DM + 4 * tid, v[rr].x, v[rr].y, v[rr].z, v[rr].w);
    float ss = v[rr].x * v[rr].x + v[rr].y * v[rr].y + v[rr].z * v[rr].z + v[rr].w * v[rr].w;
#pragma unroll
    for (int o = 32; o > 0; o >>= 1) ss += __shfl_xor(ss, o);
    if ((tid & 63) == 0) red[rr * 4 + (tid >> 6)] = ss;
  }
  __syncthreads();
  if (tid < 128) {
    const int rr = tid >> 4, j = tid & 15;
    ssq[(size_t)(item * 8 + rr) * 16 + j] = (j == 0) ? (red[rr * 4] + red[rr * 4 + 1] + red[rr * 4 + 2] + red[rr * 4 + 3]) : 0.f;
  }
}

DI void final_phase(const Params& p, int vb, int nvb) {
  const float* x = (const float*)(p.ws + X_OFF);
  const float* ssq = (const float*)(p.ws + SSQ_OFF);
  const int tid = otid();
  const float4 fw = ((const float4*)p.in[29])[tid];
  for (int row0 = vb; row0 < T_TOK; row0 += 4 * nvb) {
    float4 v[4]; float rs[4]; float* dst[4];
#pragma unroll
    for (int u = 0; u < 4; ++u) {
      const int row = row0 + u * nvb;
      dst[u] = nullptr;
      if (row < T_TOK) {
        if (row < 16512) { const int s = row / 2064, pos = row - s * 2064; if (pos >= 16) dst[u] = p.out + O_YP + ((size_t)s * 2048 + (pos - 16)) * 1024; }
        else dst[u] = p.out + O_YS + (size_t)(row - 16512) * 1024;
      }
      if (dst[u]) { rs[u] = ((const float*)(p.ws + RSV_OFF))[row]; v[u] = ((const float4*)(x + (size_t)row * DM))[tid]; }
    }
#pragma unroll
    for (int u = 0; u < 4; ++u) {
      if (dst[u]) {
        float4 o = v[u];
        o.x *= rs[u] * fw.x; o.y *= rs[u] * fw.y; o.z *= rs[u] * fw.z; o.w *= rs[u] * fw.w;
        ((float4*)dst[u])[tid] = o;
      }
    }
  }
}

struct CI { int r0, nv, sbase, stream, last, sample; };
DI CI chunk_info(int ci) {
  CI c;
  if (ci < 264) {
    const int s = ci / 33, k = ci - s * 33;
    c.stream = s; c.sbase = s * 2064; c.sample = 0;
    if (k == 0) { c.r0 = c.sbase; c.nv = 16; } else { c.r0 = c.sbase + 16 + 64 * (k - 1); c.nv = 64; }
    c.last = (k == 32);
  } else {
    const int s = ci - 264;
    c.stream = 8 + s; c.sbase = 16512 + 32 * s; c.r0 = c.sbase; c.nv = 32; c.last = 1; c.sample = 1;
  }
  return c;
}

DI void dconv_store(const Params& p, int l, const CI& c, int cc, int ch, int half, char* RM, char* RT, float* cqo, const float w0, const float w1, const float w2, const float w3) {
  const u16* P = (const u16*)(p.ws + P_OFF);
  const int t0 = 32 * half;
  int pad = 64 - c.nv;
  asm volatile("" : "+v"(pad));
  float r[35];
  const int rowb = c.r0 + t0 - 3 - (64 - c.nv);
  int sbase_v = c.sbase;
  asm volatile("" : "+v"(sbase_v));
#pragma unroll
  for (int i = 0; i < 35; ++i) {
    int rowu = rowb + i;
    rowu = rowu < sbase_v ? sbase_v : rowu;
    r[i] = bf2f(P[(unsigned)rowu * (unsigned)PLD + (unsigned)cc]);
  }
  float hist[3] = {0.f, 0.f, 0.f};
  if (c.sample) {
#pragma unroll
    for (int j = 0; j < 3; ++j) hist[j] = p.in[3][((size_t)(l * 16 + (c.stream - 8)) * 3 + j) * 3072 + cc];
  }
#pragma unroll
  for (int i = 0; i < 35; ++i) {
    const int u = t0 - 3 + i, rowu = rowb + i;
    if (u < pad - 3) r[i] = 0.f;
    else if (rowu < sbase_v) { const int j = 3 + rowu - sbase_v; r[i] = (j == 0) ? hist[0] : (j == 1 ? hist[1] : hist[2]); }
  }
#pragma unroll
  for (int q = 0; q < 4; ++q) {
    const int tq = t0 + 8 * q;
    float o[8];
#pragma unroll
    for (int i = 0; i < 8; ++i) {
      const float sv = r[8 * q + i] * w0 + r[8 * q + i + 1] * w1 + r[8 * q + i + 2] * w2 + r[8 * q + i + 3] * w3;
      o[i] = (tq + i >= pad) ? silu_(sv) : 0.f;
    }
    if (RM) {
#pragma unroll
      for (int i = 0; i < 8; ++i) *(u16*)(RM + sw256(tq + i, ch >> 3) + (ch & 7) * 2) = f2bf(o[i]);
    }
    if (RT) {
      u32x4 v; v[0] = pk2(o[0], o[1]); v[1] = pk2(o[2], o[3]); v[2] = pk2(o[4], o[5]); v[3] = pk2(o[6], o[7]);
      *(u32x4*)(RT + sw128(ch, 4 * half + q)) = v;
    }
  }
  if (half && c.last) { cqo[cc] = r[32]; cqo[3072 + cc] = r[33]; cqo[6144 + cc] = r[34]; }
}

DI void delta_pre_item(const Params& p, int l, int it, char* smem, const float (&tw)[12]) {
  const int ci = it >> 3, h = it & 7;
  const CI c = chunk_info(ci);
  const u16* P = (const u16*)(p.ws + P_OFF);
  char* R0 = smem; char* R1 = smem + 16384; char* R2 = smem + 32768; float* Lm = (float*)(smem + 49152);
  float* sBeta = (float*)(smem + 65536); float* sGc = sBeta + 64; float* sNk = sBeta + 128; float* sNq = sBeta + 192;
  const int tid = otid(), lane = tid & 63, wid = tid >> 6, lr = lane & 31, lh = lane >> 5;
  const int ch = tid & 127, half = tid >> 7, t0 = 32 * half;
  const int pad = 64 - c.nv;
  float* cqo = p.out + (c.sample ? O_SCQ + ((size_t)(l * 16 + (c.stream - 8)) * 3) * 3072 : O_PCQ + ((size_t)(l * 8 + c.stream) * 3) * 3072);
  __syncthreads();
  dconv_store(p, l, c, h * 128 + ch, ch, half, R0, nullptr, cqo, tw[0], tw[1], tw[2], tw[3]);
  dconv_store(p, l, c, 1024 + h * 128 + ch, ch, half, R1, R2, cqo, tw[4], tw[5], tw[6], tw[7]);
  if (tid < 64) {
    float beta = 0.f, g = 0.f;
    if (tid >= pad) {
      const size_t row = (size_t)(c.r0 + tid - pad);
      beta = sigmoid_(bf2f(P[row * PLD + PC_BETA + h]));
      g = -__expf(p.in[13][l * 8 + h]) * softplus_(bf2f(P[row * PLD + PC_ALPHA + h]) + p.in[14][l * 8 + h]);
    }
#pragma unroll
    for (int o = 1; o < 64; o <<= 1) { const float v = __shfl_up(g, o); if (lane >= o) g += v; }
    sBeta[tid] = beta; sGc[tid] = g;
  }
  __syncthreads();
  const int ti = wid >> 1, tj = wid & 1;
  f32x16 aQK, aKK, aQQ;
  zero16(aQK); zero16(aKK); zero16(aQQ);
#pragma unroll
  for (int ks = 0; ks < 8; ++ks) {
    const bf16x8 kf = ldsfrag(R1, sw256(32 * tj + lr, 2 * ks + lh));
    const bf16x8 qf = ldsfrag(R0, sw256(32 * ti + lr, 2 * ks + lh));
    const bf16x8 kif = ldsfrag(R1, sw256(32 * ti + lr, 2 * ks + lh));
    aQK = MFMA(kf, qf, aQK);
    aKK = MFMA(kf, kif, aKK);
    if (ti == tj) aQQ = MFMA(qf, qf, aQQ);
  }
  if (ti == tj && (((lr >> 2) & 1) == lh)) {
    float vk = 0.f, vq = 0.f;
#pragma unroll
    for (int reg = 0; reg < 16; ++reg) if (crow(reg, lh) == lr) { vk = aKK[reg]; vq = aQQ[reg]; }
    sNk[32 * ti + lr] = vk; sNq[32 * ti + lr] = vq;
  }
  __syncthreads();
  const size_t itb = (size_t)it;
  {
    u16* Ag = (u16*)(p.ws + A_OFF) + itb * 4096;
    const int i = 32 * ti + lr;
    const float gi = sGc[i], rqi = __builtin_amdgcn_rsqf(sNq[i] + EPS) * 0.08838834764831845f, bki = sBeta[i] * __builtin_amdgcn_rsqf(sNk[i] + EPS);
#pragma unroll
    for (int b = 0; b < 4; ++b) {
      float av[4], lv[4];
#pragma unroll
      for (int r = 0; r < 4; ++r) {
        const int j = 32 * tj + 8 * b + 4 * lh + r;
        const float rkj = __builtin_amdgcn_rsqf(sNk[j] + EPS);
        const float dec = (j <= i) ? __expf(gi - sGc[j]) : 0.f;
        av[r] = rqi * rkj * aQK[4 * b + r] * dec;
        lv[r] = (j < i) ? bki * rkj * aKK[4 * b + r] * dec : 0.f;
      }
      st_bf4(Ag + i * 64 + 16 * (2 * tj + (b >> 1)) + 8 * lh + 4 * (b & 1), av[0], av[1], av[2], av[3]);
      *(float4*)(Lm + i * 64 + 32 * tj + 8 * b + 4 * lh) = make_float4(lv[0], lv[1], lv[2], lv[3]);
      if (wid == 2) st_bf4((u16*)(smem + 66560) + lr * 32 + 8 * b + 4 * lh, lv[0], lv[1], lv[2], lv[3]);
    }
    u16* Qg = (u16*)(p.ws + QD_OFF) + itb * 8192;
    u16* Kg = (u16*)(p.ws + KD_OFF) + itb * 8192;
    const float glc = sGc[63];
#pragma unroll
    for (int ii = 0; ii < 4; ++ii) {
      const int q = tid + 256 * ii;
      {
        const int t = q >> 4, chn = q & 15, s = chn >> 1, hh = chn & 1;
        const float sc = __builtin_amdgcn_rsqf(sNq[t] + EPS) * 0.08838834764831845f * __expf(sGc[t]);
        const int c0 = 16 * s + 4 * hh, c1 = c0 + 8;
        const float4 v0 = ld_bf4((const u16*)(R0 + sw256(t, c0 >> 3) + (c0 & 7) * 2));
        const float4 v1 = ld_bf4((const u16*)(R0 + sw256(t, c1 >> 3) + (c1 & 7) * 2));
        uint4 o; o.x = pk2(v0.x * sc, v0.y * sc); o.y = pk2(v0.z * sc, v0.w * sc); o.z = pk2(v1.x * sc, v1.y * sc); o.w = pk2(v1.z * sc, v1.w * sc);
        *(uint4*)(Qg + t * 128 + 8 * chn) = o;
      }
      {
        const int dk = q >> 3, chn = q & 7, s = chn >> 1, hh = chn & 1;
        const int ta = 16 * s + 4 * hh, tb = ta + 8;
        const float4 v0 = ld_bf4((const u16*)(R2 + sw128(dk, ta >> 3) + (ta & 7) * 2));
        const float4 v1 = ld_bf4((const u16*)(R2 + sw128(dk, tb >> 3) + (tb & 7) * 2));
        float sa[4], sb[4];
#pragma unroll
        for (int r = 0; r < 4; ++r) { sa[r] = __builtin_amdgcn_rsqf(sNk[ta + r] + EPS) * __expf(glc - sGc[ta + r]); sb[r] = __builtin_amdgcn_rsqf(sNk[tb + r] + EPS) * __expf(glc - sGc[tb + r]); }
        uint4 o; o.x = pk2(v0.x * sa[0], v0.y * sa[1]); o.y = pk2(v0.z * sa[2], v0.w * sa[3]); o.z = pk2(v1.x * sb[0], v1.y * sb[1]); o.w = pk2(v1.z * sb[2], v1.w * sb[3]);
        *(uint4*)(Kg + dk * 64 + 8 * chn) = o;
      }
    }
    if (tid == 0) ((float*)(p.ws + GL_OFF))[it] = __expf(glc);
  }
  __syncthreads();
  dconv_store(p, l, c, 2048 + h * 128 + ch, ch, half, nullptr, R0, cqo, tw[8], tw[9], tw[10], tw[11]);
  {
    u16* L21b = (u16*)(smem + 66560); u16* T11t = (u16*)(smem + 68608); u16* T22b = (u16*)(smem + 70656);
    if (wid < 2) {
      const int blk = wid, cc = 32 * blk + lr;
      float tc[32];
#pragma unroll
      for (int i = 0; i < 32; ++i) tc[i] = 0.f;
#pragma unroll
      for (int i = 0; i < 32; ++i) {
        float sacc = (i == lr) ? 1.f : 0.f;
#pragma unroll
        for (int j4 = 0; j4 < i; j4 += 4) {
          const float4 lv = *(const float4*)(Lm + (32 * blk + i) * 64 + 32 * blk + j4);
          sacc -= lv.x * tc[j4]; sacc -= lv.y * tc[j4 + 1]; sacc -= lv.z * tc[j4 + 2]; sacc -= lv.w * tc[j4 + 3];
        }
        tc[i] = sacc;
      }
      if (lh == 0) {
        const float b1 = sBeta[cc], c1 = b1 * __builtin_amdgcn_rsqf(sNk[cc] + EPS) * __expf(sGc[cc]);
#pragma unroll
        for (int i = 0; i < 32; ++i) {
          const int off = sw128(32 * blk + i, cc >> 3) + (cc & 7) * 2;
          *(u16*)(R1 + off) = f2bf(tc[i] * c1);
          *(u16*)(R1 + 8192 + off) = f2bf(tc[i] * b1);
        }
        if (blk == 0) {
#pragma unroll
          for (int q = 0; q < 4; ++q) {
            u32x4 v; v[0] = pk2(tc[8 * q], tc[8 * q + 1]); v[1] = pk2(tc[8 * q + 2], tc[8 * q + 3]); v[2] = pk2(tc[8 * q + 4], tc[8 * q + 5]); v[3] = pk2(tc[8 * q + 6], tc[8 * q + 7]);
            *(u32x4*)(T11t + lr * 32 + 8 * q) = v;
          }
        } else {
#pragma unroll
          for (int i = 0; i < 32; ++i) T22b[i * 32 + lr] = f2bf(tc[i]);
        }
      }
    } else {
#pragma unroll
      for (int i = 0; i < 2; ++i) {
        const int idx = (tid - 128) + 128 * i, mat = idx >> 7, rc = idx & 127;
        u32x4 z; z[0] = 0u; z[1] = 0u; z[2] = 0u; z[3] = 0u;
        *(u32x4*)(R1 + mat * 8192 + sw128(rc >> 2, 4 + (rc & 3))) = z;
      }
    }
    __syncthreads();
    if (wid == 0) {
      f32x16 Mx, D2;
      zero16(Mx); zero16(D2);
#pragma unroll
      for (int ks = 0; ks < 2; ++ks) {
        const bf16x8 xf = *(const bf16x8*)(L21b + lr * 32 + (2 * ks + lh) * 8);
        const bf16x8 yf = *(const bf16x8*)(T11t + lr * 32 + (2 * ks + lh) * 8);
        Mx = MFMA(xf, yf, Mx);
      }
#pragma unroll
      for (int sx = 0; sx < 2; ++sx) {
        const bf16x8 yp = sx ? pack8<1>(Mx) : pack8<0>(Mx);
        const uint2 lo = *(const uint2*)(T22b + lr * 32 + 16 * sx + 4 * lh);
        const uint2 hi = *(const uint2*)(T22b + lr * 32 + 16 * sx + 8 + 4 * lh);
        u32x4 xv; xv[0] = lo.x; xv[1] = lo.y; xv[2] = hi.x; xv[3] = hi.y;
        D2 = MFMA(__builtin_bit_cast(bf16x8, xv), yp, D2);
      }
      const float b1 = sBeta[lr], c1 = b1 * __builtin_amdgcn_rsqf(sNk[lr] + EPS) * __expf(sGc[lr]);
#pragma unroll
      for (int r = 0; r < 16; ++r) {
        const int off = sw128(32 + crow(r, lh), lr >> 3) + (lr & 7) * 2;
        *(u16*)(R1 + off) = f2bf(-D2[r] * c1);
        *(u16*)(R1 + 8192 + off) = f2bf(-D2[r] * b1);
      }
    }
  }
  __syncthreads();
  {
    u16* Wg = (u16*)(p.ws + WW_OFF) + itb * 8192;
    u16* Ug = (u16*)(p.ws + UT_OFF) + itb * 8192;
    f32x16 aw[2], au[2];
    zero16(aw[0]); zero16(aw[1]); zero16(au[0]); zero16(au[1]);
#pragma unroll
    for (int ks = 0; ks < 4; ++ks) {
      const bf16x8 kT = ldsfrag(R2, sw128(32 * wid + lr, 2 * ks + lh));
      const bf16x8 vT = ldsfrag(R0, sw128(32 * wid + lr, 2 * ks + lh));
#pragma unroll
      for (int bb = 0; bb < 2; ++bb) {
        const bf16x8 t1 = ldsfrag(R1, sw128(32 * bb + lr, 2 * ks + lh));
        const bf16x8 t2 = ldsfrag(R1 + 8192, sw128(32 * bb + lr, 2 * ks + lh));
        aw[bb] = MFMA(kT, t1, aw[bb]);
        au[bb] = MFMA(t2, vT, au[bb]);
      }
    }
#pragma unroll
    for (int bb = 0; bb < 2; ++bb)
#pragma unroll
      for (int b = 0; b < 4; ++b) {
        st_bf4(Wg + (32 * bb + lr) * 128 + 32 * wid + 16 * (b >> 1) + 8 * lh + 4 * (b & 1), aw[bb][4 * b], aw[bb][4 * b + 1], aw[bb][4 * b + 2], aw[bb][4 * b + 3]);
        st_bf4(Ug + (32 * wid + lr) * 64 + 32 * bb + 8 * b + 4 * lh, au[bb][4 * b], au[bb][4 * b + 1], au[bb][4 * b + 2], au[bb][4 * b + 3]);
      }
  }
}

DI void delta_seq_item(const Params& p, int l, int item, char* smem) {
  const int stream = item >> 3, h = item & 7;
  const int tid = otid(), lane = tid & 63, wid = tid >> 6, lr = lane & 31, lh = lane >> 5;
  const int dv = 32 * wid + lr;
  u16* P = (u16*)(p.ws + P_OFF);
  f32x16 S[4];
  float* Sout;
  int nchunk, ci0;
  if (stream < 8) {
#pragma unroll
    for (int m = 0; m < 4; ++m) zero16(S[m]);
    Sout = p.out + O_PS + ((size_t)(l * 8 + stream) * 8 + h) * 16384;
    nchunk = 33; ci0 = stream * 33;
  } else {
    const float* S0 = p.in[2] + ((size_t)(l * 16 + (stream - 8)) * 8 + h) * 16384;
    const float* sp = S0 + (4 * lh) * 128 + dv;
#pragma unroll
    for (int m = 0; m < 4; ++m)
#pragma unroll
      for (int b = 0; b < 4; ++b) {
#pragma unroll
        for (int r = 0; r < 4; ++r) S[m][4 * b + r] = sp[r * 128];
        sp += 8 * 128;
        __builtin_amdgcn_sched_barrier(0);
      }
    Sout = p.out + O_SS + ((size_t)(l * 16 + (stream - 8)) * 8 + h) * 16384;
    nchunk = 1; ci0 = 264 + (stream - 8);
  }
  char* sW = smem; char* sQ = smem + 16384; char* sK = smem + 32768; char* sA = smem + 49152; char* sO = smem + 57344;
#define DMA256(gbase, lbase) { _Pragma("unroll") for (int ii = 0; ii < 4; ++ii) { const int pos = tid + 256 * ii, row = pos >> 4, chn = (pos & 15) ^ (row & 15); \
    __builtin_amdgcn_global_load_lds((const unsigned*)((gbase) + row * 128 + chn * 8), (lds_u32*)((lbase) + pos * 16), 16, 0, 0); } }
#define DMA128(gbase, lbase, n) { _Pragma("unroll") for (int ii = 0; ii < (n); ++ii) { const int pos = tid + 256 * ii, row = pos >> 3, chn = (pos & 7) ^ ((row >> 1) & 7); \
    __builtin_amdgcn_global_load_lds((const unsigned*)((gbase) + row * 64 + chn * 8), (lds_u32*)((lbase) + pos * 16), 16, 0, 0); } }
  __syncthreads();
  {
    const size_t it = (size_t)ci0 * 8 + h;
    const u16* Wg = (const u16*)(p.ws + WW_OFF) + it * 8192;
    const u16* Qg = (const u16*)(p.ws + QD_OFF) + it * 8192;
    DMA256(Wg, sW); DMA256(Qg, sQ);
  }
  asm volatile("s_waitcnt vmcnt(0)" ::: "memory");
  __syncthreads();
  for (int k = 0; k < nchunk; ++k) {
    const int ci = ci0 + k;
    const CI c = chunk_info(ci);
    const size_t it = (size_t)ci * 8 + h;
    const u16* Kg = (const u16*)(p.ws + KD_OFF) + it * 8192;
    const u16* Ag = (const u16*)(p.ws + A_OFF) + it * 4096;
    const u16* Ug = (const u16*)(p.ws + UT_OFF) + it * 8192;
    const float gl = ((const float*)(p.ws + GL_OFF))[it];
    if (k == 0) { DMA128(Kg, sK, 4); DMA128(Ag, sA, 2); }
    uint2 uvr[2][4];
#pragma unroll
    for (int m = 0; m < 2; ++m)
#pragma unroll
      for (int b = 0; b < 4; ++b) uvr[m][b] = *(const uint2*)(Ug + dv * 64 + 32 * m + 8 * b + 4 * lh);
    const int et = tid >> 2, eq = tid & 3, epad = 64 - c.nv;
    const bool erow = (et >= epad);
    const size_t erow_off = (size_t)(c.r0 + (erow ? et - epad : 0)) * PLD + h * 128 + 32 * eq;
    f32x16 M1[2], M2[2];
    zero16(M1[0]); zero16(M1[1]); zero16(M2[0]); zero16(M2[1]);
#pragma unroll
    for (int mt = 0; mt < 4; ++mt) {
#pragma unroll
      for (int sx = 0; sx < 2; ++sx) {
        const int ks = 2 * mt + sx;
        const bf16x8 Sp = sx ? pack8<1>(S[mt]) : pack8<0>(S[mt]);
#pragma unroll
        for (int m = 0; m < 2; ++m) {
          const bf16x8 wf = ldsfrag(sW, sw256(32 * m + lr, 2 * ks + lh));
          const bf16x8 qf = ldsfrag(sQ, sw256(32 * m + lr, 2 * ks + lh));
          M1[m] = MFMA(wf, Sp, M1[m]);
          M2[m] = MFMA(qf, Sp, M2[m]);
        }
      }
    }
    asm volatile("s_waitcnt vmcnt(0)" ::: "memory");
    __syncthreads();
    const bool more = (k + 1 < nchunk);
    if (more) {
      const u16* Wg = (const u16*)(p.ws + WW_OFF) + (it + 8) * 8192;
      const u16* Qg = (const u16*)(p.ws + QD_OFF) + (it + 8) * 8192;
      DMA256(Wg, sW); DMA256(Qg, sQ);
    }
    uint2 zr[8];
#pragma unroll
    for (int i = 0; i < 8; ++i) zr[i] = *(const uint2*)(P + erow_off + PC_Z + 4 * i);
#pragma unroll
    for (int m = 0; m < 2; ++m)
#pragma unroll
      for (int b = 0; b < 4; ++b) {
        const uint2 u2 = uvr[m][b];
        M1[m][4 * b] = __uint_as_float(u2.x << 16) - M1[m][4 * b]; M1[m][4 * b + 1] = __uint_as_float(u2.x & 0xffff0000u) - M1[m][4 * b + 1];
        M1[m][4 * b + 2] = __uint_as_float(u2.y << 16) - M1[m][4 * b + 2]; M1[m][4 * b + 3] = __uint_as_float(u2.y & 0xffff0000u) - M1[m][4 * b + 3];
      }
    bf16x8 Vp[4];
    Vp[0] = pack8<0>(M1[0]); Vp[1] = pack8<1>(M1[0]); Vp[2] = pack8<0>(M1[1]); Vp[3] = pack8<1>(M1[1]);
#pragma unroll
    for (int mt = 0; mt < 4; ++mt) {
#pragma unroll
      for (int r = 0; r < 16; ++r) S[mt][r] *= gl;
#pragma unroll
      for (int kk = 0; kk < 4; ++kk) {
        const bf16x8 kf = ldsfrag(sK, sw128(32 * mt + lr, 2 * kk + lh));
        S[mt] = MFMA(kf, Vp[kk], S[mt]);
      }
    }
#pragma unroll
    for (int m = 0; m < 2; ++m)
#pragma unroll
      for (int kk = 0; kk < 4; ++kk) {
        const bf16x8 af = ldsfrag(sA, sw128(32 * m + lr, 2 * kk + lh));
        M2[m] = MFMA(af, Vp[kk], M2[m]);
      }
#pragma unroll
    for (int m = 0; m < 2; ++m)
#pragma unroll
      for (int r = 0; r < 16; ++r) *(u16*)(sO + (32 * m + crow(r, lh)) * 256 + dv * 2) = f2bf(M2[m][r]);
    __syncthreads();
    if (more) { DMA128(Kg + 8 * 8192, sK, 4); DMA128(Ag + 8 * 4096, sA, 2); }
    {
      float ov[32];
      float ss = 0.f;
#pragma unroll
      for (int i = 0; i < 4; ++i) {
        const u32x4 t4 = *(const u32x4*)(sO + et * 256 + 64 * eq + 16 * i);
#pragma unroll
        for (int e = 0; e < 4; ++e) {
          const float a0 = __uint_as_float(t4[e] << 16), a1 = __uint_as_float(t4[e] & 0xffff0000u);
          ov[8 * i + 2 * e] = a0; ov[8 * i + 2 * e + 1] = a1; ss += a0 * a0 + a1 * a1;
        }
      }
      ss += __shfl_xor(ss, 1); ss += __shfl_xor(ss, 2);
      const float rs = __builtin_amdgcn_rsqf(ss * (1.f / 128.f) + EPS);
      if (erow) {
        u16* op = P + erow_off + PC_OA;
        const float* nw = p.in[15] + l * 128 + 32 * eq;
#pragma unroll
        for (int i = 0; i < 8; ++i) {
          const float zx = __uint_as_float(zr[i].x << 16), zy = __uint_as_float(zr[i].x & 0xffff0000u), zz = __uint_as_float(zr[i].y << 16), zw = __uint_as_float(zr[i].y & 0xffff0000u);
          const float4 w4 = *(const float4*)(nw + 4 * i);
          st_bf4(op + 4 * i, ov[4 * i] * rs * w4.x * silu_(zx), ov[4 * i + 1] * rs * w4.y * silu_(zy), ov[4 * i + 2] * rs * w4.z * silu_(zz), ov[4 * i + 3] * rs * w4.w * silu_(zw));
        }
      }
    }
    if (more) {
      asm volatile("s_waitcnt vmcnt(0)" ::: "memory");
      __syncthreads();
    }
  }
#undef DMA256
#undef DMA128
  float* so = Sout + (4 * lh) * 128 + dv;
#pragma unroll
  for (int m = 0; m < 4; ++m)
#pragma unroll
    for (int b = 0; b < 4; ++b) {
#pragma unroll
      for (int r = 0; r < 4; ++r) so[r * 128] = S[m][4 * b + r];
      so += 8 * 128;
      __builtin_amdgcn_sched_barrier(0);
    }
}

struct LT { int r0, nv, first, last, stream; };
DI LT lru_tile(int tl) {
  LT t;
  if (tl < 520) { const int s = tl / 65, j = tl - s * 65; t.stream = s; t.first = (j == 0); t.last = (j == 64); t.nv = j ? 32 : 16; t.r0 = s * 2064 + (j ? 16 + 32 * (j - 1) : 0); }
  else { const int s = tl - 520; t.stream = 8 + s; t.first = 1; t.last = 1; t.nv = 32; t.r0 = 16512 + 32 * s; }
  return t;
}
DI void lru_a_item(const Params& p, int l, int item, char* smem, const bf16x8 (&wrf)[8], const bf16x8 (&wif)[8],
                   const float cw0, const float cw1, const float cw2, const float cw3, const float cb, const float br, const float bi, const float c8) {
  const int tl = item >> 3, n = item & 7;
  const LT T = lru_tile(tl);
  const int tid = otid(), lane = tid & 63, wid = tid >> 6, lr = lane & 31, lh = lane >> 5;
  u16* P = (u16*)(p.ws + P_OFF);
  u16* Ya = (u16*)(p.out + O_YP);
  const u16* W = (const u16*)(p.ws + W_OFF);
  float* AG = (float*)(p.ws + AG_OFF);
  float* raw = (float*)smem; float* xc = (float*)(smem + 18432); char* xcb = smem + 34816;
  const int ch = tid & 127, rp = tid >> 7;
  const int gc = n * 128 + ch;
  const int d = 32 * wid + lr, gd = n * 128 + d;
  float lyv[16];
#pragma unroll
  for (int r = 0; r < 16; ++r) { const int t = crow(r, lh); lyv[r] = (t < T.nv) ? bf2f(P[(size_t)(T.r0 + t) * PLD + PC_LY + gd]) : 0.f; }
  __syncthreads();
#pragma unroll
  for (int i = 0; i < 18; ++i) {
    const int rr = rp + 2 * i;
    if (rr < 3 + T.nv) {
      float v;
      if (rr >= 3 || !T.first) v = bf2f(P[(size_t)(T.r0 + rr - 3) * PLD + PC_LX + gc]);
      else v = (T.stream >= 8) ? p.in[5][((size_t)(l * 16 + (T.stream - 8)) * 3 + rr) * 1024 + gc] : 0.f;
      raw[rr * 128 + ch] = v;
    }
  }
  __syncthreads();
#pragma unroll 4
  for (int t = rp; t < 32; t += 2) {
    float v = 0.f;
    if (t < T.nv) v = cb + raw[t * 128 + ch] * cw0 + raw[(t + 1) * 128 + ch] * cw1 + raw[(t + 2) * 128 + ch] * cw2 + raw[(t + 3) * 128 + ch] * cw3;
    xc[t * 128 + ch] = v;
    *(u16*)(xcb + sw256(t, ch >> 3) + (ch & 7) * 2) = f2bf(v);
  }
  if (T.last && tid < 128) {
    float* ocx = (T.stream < 8) ? p.out + O_PCX + (size_t)(l * 8 + T.stream) * 3 * 1024 : p.out + O_SCX + (size_t)(l * 16 + (T.stream - 8)) * 3 * 1024;
    ocx[gc] = raw[T.nv * 128 + ch]; ocx[1024 + gc] = raw[(T.nv + 1) * 128 + ch]; ocx[2048 + gc] = raw[(T.nv + 2) * 128 + ch];
  }
  __syncthreads();
  f32x16 aR, aI;
  zero16(aR); zero16(aI);
#pragma unroll
  for (int ks = 0; ks < 8; ++ks) {
    const bf16x8 af = ldsfrag(xcb, sw256(lr, 2 * ks + lh));
    aR = MFMA(af, wrf[ks], aR);
    aI = MFMA(af, wif[ks], aI);
  }
  float av[16], bv[16], hv[16], pv[16];
#pragma unroll
  for (int r = 0; r < 16; ++r) {
    const int t = crow(r, lh);
    const float rr = sigmoid_(aR[r] + br), ig = sigmoid_(aI[r] + bi);
    const float la = c8 * rr;
    const float a = __expf(la), mult = __builtin_amdgcn_sqrtf(fmaxf(1.f - __expf(2.f * la), 0.f));
    const float xv = xc[t * 128 + d];
    av[r] = (t < T.nv) ? a : 1.f;
    bv[r] = (t < T.nv) ? mult * ig * xv : 0.f;
  }
  float hc = 0.f, pc = 1.f;
#pragma unroll
  for (int b = 0; b < 4; ++b) {
    float cA = hc, qA = pc, tA[4], uA[4], tB[4], uB[4];
#pragma unroll
    for (int r = 0; r < 4; ++r) { cA = av[4 * b + r] * cA + bv[4 * b + r]; qA = av[4 * b + r] * qA; tA[r] = cA; uA[r] = qA; }
    hc = __shfl(cA, lr); pc = __shfl(qA, lr);
    float cB = hc, qB = pc;
#pragma unroll
    for (int r = 0; r < 4; ++r) { cB = av[4 * b + r] * cB + bv[4 * b + r]; qB = av[4 * b + r] * qB; tB[r] = cB; uB[r] = qB; }
    hc = __shfl(cB, lr + 32); pc = __shfl(qB, lr + 32);
#pragma unroll
    for (int r = 0; r < 4; ++r) { hv[4 * b + r] = lh ? tB[r] : tA[r]; pv[4 * b + r] = lh ? uB[r] : uA[r]; }
  }
#pragma unroll
  for (int r = 0; r < 16; ++r) {
    const int t = crow(r, lh);
    if (t < T.nv) {
      const float g = gelu_tanh_(lyv[r]);
      P[(size_t)(T.r0 + t) * PLD + PC_LY + gd] = f2bf(hv[r] * g);
      Ya[(size_t)(T.r0 + t) * 1024 + gd] = f2bf(pv[r] * g);
    }
  }
  if (lh == 0) { AG[(size_t)(tl * 2) * 1024 + gd] = pc; AG[(size_t)(tl * 2 + 1) * 1024 + gd] = hc; }
}

DI void lru_b_item(const Params& p, int l, int item, char* smem) {
  const int tid = otid();
  u16* P = (u16*)(p.ws + P_OFF);
  const u16* Ya = (const u16*)(p.out + O_YP);
  const float* AG = (const float*)(p.ws + AG_OFF);
  float* cin = (float*)smem;
  int stream, n, qtr, ntile, tl0, rbase, L;
  if (item < 256) { stream = item >> 5; n = (item >> 2) & 7; qtr = item & 3; ntile = 65; tl0 = stream * 65; rbase = stream * 2064; L = 2064; }
  else { const int q = item - 256; stream = 8 + (q >> 3); n = q & 7; qtr = -1; ntile = 1; tl0 = 520 + (stream - 8); rbase = 16512 + 32 * (stream - 8); L = 32; }
  __syncthreads();
  if (tid < 128) {
    const int gd = n * 128 + tid;
    float c = (stream >= 8) ? p.in[4][(size_t)(l * 16 + (stream - 8)) * 1024 + gd] : 0.f;
#pragma unroll 13
    for (int j = 0; j < ntile; ++j) {
      const float a = AG[(size_t)((tl0 + j) * 2) * 1024 + gd], h = AG[(size_t)((tl0 + j) * 2 + 1) * 1024 + gd];
      cin[j * 128 + tid] = c;
      c = a * c + h;
    }
    if (qtr <= 0) {
      float* oh = (stream < 8) ? p.out + O_PH + (size_t)(l * 8 + stream) * 1024 : p.out + O_SH + (size_t)(l * 16 + (stream - 8)) * 1024;
      oh[gd] = c;
    }
  }
  __syncthreads();
  const int ck = tid & 15, rsub = tid >> 4;
  int pb = 0, pe = L;
  if (qtr >= 0) { pb = 516 * qtr; pe = pb + 516; }
  for (int pr0 = pb + rsub; pr0 < pe; pr0 += 64) {
    u32x4 yl[4], ya[4];
#pragma unroll
    for (int u = 0; u < 4; ++u) {
      const int pr = pr0 + 16 * u;
      if (pr < pe) {
        const size_t row = (size_t)(rbase + pr);
        yl[u] = *(const u32x4*)(P + row * PLD + PC_LY + n * 128 + 8 * ck);
        ya[u] = *(const u32x4*)(Ya + row * 1024 + n * 128 + 8 * ck);
      }
    }
#pragma unroll
    for (int u = 0; u < 4; ++u) {
      const int pr = pr0 + 16 * u;
      if (pr < pe) {
        const int j = (stream < 8) ? (pr < 16 ? 0 : 1 + ((pr - 16) >> 5)) : 0;
        const size_t row = (size_t)(rbase + pr);
        const float* cp = cin + j * 128 + 8 * ck;
        u32x4 o;
#pragma unroll
        for (int e = 0; e < 4; ++e) {
          const float y0 = __uint_as_float(yl[u][e] << 16) + __uint_as_float(ya[u][e] << 16) * cp[2 * e];
          const float y1 = __uint_as_float(yl[u][e] & 0xffff0000u) + __uint_as_float(ya[u][e] & 0xffff0000u) * cp[2 * e + 1];
          o[e] = pk2(y0, y1);
        }
        *(u32x4*)(P + row * PLD + PC_Y + n * 128 + 8 * ck) = o;
      }
    }
  }
}

#define XB_TMO      128
#define XB_XCNT(j)  (256  + 64 * (j))
#define XB_XSUB(j)  (1280 + 64 * (j))
#define XB_XGEN(j)  (2304 + 64 * (j))
#define XB_TOP      3328
#define XB_TOPGEN   3392
#define XCD_BAR_WORDS 3456
#define XB_SPIN_CAP (1u << 22)
DI unsigned xb_ld(unsigned* p) { return __hip_atomic_load(p, __ATOMIC_RELAXED, __HIP_MEMORY_SCOPE_AGENT); }
DI unsigned xb_add(unsigned* p, unsigned v) { return __hip_atomic_fetch_add(p, v, __ATOMIC_RELAXED, __HIP_MEMORY_SCOPE_AGENT); }
DI unsigned xb_xcc_id() { return (unsigned)__builtin_amdgcn_s_getreg((3 << 11) | 20) & 0xFu; }
#define XB_SPIN(cond, bar) do { unsigned _sp = 0; while (cond) { __builtin_amdgcn_s_sleep(1); \
    if ((++_sp & 255u) == 0u) { if (xb_ld(&(bar)[XB_TMO])) break; if (_sp > XB_SPIN_CAP) { atomicAdd(&(bar)[XB_TMO], 1u); break; } } } } while (0)
struct XcdBarrier { unsigned* bar; unsigned x; volatile unsigned* st; };
DI XcdBarrier xcd_barrier_post(unsigned* bar, volatile unsigned* st) {
  XcdBarrier b; b.bar = bar; b.x = xb_xcc_id(); b.st = st;
  if (threadIdx.x == 0) (void)xb_add(&bar[XB_XCNT(b.x)], 1u);
  return b;
}
DI void xcd_barrier_complete(unsigned* bar, unsigned x, unsigned& nloc, unsigned& nx) {
  const unsigned G = gridDim.x * gridDim.y * gridDim.z;
  unsigned sum, cnt, mine, sp = 0u;
  for (;;) {
    sum = 0u; cnt = 0u; mine = 0u;
#pragma unroll
    for (unsigned j = 0; j < 16; ++j) { const unsigned c = xb_ld(&bar[XB_XCNT(j)]); sum += c; cnt += (c > 0u) ? 1u : 0u; mine = (j == x) ? c : mine; }
    if (sum == G) break;
    __builtin_amdgcn_s_sleep(1);
    if ((++sp & 255u) == 0u) { if (xb_ld(&bar[XB_TMO])) break; if (sp > XB_SPIN_CAP) { atomicAdd(&bar[XB_TMO], 1u); break; } }
  }
  nloc = mine > 0u ? mine : 1u; nx = cnt > 0u ? cnt : 1u;
}
DI void xcd_barrier(const XcdBarrier& b) {
  asm volatile("s_waitcnt vmcnt(0)" ::: "memory");
  __syncthreads();
  if (threadIdx.x == 0) {
    unsigned* bar = b.bar;
    __builtin_amdgcn_s_waitcnt(0);
    unsigned nloc = b.st[0], nx = b.st[1];
    if (nloc == 0u) { xcd_barrier_complete(bar, b.x, nloc, nx); b.st[0] = nloc; b.st[1] = nx; }
    const unsigned old = xb_add(&bar[XB_XSUB(b.x)], 1u);
    const unsigned gen = old / nloc;
    if (old + 1u == (gen + 1u) * nloc) {
      __builtin_amdgcn_fence(__ATOMIC_RELEASE, "agent");
      asm volatile("s_waitcnt vmcnt(0)" ::: "memory");
      const unsigned og = xb_add(&bar[XB_TOP], 1u);
      const unsigned tg = og / nx;
      if (og + 1u == (tg + 1u) * nx) xb_add(&bar[XB_TOPGEN], 1u);
      else XB_SPIN(xb_ld(&bar[XB_TOPGEN]) == tg, bar);
      __builtin_amdgcn_fence(__ATOMIC_ACQUIRE, "agent");
      xb_add(&bar[XB_XGEN(b.x)], 1u);
      asm volatile("s_waitcnt vmcnt(0)" ::: "memory");
    } else {
      XB_SPIN(xb_ld(&bar[XB_XGEN(b.x)]) == gen, bar);
      __builtin_amdgcn_fence(__ATOMIC_ACQUIRE, "agent");
      asm volatile("s_waitcnt vmcnt(0)" ::: "memory");
    }
  }
  __syncthreads();
}

__global__ void __launch_bounds__(512, 2) mega(Params p, int lo, int hi) {
  extern __shared__ __attribute__((aligned(16))) char smem[];
  volatile unsigned* bst = (volatile unsigned*)(smem + 2 * HALF_LDS);
  if (threadIdx.x == 0) { bst[0] = 0u; bst[1] = 0u; }
  __syncthreads();
  const XcdBarrier gb = xcd_barrier_post((unsigned*)(p.ws + BAR_OFF), bst);
  if (lo < 0) cg::this_grid().sync();
#define GRID_SYNC() xcd_barrier(gb)
  const int hid = __builtin_amdgcn_readfirstlane((int)(threadIdx.x >> 8));
  char* hs = smem + hid * HALF_LDS;
  const int vb0 = 2 * blockIdx.x + hid;
  const int nvb = 2 * gridDim.x;
  int ph = 0;
#if defined(__HIP_DEVICE_COMPILE__)
#define LOAD_PARAMS(q) const __attribute__((address_space(4))) Params* pk_ = (const __attribute__((address_space(4))) Params*)__builtin_amdgcn_kernarg_segment_ptr(); \
    asm volatile("" : "+s"(pk_)); Params q; _Pragma("unroll") for (int i_ = 0; i_ < 30; ++i_) q.in[i_] = pk_->in[i_]; q.out = pk_->out; q.ws = pk_->ws;
#else
#define LOAD_PARAMS(q) Params q = p;
#endif
#define PH(...) { if (ph >= lo && ph < hi) { if (ph > lo) GRID_SYNC(); LOAD_PARAMS(q) asm volatile("" : "+s"(q.ws), "+s"(q.out)); \
    int lz_ = 0; asm volatile("" : "+s"(lz_)); const int vb = vb0 + lz_; const int bid = (int)blockIdx.x + lz_; (void)vb; (void)bid; \
    const u16* xb = (const u16*)(q.ws + XB_OFF); const u16* P = (const u16*)(q.ws + P_OFF); const u16* W = (const u16*)(q.ws + W_OFF); (void)xb; (void)P; (void)W; __VA_ARGS__ } ++ph; }
  PH({
    for (int w = vb; w < 3776 + 2128; w += nvb) {
      if (w < 3776) wconv_tile(q, 0, w < 3712 ? w : 7104 + (w - 3712), hs); else gather_item(q, w - 3776, hs);
    }
  })
#pragma unroll 1
  for (int l = 0; l < 5; ++l) {
    PH({ rs_pass(q, smem, l > 0 ? 11 : 0, 0.5f, (const float*)(q.ws + PART_OFF)); if (l < 4) { GRID_SYNC(); EpiGU e; e.H = (u16*)(q.ws + P_OFF); e.rsv = (const float*)(q.ws + RSV_OFF); wide_gemm(xb, W + WB_GU1, 5632, DM, e, smem, bid); } })
    if (l == 4) break;
    PH({ EpiDOWN e; e.x = (float*)(q.ws + X_OFF); e.xb = (u16*)(q.ws + XB_OFF); e.ssq = (float*)(q.ws + SSQ_OFF); e.f = 0.5f; resid_gemm(P, DFF, W + WB_DN1, DFF, e, (float*)(q.ws + PART_OFF), smem, bid); })
    PH({ rs_pass(q, smem, 11, 0.5f, (const float*)(q.ws + PART_OFF)); GRID_SYNC(); EpiWIN e; e.P = (u16*)(q.ws + P_OFF); e.rsv = (const float*)(q.ws + RSV_OFF); wide_gemm(xb, W + WB_WIN, 6400, DM, e, smem, bid); })
    PH({
      float tw[12];
      { const int t4 = otid(); const float* cwp4 = q.in[12] + (size_t)l * 4 * 3072 + (vb & 7) * 128 + (t4 & 127);
        _Pragma("unroll") for (int sel = 0; sel < 3; ++sel) _Pragma("unroll") for (int j = 0; j < 4; ++j) tw[4 * sel + j] = cwp4[sel * 1024 + j * 3072]; }
      for (int w = vb; w < NITEM; w += nvb) delta_pre_item(q, l, w, hs, tw);
    })
    PH({
      if (vb < 64) delta_seq_item(q, l, vb, hs);
      else {
        const int nb = nvb - 64;
        const int b = vb - 64;
        if (b < 128) delta_seq_item(q, l, 64 + b, hs);
        {
          const int t5 = otid();
          const int n5 = b & 7;
          const int d5 = 32 * (t5 >> 6) + (t5 & 31);
          const int lh5 = (t5 >> 5) & 1;
          const u16* W5 = (const u16*)(q.ws + W_OFF);
          bf16x8 wrf[8];
          bf16x8 wif[8];
          _Pragma("unroll") for (int ks = 0; ks < 8; ++ks) {
            wrf[ks] = *(const bf16x8*)(W5 + WB_WR + n5 * 16384 + d5 * 128 + (2 * ks + lh5) * 8);
            wif[ks] = *(const bf16x8*)(W5 + WB_WI + n5 * 16384 + d5 * 128 + (2 * ks + lh5) * 8);
          }
          const int gc5 = n5 * 128 + (t5 & 127);
          const int gd5 = n5 * 128 + d5;
          const float* cwp5 = q.in[16] + (size_t)l * 4 * 1024 + gc5;
          const float cw0 = cwp5[0];
          const float cw1 = cwp5[1024];
          const float cw2 = cwp5[2048];
          const float cw3 = cwp5[3072];
          const float cb5 = q.in[17][l * 1024 + gc5];
          const float br5 = q.in[19][l * 1024 + gd5];
          const float bi5 = q.in[21][l * 1024 + gd5];
          const float c85 = -8.f * softplus_(-q.in[22][l * 1024 + gd5]);
          for (int w = (b < 128 ? b + nb : b); w < 128 + NLT * 8; w += nb) lru_a_item(q, l, w - 128, hs, wrf, wif, cw0, cw1, cw2, cw3, cb5, br5, bi5, c85);
        }
        const int ntot = 3392 + (l < 3 ? 3712 : 0);
        for (int t = b; t < ntot; t += nb) {
          if (t < 3392) wconv_tile(q, l, 3712 + t, hs);
          else wconv_tile(q, l + 1, t - 3392, hs);
        }
      }
    })
    PH({
      const int nw = 384 + (l < 3 ? 64 : 0);
      for (int w = vb; w < nw; w += nvb) { if (w < 384) lru_b_item(q, l, w, hs); else wconv_tile(q, l + 1, 7104 + (w - 384), hs); }
    })
    PH({
      u16* Pw = (u16*)(q.ws + P_OFF);
      const float* rsv = (const float*)(q.ws + RSV_OFF);
      { EpiTMP e; e.T = Pw + PC_MRG; wide_gemm(P + PC_OA, W + WB_BA, 1024, DM, e, smem, bid, PLD, 16384); }
      { EpiGATE e; e.T = Pw + PC_MRG; e.M = Pw + PC_MRG; e.rsv = rsv; e.accum = 0; wide_gemm(xb, W + WB_WG, 1024, DM, e, smem, bid, 0, 16384); }
      { EpiTMP e; e.T = Pw + PC_Z; wide_gemm(P + PC_Y, W + WB_BB, 1024, DM, e, smem, bid, PLD, 16384); }
      { EpiGATE e; e.T = Pw + PC_Z; e.M = Pw + PC_MRG; e.rsv = rsv; e.accum = 1; wide_gemm(xb, W + WB_WG + (size_t)1024 * DM, 1024, DM, e, smem, bid, 0, 16384); }
      u16* mpart = (u16*)(q.out + O_YP + 12582912);
      tail_slices(P + PC_OA, PLD, PC_Y - PC_OA, W + WB_BA, (int)(WB_BB - WB_BA), mpart, smem, bid);
      tail_slices(xb, DM, 0, W + WB_WG, 1024 * DM, mpart + (size_t)4 * 768 * 1024, smem, bid);
    })
    PH({ merge_tail_fix(q, (const u16*)(q.out + O_YP + 12582912)); GRID_SYNC(); EpiDOWN e; e.x = (float*)(q.ws + X_OFF); e.xb = (u16*)(q.ws + XB_OFF); e.ssq = (float*)(q.ws + SSQ_OFF); e.f = 1.f; resid_gemm(P + PC_MRG, PLD, W + WB_WO, DM, e, q.out + O_YP + 9437184, smem, bid); })
    PH({ rs_pass(q, smem, 4, 1.f, q.out + O_YP + 9437184); GRID_SYNC(); EpiGU e; e.H = (u16*)(q.ws + P_OFF); e.rsv = (const float*)(q.ws + RSV_OFF); wide_gemm(xb, W + WB_GU2, 5632, DM, e, smem, bid); })
    PH({ EpiDOWN e; e.x = (float*)(q.ws + X_OFF); e.xb = (u16*)(q.ws + XB_OFF); e.ssq = (float*)(q.ws + SSQ_OFF); e.f = 0.5f; resid_gemm(P, DFF, W + WB_DN2, DFF, e, (float*)(q.ws + PART_OFF), smem, bid); })
  }
  PH({ final_phase(q, vb, nvb); })
}

extern "C" void kernel_launch(void* const* d_in, const int* in_sizes, int n_in, void* d_out, int out_size, void* d_ws, size_t ws_size,
                              hipStream_t stream) {
  if (ws_size < WS_NEED || n_in < 30) { fprintf(stderr, "workspace too small: %zu < %zu\n", ws_size, (size_t)WS_NEED); return; }
  static int grid_blocks = 0;
  if (!grid_blocks) {
    hipFuncSetAttribute((const void*)mega, hipFuncAttributeMaxDynamicSharedMemorySize, LDS_BYTES);
    int dev = 0, cus = 0, per_cu = 0;
    hipGetDevice(&dev);
    hipDeviceGetAttribute(&cus, hipDeviceAttributeMultiprocessorCount, dev);
    hipOccupancyMaxActiveBlocksPerMultiprocessor(&per_cu, mega, 512, LDS_BYTES);
    per_cu = 1;
    grid_blocks = cus * per_cu;
  }
  Params p{};
  for (int i = 0; i < 30; ++i) p.in[i] = (const float*)d_in[i];
  p.out = (float*)d_out;
  p.ws = (char*)d_ws;
  hipMemsetAsync((char*)d_ws + BAR_OFF, 0, XCD_BAR_WORDS * 4, stream);
#ifdef MK_MULTI
  for (int ph = 0; ph < 43; ++ph) {
    int lo = ph, hi = ph + 1;
    hipLaunchKernelGGL(mega, dim3(grid_blocks), dim3(512), LDS_BYTES, stream, p, lo, hi);
  }
#else
  int lo = 0, hi = 43;
  void* args[] = {&p, &lo, &hi};
  hipError_t e = hipLaunchCooperativeKernel((void*)mega, dim3(grid_blocks), dim3(512), args, LDS_BYTES, stream);
  if (e != hipSuccess) fprintf(stderr, "cooperative launch failed: %s (grid %d)\n", hipGetErrorString(e), grid_blocks);
#endif
}
```

```cpp
#include <hip/hip_runtime.h>
#include <hip/hip_cooperative_groups.h>
#include <cstdio>
namespace cg = cooperative_groups;

typedef unsigned short u16;
typedef short bf16x8 __attribute__((ext_vector_type(8)));
typedef float f32x16 __attribute__((ext_vector_type(16)));
typedef unsigned u32x4 __attribute__((ext_vector_type(4)));
typedef __bf16 bf2_t __attribute__((ext_vector_type(2)));
typedef float f2_t __attribute__((ext_vector_type(2)));
#define DI __device__ __forceinline__
#define MFMA(a, b, c) __builtin_amdgcn_mfma_f32_32x32x16_bf16((a), (b), (c), 0, 0, 0)

constexpr int T_TOK = 17024;
constexpr int DM = 1024, DFF = 2816, PLD = 6400;
constexpr int T_PAD = 17152;
constexpr int NMT = 67;
constexpr int PC_Z = 3072, PC_LX = 4096, PC_LY = 5120, PC_BETA = 6144, PC_ALPHA = 6152;
constexpr int PC_OA = 0, PC_Y = 1024, PC_MRG = 2048;
constexpr int NLT = 536;
constexpr float EPS = 1e-6f;
constexpr int HALF_LDS = 73728;
constexpr int LDS_BYTES = 147472;
constexpr int NITEM = 2240;

constexpr size_t WB_GU1 = 0, WB_DN1 = 5767168, WB_WIN = 8650752, WB_WG = 15204352, WB_BA = 17301504, WB_BB = 18350080,
                 WB_WO = 19398656, WB_GU2 = 20447232, WB_DN2 = 26214400, WB_WR = 29097984, WB_WI = 29229056;
constexpr size_t X_OFF = 0, XB_OFF = 69730304, SSQ_OFF = 104857600, W_OFF = 105947136, P_OFF = 164667392,
                 QD_OFF = 384212992, WW_OFF = 420913152, KD_OFF = 457613312, UT_OFF = 494313472, A_OFF = 531013632,
                 GL_OFF = 549363712, BAR_OFF = 549380096, AG_OFF = 549396480, RSV_OFF = 553787392, WS_NEED = 553787392 + 131072;
constexpr size_t O_YP = 0, O_YS = 16777216, O_PS = 17301504, O_PCQ = 21495808, O_PH = 21790720, O_PCX = 21823488,
                 O_SS = 21921792, O_SCQ = 30310400, O_SH = 30900224, O_SCX = 30965760;

struct Params {
  const float* in[30];
  float* out;
  char* ws;
};

DI unsigned pk2(float a, float b) { f2_t v = {a, b}; bf2_t r = __builtin_convertvector(v, bf2_t); return __builtin_bit_cast(unsigned, r); }
DI u16 f2bf(float x) { __bf16 b = (__bf16)x; return __builtin_bit_cast(u16, b); }
DI float bf2f(u16 v) { return __uint_as_float(((unsigned)v) << 16); }
DI float4 ld_bf4(const u16* p) {
  uint2 v = *(const uint2*)p;
  return make_float4(__uint_as_float(v.x << 16), __uint_as_float(v.x & 0xffff0000u), __uint_as_float(v.y << 16), __uint_as_float(v.y & 0xffff0000u));
}
DI void st_bf4(u16* p, float a, float b, float c, float d) { uint2 v; v.x = pk2(a, b); v.y = pk2(c, d); *(uint2*)p = v; }
DI float sigmoid_(float x) { return __builtin_amdgcn_rcpf(1.f + __expf(-x)); }
DI float silu_(float x) { return x * __builtin_amdgcn_rcpf(1.f + __expf(-x)); }
DI float softplus_(float x) { return fmaxf(x, 0.f) + log1pf(__expf(-fabsf(x))); }
DI float gelu_tanh_(float x) { float u = 0.7978845608028654f * (x + 0.044715f * x * x * x); return x * __builtin_amdgcn_rcpf(1.f + __expf(-2.f * u)); }
DI int otid() { int t = threadIdx.x & 255; asm volatile("" : "+v"(t)); return t; }
DI int otid512() { int t = threadIdx.x; asm volatile("" : "+v"(t)); return t; }
DI int crow(int reg, int h) { return (reg & 3) + 8 * (reg >> 2) + 4 * h; }
DI bf16x8 ldsfrag(const char* base, int off) { return *(const bf16x8*)(base + off); }
DI int sw128(int row, int ch) { return row * 128 + ((ch ^ ((row >> 1) & 7)) << 4); }
DI int sw256(int row, int ch) { return row * 256 + ((ch ^ (row & 15)) << 4); }
template <int S> DI bf16x8 pack8(const f32x16& x) {
  u32x4 u;
  u[0] = pk2(x[8 * S + 0], x[8 * S + 1]); u[1] = pk2(x[8 * S + 2], x[8 * S + 3]);
  u[2] = pk2(x[8 * S + 4], x[8 * S + 5]); u[3] = pk2(x[8 * S + 6], x[8 * S + 7]);
  return __builtin_bit_cast(bf16x8, u);
}
DI void zero16(f32x16& a) {
#pragma unroll
  for (int i = 0; i < 16; ++i) a[i] = 0.f;
}
DI float row_rs(const float* ssq, int row) {
  const float4* q = (const float4*)(ssq + (size_t)row * 16);
  float4 a = q[0], b = q[1], c = q[2], d = q[3];
  float s = (a.x + a.y + a.z + a.w) + (b.x + b.y + b.z + b.w) + (c.x + c.y + c.z + c.w) + (d.x + d.y + d.z + d.w);
  return __builtin_amdgcn_rsqf(s * (1.f / 1024.f) + EPS);
}
DI float row_rs_lean(const float* ssq, int row) {
  const float4* q = (const float4*)(ssq + (size_t)row * 16);
  float s = 0.f;
#pragma unroll
  for (int i = 0; i < 4; ++i) { const float4 a = q[i]; s += (a.x + a.y) + (a.z + a.w); asm volatile("" : "+v"(s)); }
  return __builtin_amdgcn_rsqf(s * (1.f / 1024.f) + EPS);
}

typedef __attribute__((address_space(3))) unsigned lds_u32;
enum { EPI_GU = 0, EPI_DOWN = 1, EPI_WIN = 2 };
DI void stage_tile_h(const u16* __restrict__ g, int ld, char* lds, int tid) {
#pragma unroll
  for (int i = 0; i < 4; ++i) {
    const int pos = tid + 256 * i, row = pos >> 3, ch = (pos & 7) ^ ((row >> 1) & 7);
    __builtin_amdgcn_global_load_lds((const unsigned*)(g + (size_t)row * ld + ch * 8), (lds_u32*)(lds + pos * 16), 16, 0, 0);
  }
}
struct NoHookH { DI void operator()() const {} };
template <class Hook = NoHookH>
DI void gemm_core_h(const u16* __restrict__ A, int lda, const u16* __restrict__ Bt, int ldb, int K, char* smem, f32x16 (&acc)[2][2], Hook hook = Hook()) {
  const int tid = otid(), lane = tid & 63, wid = tid >> 6, wm = wid >> 1, wn = wid & 1;
  const int lr = lane & 31, lh = lane >> 5;
#pragma unroll
  for (int i = 0; i < 2; ++i)
#pragma unroll
    for (int j = 0; j < 2; ++j) zero16(acc[i][j]);
  __syncthreads();
  stage_tile_h(A, lda, smem, tid);
  stage_tile_h(Bt, ldb, smem + 16384, tid);
  const int nk = K >> 6;
  for (int kt = 0; kt < nk; ++kt) {
    const char* sa = smem + (kt & 1) * 32768;
    const char* sb = sa + 16384;
    asm volatile("s_waitcnt vmcnt(0)" ::: "memory");
    __syncthreads();
    if (kt + 1 < nk) {
      char* da = smem + ((kt + 1) & 1) * 32768;
      stage_tile_h(A + (kt + 1) * 64, lda, da, tid);
      stage_tile_h(Bt + (kt + 1) * 64, ldb, da + 16384, tid);
    }
    if (kt == nk - 2) hook();
#pragma unroll
    for (int ks = 0; ks < 4; ++ks) {
      bf16x8 a0 = ldsfrag(sa, sw128(64 * wm + lr, 2 * ks + lh));
      bf16x8 a1 = ldsfrag(sa, sw128(64 * wm + 32 + lr, 2 * ks + lh));
      bf16x8 b0 = ldsfrag(sb, sw128(64 * wn + lr, 2 * ks + lh));
      bf16x8 b1 = ldsfrag(sb, sw128(64 * wn + 32 + lr, 2 * ks + lh));
      acc[0][0] = MFMA(b0, a0, acc[0][0]);
      acc[0][1] = MFMA(b1, a0, acc[0][1]);
      acc[1][0] = MFMA(b0, a1, acc[1][0]);
      acc[1][1] = MFMA(b1, a1, acc[1][1]);
    }
  }
}

DI bool tile_of_h(int it, int NT, int& mt, int& nt, int b) {
  const int G = gridDim.x;
  const int rb = ((G & 7) == 0) ? ((b & 7) * (G >> 3) + (b >> 3)) : b;
  const int hid = __builtin_amdgcn_readfirstlane((int)(threadIdx.x >> 8));
  const int L = it * 2 * G + 2 * rb + hid;
  if (L >= 133 * NT) return false;
  const int nig = 8 * NT, gid = L / nig, fm = gid * 8, gsz = (133 - fm) < 8 ? (133 - fm) : 8, w = L - gid * nig;
  mt = fm + (w % gsz); nt = w / gsz;
  return true;
}
DI int num_rounds_h(int NT) { return (133 * NT + 2 * gridDim.x - 1) / (2 * gridDim.x); }


template <int EPI>
DI void gemm_phase_h(const Params& p, const u16* A, int lda, const u16* Bt, int ldb, int K, int NT, float f, char* smem, int bid) {
  float* x = (float*)(p.ws + X_OFF);
  u16* xb = (u16*)(p.ws + XB_OFF);
  float* ssq = (float*)(p.ws + SSQ_OFF);
  u16* P = (u16*)(p.ws + P_OFF);
  const int tid_ = otid(), lane = tid_ & 63, wid = tid_ >> 6, wm = wid >> 1, wn = wid & 1, lr = lane & 31, lh = lane >> 5;
  const int nr = num_rounds_h(NT);
  for (int it = 0; it < nr; ++it) {
    int mt, nt;
    if (!tile_of_h(it, NT, mt, nt, bid)) break;
    f32x16 acc[2][2];
    float rsv[2] = {0.f, 0.f};
    float4 xo[2][2][4];
    if (EPI != EPI_DOWN) {
#pragma unroll
      for (int mi = 0; mi < 2; ++mi) rsv[mi] = row_rs(ssq, mt * 128 + 64 * wm + 32 * mi + lr);
      gemm_core_h(A + (size_t)(mt * 128) * lda, lda, Bt + (size_t)(nt * 128) * ldb, ldb, K, smem, acc);
    } else {
      const float* xbase = x + (size_t)(mt * 128 + 64 * wm + lr) * DM + nt * 128 + 64 * wn + 4 * lh;
      gemm_core_h(A + (size_t)(mt * 128) * lda, lda, Bt + (size_t)(nt * 128) * ldb, ldb, K, smem, acc, [&]() {
#pragma unroll
        for (int mi = 0; mi < 2; ++mi)
#pragma unroll
          for (int ni = 0; ni < 2; ++ni)
#pragma unroll
            for (int b = 0; b < 4; ++b) xo[mi][ni][b] = *(const float4*)(xbase + (size_t)(32 * mi) * DM + 32 * ni + 8 * b);
      });
    }
#pragma unroll
    for (int mi = 0; mi < 2; ++mi) {
      const int row = mt * 128 + 64 * wm + 32 * mi + lr;
      if (EPI == EPI_GU) {
        const float rs = rsv[mi];
        u16* hrow = P + (size_t)row * DFF + 32 * (2 * nt + wn) + 4 * lh;
#pragma unroll
        for (int b = 0; b < 4; ++b) {
          float hv[4];
#pragma unroll
          for (int r = 0; r < 4; ++r) { float g = acc[mi][0][4 * b + r] * rs, u = acc[mi][1][4 * b + r] * rs; hv[r] = silu_(g) * u; }
          st_bf4(hrow + 8 * b, hv[0], hv[1], hv[2], hv[3]);
        }
      } else if (EPI == EPI_WIN) {
        const float rs = rsv[mi];
#pragma unroll
        for (int ni = 0; ni < 2; ++ni)
#pragma unroll
          for (int b = 0; b < 4; ++b) {
            const int col = nt * 128 + 64 * wn + 32 * ni + 8 * b + 4 * lh;
            st_bf4(P + (size_t)row * PLD + col, acc[mi][ni][4 * b] * rs, acc[mi][ni][4 * b + 1] * rs, acc[mi][ni][4 * b + 2] * rs, acc[mi][ni][4 * b + 3] * rs);
          }
      } else {
        float ss = 0.f;
#pragma unroll
        for (int ni = 0; ni < 2; ++ni)
#pragma unroll
          for (int b = 0; b < 4; ++b) {
            const int col = nt * 128 + 64 * wn + 32 * ni + 8 * b + 4 * lh;
            float4 v = xo[mi][ni][b];
            v.x += f * acc[mi][ni][4 * b]; v.y += f * acc[mi][ni][4 * b + 1]; v.z += f * acc[mi][ni][4 * b + 2]; v.w += f * acc[mi][ni][4 * b + 3];
            *(float4*)(x + (size_t)row * DM + col) = v;
            st_bf4(xb + (size_t)row * DM + col, v.x, v.y, v.z, v.w);
            ss += v.x * v.x + v.y * v.y + v.z * v.z + v.w * v.w;
          }
        ss += __shfl_xor(ss, 32);
        if (lh == 0) ssq[(size_t)row * 16 + 2 * nt + wn] = ss;
      }
    }
  }
}

DI void merge_phase_h(const Params& p, char* smem, int bid) {
  const u16* xb = (const u16*)(p.ws + XB_OFF);
  const float* ssq = (const float*)(p.ws + SSQ_OFF);
  u16* P = (u16*)(p.ws + P_OFF);
  const u16* W = (const u16*)(p.ws + W_OFF);
  const int tid_ = otid(), lane = tid_ & 63, wid = tid_ >> 6, wm = wid >> 1, wn = wid & 1, lr = lane & 31, lh = lane >> 5;
  const int nr = num_rounds_h(8);
  for (int it = 0; it < nr; ++it) {
    int mt, nt;
    if (!tile_of_h(it, 8, mt, nt, bid)) break;
    for (int pass = 0; pass < 2; ++pass) {
      f32x16 acc[2][2];
      unsigned Gp[2][2][8];
      float rsv[2];
#pragma unroll
      for (int mi = 0; mi < 2; ++mi) rsv[mi] = row_rs(ssq, mt * 128 + 64 * wm + 32 * mi + lr);
      gemm_core_h(xb + (size_t)(mt * 128) * DM, DM, W + WB_WG + (size_t)(pass * 1024 + nt * 128) * DM, DM, DM, smem, acc);
#pragma unroll
      for (int mi = 0; mi < 2; ++mi) {
        const float rs = rsv[mi];
#pragma unroll
        for (int ni = 0; ni < 2; ++ni)
#pragma unroll
          for (int r = 0; r < 8; ++r) Gp[mi][ni][r] = pk2(sigmoid_(acc[mi][ni][2 * r] * rs), sigmoid_(acc[mi][ni][2 * r + 1] * rs));
      }
      gemm_core_h(P + (size_t)(mt * 128) * PLD + (pass ? PC_Y : PC_OA), PLD, W + (pass ? WB_BB : WB_BA) + (size_t)(nt * 128) * DM, DM, DM, smem, acc);
#pragma unroll
      for (int mi = 0; mi < 2; ++mi) {
        const int row = mt * 128 + 64 * wm + 32 * mi + lr;
        float4 prev[2][4];
#pragma unroll
        for (int ni = 0; ni < 2; ++ni)
#pragma unroll
          for (int b = 0; b < 4; ++b) {
            prev[ni][b] = make_float4(0.f, 0.f, 0.f, 0.f);
            if (pass) prev[ni][b] = ld_bf4(P + (size_t)row * PLD + PC_MRG + nt * 128 + 64 * wn + 32 * ni + 8 * b + 4 * lh);
          }
#pragma unroll
        for (int ni = 0; ni < 2; ++ni)
#pragma unroll
          for (int b = 0; b < 4; ++b) {
            u16* op = P + (size_t)row * PLD + PC_MRG + nt * 128 + 64 * wn + 32 * ni + 8 * b + 4 * lh;
            const unsigned g0 = Gp[mi][ni][2 * b], g1 = Gp[mi][ni][2 * b + 1];
            st_bf4(op, prev[ni][b].x + __uint_as_float(g0 << 16) * acc[mi][ni][4 * b], prev[ni][b].y + __uint_as_float(g0 & 0xffff0000u) * acc[mi][ni][4 * b + 1],
                   prev[ni][b].z + __uint_as_float(g1 << 16) * acc[mi][ni][4 * b + 2], prev[ni][b].w + __uint_as_float(g1 & 0xffff0000u) * acc[mi][ni][4 * b + 3]);
          }
      }
    }
  }
}

namespace pg8 {
#define PG8_LAS __attribute__((address_space(3)))
typedef unsigned short bf16_t;
typedef short bf16x8 __attribute__((ext_vector_type(8)));
typedef float f32x4 __attribute__((ext_vector_type(4)));
typedef unsigned u32x4 __attribute__((ext_vector_type(4)));
constexpr int BM = 256, BK = 64, HALF = 128, HTB = HALF * BK * 2  , STAGE_BYTES = 8 * HTB, NXCD = 8, WGM = 8;

__host__ __device__ __forceinline__ int lds_byte(int r, int c) { const int st = (r >> 4) * 2 + (c >> 5), rr = r & 15, cc = c & 31, ob = rr * 64 + cc * 2; return st * 1024 + (ob ^ (((ob >> 9) & 1) << 5)); }
__host__ __device__ __forceinline__ void stage_rc(int b, int& R, int& C) { const int st = b / 1024, sb = b % 1024, swz = sb ^ (((sb >> 9) & 1) << 5); R = (st >> 1) * 16 + swz / 64; C = (st & 1) * 32 + (swz % 64) / 2; }
__host__ __device__ __forceinline__ int perm32(int rho) { const int n = rho >> 4, i = rho & 15; return 8 * (i >> 2) + 4 * n + (i & 3); }

struct Unit { int pm, pn, ko, ao, bo; };
struct Gemm { const bf16_t* A; const bf16_t* Bt; int M, N, K, lda, ldb; };

struct StaticOrder {
    int nM, nN, nwg, G, c;
    __host__ __device__ void init(int M, int N, int G_, int c_) { nM = M / BM; nN = N / BM; nwg = nM * nN; G = G_; c = c_; }
    __host__ __device__ bool next(int i, Unit& u) const {
        const long L = (long)i * G + c; if (L >= nwg) return false;
        int wgid = (int)L; { const int q = nwg / NXCD, r = nwg % NXCD, xcd = wgid % NXCD, off = wgid / NXCD; wgid = (xcd < r ? xcd * (q + 1) : r * (q + 1) + (xcd - r) * q) + off; }
        const int nig = WGM * nN, gid = wgid / nig, fm = gid * WGM, gsz = (nM - fm) < WGM ? (nM - fm) : WGM;
        u.pm = fm + ((wgid % nig) % gsz); u.pn = (wgid % nig) / gsz; u.ko = 0; u.ao = 0; u.bo = 0; return true;
    }
    __device__ __forceinline__ void a_ready(const Unit&) const {}
    __device__ __forceinline__ void done(const Unit&) const {}
};

template <class Epi, class Sched, bool STAMP = false>
__device__ __forceinline__ void gemm_phase(PG8_LAS unsigned char* lds, const Gemm g, const Sched& S, const Epi& E, unsigned long long* stamps) {
    const int tid = otid512(), wid = __builtin_amdgcn_readfirstlane(tid >> 6), lane = tid & 63, wr = wid >> 2, wc = wid & 3, fr = lane & 15, fq = lane >> 4;
    const int K = g.K, nt = K / BK;
    int ts_lo = 0, ts_hi = 0, nts = 0; const unsigned long long rt_entry = STAMP ? (unsigned long long)wall_clock64() : 0ull;
#define PG8_STAMP() do { if (STAMP && wid == 0 && nts < 64) { const unsigned long long _c = (unsigned long long)clock64(); \
        ts_lo = (lane == nts) ? (int)(unsigned)_c : ts_lo; ts_hi = (lane == nts) ? (int)(unsigned)(_c >> 32) : ts_hi; ++nts; } } while (0)
    PG8_STAMP();
    unsigned voffA[2], voffB[2];
#pragma unroll
    for (int i = 0; i < 2; ++i) { int R, C; stage_rc(tid * 16 + i * 8192, R, C); const int Rb = Epi::PERM ? ((R & ~31) + perm32(R & 31)) : R;
        voffA[i] = (unsigned)(R * g.lda + C) * 2u; voffB[i] = (unsigned)(Rb * g.ldb + C) * 2u; }
    const size_t kstep = (size_t)(BK * 2);
    const size_t hstep = (size_t)HALF * g.ldb * 2;
    const size_t tstep = 2 * hstep;
    const size_t hstepA = (size_t)HALF * g.lda * 2, tstepA = 2 * hstepA;
    const unsigned ldsw = (unsigned)wid * 1024u;
    const int aoff = lds_byte(wr * 64 + fr, fq * 8), boff = lds_byte(wc * 32 + fr, fq * 8);
#define PG8_SA(b, h) (((b) * 2 + (h)) * HTB)
#define PG8_SB(b, h) ((4 + (b) * 2 + (h)) * HTB)
#define PG8_STAGE(bufoff, gbase, voff) do { _Pragma("unroll") for (int _i = 0; _i < 2; ++_i) \
        __builtin_amdgcn_global_load_lds((const unsigned*)((const char*)(gbase) + (voff)[_i]), (PG8_LAS unsigned*)(lds + (bufoff) + ldsw + _i * 8192), 16, 0, 0); } while (0)
#define PG8_LDA(dst, b, h) do { _Pragma("unroll") for (int m = 0; m < 4; ++m) _Pragma("unroll") for (int k = 0; k < 2; ++k) dst[m][k] = *(const PG8_LAS bf16x8*)(lds + PG8_SA(b, h) + aoff + m * 2048 + k * 1024); } while (0)
#define PG8_LDB(dst, b, h) do { _Pragma("unroll") for (int n = 0; n < 2; ++n) _Pragma("unroll") for (int k = 0; k < 2; ++k) dst[n][k] = *(const PG8_LAS bf16x8*)(lds + PG8_SB(b, h) + boff + n * 2048 + k * 1024); } while (0)
#define PG8_MMA(ai, bj, At, Bt) do { __builtin_amdgcn_s_setprio(1); _Pragma("unroll") for (int m = 0; m < 4; ++m) _Pragma("unroll") for (int n = 0; n < 2; ++n) _Pragma("unroll") for (int k = 0; k < 2; ++k) \
        acc[ai][bj][m][n] = __builtin_amdgcn_mfma_f32_16x16x32_bf16(Bt[n][k], At[m][k], acc[ai][bj][m][n], 0, 0, 0); __builtin_amdgcn_s_setprio(0); } while (0)
#define PG8_WAIT_V(n) asm volatile("s_waitcnt vmcnt(" #n ")" ::: "memory")
#define PG8_WAIT_L(n) asm volatile("s_waitcnt lgkmcnt(" #n ")" ::: "memory")
#define PG8_BAR __builtin_amdgcn_s_barrier()
#define PG8_SCHED __builtin_amdgcn_sched_barrier(0)
    Unit cur, nxt; int ui = 0;
    if (!S.next(0, cur)) return;
    f32x4 acc[2][2][4][2];
#pragma unroll
    for (int a = 0; a < 2; ++a)
#pragma unroll
        for (int b = 0; b < 2; ++b)
#pragma unroll
            for (int m = 0; m < 4; ++m)
#pragma unroll
                for (int n = 0; n < 2; ++n) acc[a][b][m][n] = (f32x4){0.f, 0.f, 0.f, 0.f};
    bf16x8 At[4][2], B0[2][2], B1[2][2];
    const char* cA = (const char*)g.A + (size_t)cur.pm * tstepA + (size_t)cur.ao * 2; const char* cB = (const char*)g.Bt + (size_t)cur.pn * tstep + (size_t)cur.bo * 2;
    S.a_ready(cur);
    PG8_STAGE(PG8_SB(0, 0), cB, voffB); PG8_STAGE(PG8_SA(0, 0), cA, voffA); PG8_STAGE(PG8_SB(0, 1), cB + hstep, voffB); PG8_STAGE(PG8_SA(0, 1), cA + hstepA, voffA);
    if (wr == 1) PG8_BAR;
    PG8_WAIT_V(4); PG8_BAR;
    PG8_STAGE(PG8_SB(1, 0), cB + kstep, voffB); PG8_STAGE(PG8_SA(1, 0), cA + kstep, voffA); PG8_STAGE(PG8_SB(1, 1), cB + hstep + kstep, voffB);
    PG8_WAIT_V(6); PG8_BAR;
    PG8_STAMP();
    for (;;) {
        const bool has_next = S.next(ui + 1, nxt);
        const char* nA = has_next ? (const char*)g.A + (size_t)nxt.pm * tstepA + (size_t)nxt.ao * 2 : cA; const char* nB = has_next ? (const char*)g.Bt + (size_t)nxt.pn * tstep + (size_t)nxt.bo * 2 : cB;
        for (int t = 0; t < nt; t += 2) {
            const bool last = (t == nt - 2);
            const char* a1 = cA + (size_t)(t + 1) * kstep;
            const char* a2 = last ? nA : cA + (size_t)(t + 2) * kstep; const char* b2 = last ? nB : cB + (size_t)(t + 2) * kstep;
            const char* a3 = a2 + kstep; const char* b3 = b2 + kstep;
            if (last && has_next) S.a_ready(nxt);
            PG8_LDB(B0, 0, 0); PG8_SCHED; PG8_LDA(At, 0, 0); PG8_STAGE(PG8_SA(1, 1), a1 + hstepA, voffA);
            PG8_WAIT_L(8); PG8_BAR; PG8_WAIT_L(0); PG8_MMA(0, 0, At, B0); PG8_BAR; PG8_SCHED;
            PG8_LDB(B1, 0, 1); PG8_STAGE(PG8_SB(0, 0), b2, voffB);
            PG8_BAR; PG8_WAIT_L(0); PG8_MMA(0, 1, At, B1); PG8_BAR;
            PG8_LDA(At, 0, 1); PG8_STAGE(PG8_SA(0, 0), a2, voffA);
            PG8_BAR; PG8_WAIT_L(0); PG8_MMA(1, 0, At, B0); PG8_BAR; PG8_SCHED;
            PG8_STAGE(PG8_SB(0, 1), b2 + hstep, voffB);
            PG8_WAIT_V(6); PG8_BAR; PG8_MMA(1, 1, At, B1); PG8_BAR;
            PG8_LDB(B0, 1, 0); PG8_SCHED; PG8_LDA(At, 1, 0); PG8_STAGE(PG8_SA(0, 1), a2 + hstepA, voffA);
            PG8_WAIT_L(8); PG8_BAR; PG8_WAIT_L(0); PG8_MMA(0, 0, At, B0); PG8_BAR; PG8_SCHED;
            PG8_LDB(B1, 1, 1); PG8_STAGE(PG8_SB(1, 0), b3, voffB);
            PG8_BAR; PG8_WAIT_L(0); PG8_MMA(0, 1, At, B1); PG8_BAR;
            PG8_LDA(At, 1, 1); PG8_STAGE(PG8_SA(1, 0), a3, voffA);
            PG8_BAR; PG8_WAIT_L(0); PG8_MMA(1, 0, At, B0); PG8_BAR; PG8_SCHED;
            PG8_STAGE(PG8_SB(1, 1), b3 + hstep, voffB);
            PG8_WAIT_V(6); PG8_BAR; PG8_MMA(1, 1, At, B1); PG8_BAR;
        }
        PG8_STAMP();
        if constexpr (!Epi::AFTER_DRAIN) { E(acc, cur, wr, wc, fr, fq); S.done(cur); }
        PG8_STAMP();
        if (!has_next) break;
#pragma unroll
        for (int a = 0; a < 2; ++a)
#pragma unroll
            for (int b = 0; b < 2; ++b)
#pragma unroll
                for (int m = 0; m < 4; ++m)
#pragma unroll
                    for (int n = 0; n < 2; ++n) acc[a][b][m][n] = (f32x4){0.f, 0.f, 0.f, 0.f};
        cur = nxt; cA = nA; cB = nB; ++ui;
    }
    PG8_WAIT_V(0);
    if (wr == 0) PG8_BAR;
    PG8_BAR;
    if constexpr (Epi::AFTER_DRAIN) { E.fused(acc, cur, wr, wc, fr, fq, lds, wid, lane); S.done(cur); }
    PG8_STAMP();
    if (STAMP && wid == 0) { stamps[lane] = lane < nts ? (((unsigned long long)(unsigned)ts_hi << 32) | (unsigned)ts_lo) : 0ull;
        if (lane == 62) stamps[62] = rt_entry; if (lane == 63) stamps[63] = (unsigned long long)wall_clock64(); }
#undef PG8_STAMP
#undef PG8_SA
#undef PG8_SB
#undef PG8_STAGE
#undef PG8_LDA
#undef PG8_LDB
#undef PG8_MMA
#undef PG8_WAIT_V
#undef PG8_WAIT_L
#undef PG8_BAR
#undef PG8_SCHED
}
}

struct EpiGU {
  static constexpr bool PERM = false, AFTER_DRAIN = false;
  u16* H; const float* rsv;
  DI void operator()(const pg8::f32x4 (&acc)[2][2][4][2], const pg8::Unit& u, int wr, int wc, int fr, int fq) const {
#pragma unroll
    for (int ai = 0; ai < 2; ++ai)
#pragma unroll
      for (int m = 0; m < 4; ++m) {
        const int row = u.pm * 256 + ai * 128 + wr * 64 + m * 16 + fr;
        const bool valid = row < T_TOK;
        const float rs = rsv[valid ? row : 0];
#pragma unroll
        for (int bj = 0; bj < 2; ++bj) {
          const pg8::f32x4 g = acc[ai][bj][m][0] * rs, up = acc[ai][bj][m][1] * rs;
          const int j = 16 * (8 * u.pn + 4 * bj + wc) + 4 * fq;
          if (valid) st_bf4(H + (size_t)row * DFF + j, silu_(g[0]) * up[0], silu_(g[1]) * up[1], silu_(g[2]) * up[2], silu_(g[3]) * up[3]);
        }
      }
  }
};
struct EpiWIN {
  static constexpr bool PERM = true, AFTER_DRAIN = false;
  u16* P; const float* rsv;
  DI void operator()(const pg8::f32x4 (&acc)[2][2][4][2], const pg8::Unit& u, int wr, int wc, int fr, int fq) const {
#pragma unroll
    for (int ai = 0; ai < 2; ++ai)
#pragma unroll
      for (int m = 0; m < 4; ++m) {
        const int row = u.pm * 256 + ai * 128 + wr * 64 + m * 16 + fr;
        const bool valid = row < T_TOK;
        const float rs = rsv[valid ? row : 0];
#pragma unroll
        for (int bj = 0; bj < 2; ++bj) {
          const pg8::f32x4 a = acc[ai][bj][m][0] * rs, b = acc[ai][bj][m][1] * rs;
          u32x4 v; v[0] = pk2(a[0], a[1]); v[1] = pk2(a[2], a[3]); v[2] = pk2(b[0], b[1]); v[3] = pk2(b[2], b[3]);
          if (valid) *(u32x4*)(P + (size_t)row * PLD + u.pn * 256 + bj * 128 + wc * 32 + 8 * fq) = v;
        }
      }
  }
};
struct EpiTMP {
  static constexpr bool PERM = true, AFTER_DRAIN = false;
  u16* T;
  DI void operator()(const pg8::f32x4 (&acc)[2][2][4][2], const pg8::Unit& u, int wr, int wc, int fr, int fq) const {
#pragma unroll
    for (int ai = 0; ai < 2; ++ai)
#pragma unroll
      for (int m = 0; m < 4; ++m) {
        const int row = u.pm * 256 + ai * 128 + wr * 64 + m * 16 + fr;
        if (row < T_TOK) {
#pragma unroll
          for (int bj = 0; bj < 2; ++bj) {
            const pg8::f32x4 a = acc[ai][bj][m][0], b = acc[ai][bj][m][1];
            u32x4 v; v[0] = pk2(a[0], a[1]); v[1] = pk2(a[2], a[3]); v[2] = pk2(b[0], b[1]); v[3] = pk2(b[2], b[3]);
            *(u32x4*)(T + (size_t)row * PLD + u.pn * 256 + bj * 128 + wc * 32 + 8 * fq) = v;
          }
        }
      }
  }
};
struct EpiGATE {
  static constexpr bool PERM = true, AFTER_DRAIN = false;
  const u16* T; u16* M; const float* rsv; int accum;
  DI void operator()(const pg8::f32x4 (&acc)[2][2][4][2], const pg8::Unit& u, int wr, int wc, int fr, int fq) const {
#pragma unroll
    for (int ai = 0; ai < 2; ++ai)
#pragma unroll
      for (int m = 0; m < 4; ++m) {
        const int row = u.pm * 256 + ai * 128 + wr * 64 + m * 16 + fr;
        const bool valid = row < T_TOK;
        const int rowc = valid ? row : 0;
        const float rs = rsv[rowc];
        u32x4 tv[2], pv[2];
#pragma unroll
        for (int bj = 0; bj < 2; ++bj) {
          const size_t off = (size_t)rowc * PLD + u.pn * 256 + bj * 128 + wc * 32 + 8 * fq;
          tv[bj] = *(const u32x4*)(T + off);
          pv[bj][0] = 0u; pv[bj][1] = 0u; pv[bj][2] = 0u; pv[bj][3] = 0u;
          if (accum) pv[bj] = *(const u32x4*)(M + off);
        }
#pragma unroll
        for (int bj = 0; bj < 2; ++bj) {
          const size_t off = (size_t)rowc * PLD + u.pn * 256 + bj * 128 + wc * 32 + 8 * fq;
          u32x4 o;
#pragma unroll
          for (int e = 0; e < 4; ++e) {
            const float g0 = sigmoid_(acc[ai][bj][m][e >> 1][2 * (e & 1)] * rs), g1 = sigmoid_(acc[ai][bj][m][e >> 1][2 * (e & 1) + 1] * rs);
            const float r0 = __uint_as_float(pv[bj][e] << 16) + g0 * __uint_as_float(tv[bj][e] << 16);
            const float r1 = __uint_as_float(pv[bj][e] & 0xffff0000u) + g1 * __uint_as_float(tv[bj][e] & 0xffff0000u);
            o[e] = pk2(r0, r1);
          }
          if (valid) *(u32x4*)(M + off) = o;
        }
      }
  }
};
struct EpiDOWN {
  static constexpr bool PERM = true, AFTER_DRAIN = false;
  float* x; u16* xb; float* ssq; float f;
  DI void operator()(const pg8::f32x4 (&acc)[2][2][4][2], const pg8::Unit& u, int wr, int wc, int fr, int fq) const {
#pragma unroll
    for (int ai = 0; ai < 2; ++ai)
#pragma unroll
      for (int m = 0; m < 4; ++m) {
        const int row = u.pm * 256 + ai * 128 + wr * 64 + m * 16 + fr;
        const bool valid = row < T_TOK;
        const size_t off = (size_t)(valid ? row : 0) * DM + u.pn * 256 + wc * 32 + 8 * fq;
        pg8::f32x4 xo[2][2];
#pragma unroll
        for (int bj = 0; bj < 2; ++bj) { xo[bj][0] = *(const pg8::f32x4*)(x + off + bj * 128); xo[bj][1] = *(const pg8::f32x4*)(x + off + bj * 128 + 4); }
        float ss = 0.f;
#pragma unroll
        for (int bj = 0; bj < 2; ++bj) {
          const pg8::f32x4 a = xo[bj][0] + acc[ai][bj][m][0] * f, b = xo[bj][1] + acc[ai][bj][m][1] * f;
          ss += a[0] * a[0] + a[1] * a[1] + a[2] * a[2] + a[3] * a[3] + b[0] * b[0] + b[1] * b[1] + b[2] * b[2] + b[3] * b[3];
          if (valid) {
            *(pg8::f32x4*)(x + off + bj * 128) = a; *(pg8::f32x4*)(x + off + bj * 128 + 4) = b;
            u32x4 v; v[0] = pk2(a[0], a[1]); v[1] = pk2(a[2], a[3]); v[2] = pk2(b[0], b[1]); v[3] = pk2(b[2], b[3]);
            *(u32x4*)(xb + off + bj * 128) = v;
          }
        }
        ss += __shfl_xor(ss, 16); ss += __shfl_xor(ss, 32);
        if (fq == 0 && valid) ssq[(size_t)row * 16 + 4 * u.pn + wc] = ss;
      }
  }
};
struct SliceOrder {
  int nitem, G, c, nslice, kstep, a2, b2;
  DI bool next(int i, pg8::Unit& u) const {
    const int L = i * G + c; if (L >= nitem) return false;
    const int unit = L / nslice, sl = L - unit * nslice;
    const int g2 = unit / 12, un = unit - g2 * 12;
    u.pm = 64 + (un >> 2); u.pn = un & 3; u.ko = (g2 * nslice + sl) * kstep; u.ao = sl * kstep + g2 * a2; u.bo = sl * kstep + g2 * b2; return true;
  }
  DI void a_ready(const pg8::Unit&) const {}
  DI void done(const pg8::Unit&) const {}
};
constexpr size_t PART_OFF = P_OFF + 104857600;
struct EpiPART {
  static constexpr bool PERM = true, AFTER_DRAIN = false;
  float* part;
  DI void operator()(const pg8::f32x4 (&acc)[2][2][4][2], const pg8::Unit& u, int wr, int wc, int fr, int fq) const {
    float* pb = part + (size_t)(u.ko >> 8) * (768 * 1024);
#pragma unroll
    for (int ai = 0; ai < 2; ++ai)
#pragma unroll
      for (int m = 0; m < 4; ++m) {
        const int rr = (u.pm - 64) * 256 + ai * 128 + wr * 64 + m * 16 + fr;
        float* xp = pb + (size_t)rr * DM + u.pn * 256 + wc * 32 + 8 * fq;
#pragma unroll
        for (int bj = 0; bj < 2; ++bj) { *(pg8::f32x4*)(xp + bj * 128) = acc[ai][bj][m][0]; *(pg8::f32x4*)(xp + bj * 128 + 4) = acc[ai][bj][m][1]; }
      }
  }
};
struct EpiPARTH {
  static constexpr bool PERM = true, AFTER_DRAIN = false;
  u16* part;
  DI void operator()(const pg8::f32x4 (&acc)[2][2][4][2], const pg8::Unit& u, int wr, int wc, int fr, int fq) const {
    u16* pb = part + (size_t)(u.ko >> 9) * (768 * 1024);
#pragma unroll
    for (int ai = 0; ai < 2; ++ai)
#pragma unroll
      for (int m = 0; m < 4; ++m) {
        const int rr = (u.pm - 64) * 256 + ai * 128 + wr * 64 + m * 16 + fr;
        u16* xp = pb + (size_t)rr * DM + u.pn * 256 + wc * 32 + 8 * fq;
#pragma unroll
        for (int bj = 0; bj < 2; ++bj) {
          const pg8::f32x4 a = acc[ai][bj][m][0], b = acc[ai][bj][m][1];
          u32x4 v; v[0] = pk2(a[0], a[1]); v[1] = pk2(a[2], a[3]); v[2] = pk2(b[0], b[1]); v[3] = pk2(b[2], b[3]);
          *(u32x4*)(xp + bj * 128) = v;
        }
      }
  }
};
DI void tail_slices(const u16* A, int lda, int a2, const u16* Bt, int b2, u16* part, char* smem, int bid) {
  int ksl = 512; asm volatile("" : "+s"(ksl));
  pg8::Gemm g; g.A = A; g.Bt = Bt; g.M = T_PAD; g.N = 1024; g.K = ksl; g.lda = lda; g.ldb = DM;
  SliceOrder S; S.nslice = 2; S.kstep = 512; S.a2 = a2; S.b2 = b2; S.nitem = 48; S.G = (int)gridDim.x; S.c = bid;
  EpiPARTH ep; ep.part = part;
  pg8::gemm_phase<EpiPARTH, SliceOrder, false>((PG8_LAS unsigned char*)smem, g, S, ep, nullptr);
  __syncthreads();
}
DI void merge_tail_fix(const Params& p, const u16* part) {
  const int tid = otid512();
  const float* rsv = (const float*)(p.ws + RSV_OFF);
  u16* P = (u16*)(p.ws + P_OFF);
  for (int r = 16384 + (int)blockIdx.x; r < T_TOK; r += (int)gridDim.x) {
    const float rs = rsv[r];
    float v[4][2];
#pragma unroll
    for (int gi = 0; gi < 4; ++gi) {
      const int t0 = (gi & 1) * 4 + (gi >> 1) * 2;
      const unsigned w0 = ((const unsigned*)(part + ((size_t)t0 * 768 + (r - 16384)) * DM))[tid];
      const unsigned w1 = ((const unsigned*)(part + ((size_t)(t0 + 1) * 768 + (r - 16384)) * DM))[tid];
      v[gi][0] = __uint_as_float(w0 << 16) + __uint_as_float(w1 << 16);
      v[gi][1] = __uint_as_float(w0 & 0xffff0000u) + __uint_as_float(w1 & 0xffff0000u);
    }
    const float m0 = sigmoid_(v[1][0] * rs) * v[0][0] + sigmoid_(v[3][0] * rs) * v[2][0];
    const float m1 = sigmoid_(v[1][1] * rs) * v[0][1] + sigmoid_(v[3][1] * rs) * v[2][1];
    ((unsigned*)(P + (size_t)r * PLD + PC_MRG))[tid] = pk2(m0, m1);
  }
}
template <class EpiMain>
DI void resid_gemm(const u16* A, int lda, const u16* Bt, int K, const EpiMain& E, float* part, char* smem, int bid) {
  {
    pg8::Gemm g; g.A = A; g.Bt = Bt; g.M = 16384; g.N = 1024; g.K = K; g.lda = lda; g.ldb = K;
    pg8::StaticOrder S; S.init(16384, 1024, (int)gridDim.x, bid);
    __syncthreads();
    pg8::gemm_phase<EpiMain, pg8::StaticOrder, false>((PG8_LAS unsigned char*)smem, g, S, E, nullptr);
    __syncthreads();
  }
  {
    int ksl = 256; asm volatile("" : "+s"(ksl));
    pg8::Gemm g; g.A = A; g.Bt = Bt; g.M = T_PAD; g.N = 1024; g.K = ksl; g.lda = lda; g.ldb = K;
    SliceOrder S; S.nslice = K >> 8; S.kstep = 256; S.a2 = 0; S.b2 = 0; S.nitem = 12 * S.nslice; S.G = (int)gridDim.x; S.c = bid;
    EpiPART ep; ep.part = part;
    pg8::gemm_phase<EpiPART, SliceOrder, false>((PG8_LAS unsigned char*)smem, g, S, ep, nullptr);
    __syncthreads();
  }
}
DI void rs_pass(const Params& p, char* smem, int nsl, float f, const float* part) {
  const int tid = otid512();
  float* rsv = (float*)(p.ws + RSV_OFF);
  const int row = (int)blockIdx.x * 512 + tid;
  if (row < 16384) rsv[row] = row_rs((const float*)(p.ws + SSQ_OFF), row);
  float* red = (float*)smem;
  for (int r = 16384 + (int)blockIdx.x; r < T_TOK; r += (int)gridDim.x) {
    float2* xr = (float2*)((float*)(p.ws + X_OFF) + (size_t)r * DM);
    float2 v = xr[tid];
    if (nsl) {
      float2 t[11];
#pragma unroll
      for (int sl = 0; sl < 11; ++sl) { t[sl] = make_float2(0.f, 0.f); if (sl < nsl) t[sl] = ((const float2*)(part + ((size_t)sl * 768 + (r - 16384)) * DM))[tid]; }
      float2 a = make_float2(0.f, 0.f);
#pragma unroll
      for (int sl = 0; sl < 11; ++sl) { a.x += t[sl].x; a.y += t[sl].y; }
      v.x += f * a.x; v.y += f * a.y;
      xr[tid] = v;
    }
    ((unsigned*)((u16*)(p.ws + XB_OFF) + (size_t)r * DM))[tid] = pk2(v.x, v.y);
    float ss = v.x * v.x + v.y * v.y;
#pragma unroll
    for (int o = 32; o > 0; o >>= 1) ss += __shfl_xor(ss, o);
    __syncthreads();
    if ((tid & 63) == 0) red[tid >> 6] = ss;
    __syncthreads();
    if (tid == 0) { float t = 0.f; for (int i = 0; i < 8; ++i) t += red[i]; rsv[r] = __builtin_amdgcn_rsqf(t * (1.f / 1024.f) + EPS); }
  }
}
template <class Epi>
DI void wide_gemm(const u16* A, const u16* Bt, int N, int K, const Epi& E, char* smem, int bid, int lda = 0, int M = T_PAD) {
  pg8::Gemm g; g.A = A; g.Bt = Bt; g.M = M; g.N = N; g.K = K; g.lda = lda ? lda : K; g.ldb = K;
  pg8::StaticOrder S; S.init(M, N, (int)gridDim.x, bid);
  __syncthreads();
  pg8::gemm_phase<Epi, pg8::StaticOrder, false>((PG8_LAS unsigned char*)smem, g, S, E, nullptr);
  __syncthreads();
}

DI void wconv_tile(const Params& p, int l, int t, char* smem) {
  u16* W = (u16*)(p.ws + W_OFF);
  const float* src; const float* fold = nullptr; int ld, K, map = 0; unsigned doff; int tn, tk;
  if (t < 7104) {
    int ntk;
    if (t < 1408) { src = p.in[8] + (size_t)l * 1024 * 5632; ld = 5632; K = 1024; fold = p.in[7] + l * 1024; map = 1; doff = (unsigned)WB_GU1; }
    else if (t < 2112) { t -= 1408; src = p.in[9] + (size_t)l * 2816 * 1024; ld = 1024; K = 2816; doff = (unsigned)WB_DN1; }
    else if (t < 3712) { t -= 2112; src = p.in[11] + (size_t)l * 1024 * 8208; ld = 8208; K = 1024; fold = p.in[10] + l * 1024; map = 2; doff = (unsigned)WB_WIN; }
    else if (t < 4224) { t -= 3712; src = p.in[11] + (size_t)l * 1024 * 8208 + 6160; ld = 8208; K = 1024; fold = p.in[10] + l * 1024; doff = (unsigned)WB_WG; }
    else if (t < 4480) { t -= 4224; src = p.in[23] + (size_t)l * 1048576; ld = 1024; K = 1024; doff = (unsigned)WB_BA; }
    else if (t < 4736) { t -= 4480; src = p.in[24] + (size_t)l * 1048576; ld = 1024; K = 1024; doff = (unsigned)WB_BB; }
    else if (t < 4992) { t -= 4736; src = p.in[25] + (size_t)l * 1048576; ld = 1024; K = 1024; doff = (unsigned)WB_WO; }
    else if (t < 6400) { t -= 4992; src = p.in[27] + (size_t)l * 1024 * 5632; ld = 5632; K = 1024; fold = p.in[26] + l * 1024; map = 1; doff = (unsigned)WB_GU2; }
    else { t -= 6400; src = p.in[28] + (size_t)l * 2816 * 1024; ld = 1024; K = 2816; doff = (unsigned)WB_DN2; }
    ntk = K >> 6; tn = t / ntk; tk = t - tn * ntk;
  } else {
    t -= 7104;
    const int mat = t >> 5, n = (t >> 2) & 7;
    src = p.in[mat ? 20 : 18] + (size_t)l * 131072 + n * 16384; ld = 128; K = 128;
    doff = (unsigned)(mat ? WB_WI : WB_WR) + n * 16384; tn = (t >> 1) & 1; tk = t & 1;
  }
  u16* dst = W + doff;
  u16* tl = (u16*)smem;
  const int tid = otid(), nl = tid & 63, kl = tid >> 6;
  const int np = tn * 64 + nl;
  int sc = np;
  if (map == 1) sc = ((np >> 4) & 1) * 2816 + 16 * (np >> 5) + (np & 15);
  else if (map == 2) sc = np < 4096 ? np : (np < 6144 ? np + 16 : (np < 6152 ? 4096 + (np - 6144) : (np < 6160 ? 4104 + (np - 6152) : -1)));
  __syncthreads();
#pragma unroll
  for (int i = 0; i < 16; ++i) {
    const int k = tk * 64 + kl + 4 * i;
    float v = 0.f;
    if (sc >= 0) { v = __builtin_nontemporal_load(src + (size_t)k * ld + sc); if (fold) v *= fold[k]; }
    tl[nl * 66 + kl + 4 * i] = f2bf(v);
  }
  __syncthreads();
  const int n = tid >> 2, kq = tid & 3;
  const unsigned* rp = (const unsigned*)(tl + n * 66 + 16 * kq);
  uint4 o0, o1;
  o0.x = rp[0]; o0.y = rp[1]; o0.z = rp[2]; o0.w = rp[3]; o1.x = rp[4]; o1.y = rp[5]; o1.z = rp[6]; o1.w = rp[7];
  uint4* dp = (uint4*)(dst + (size_t)(tn * 64 + n) * K + tk * 64 + 16 * kq);
  dp[0] = o0; dp[1] = o1;
}

DI void gather_item(const Params& p, int item, char* smem) {
  float* x = (float*)(p.ws + X_OFF);
  u16* xb = (u16*)(p.ws + XB_OFF);
  float* ssq = (float*)(p.ws + SSQ_OFF);
  float* red = (float*)smem;
  const int tid = otid();
  float4 v[8];
#pragma unroll
  for (int rr = 0; rr < 8; ++rr) {
    const int row = item * 8 + rr;
    const float* src;
    if (row < 16512) { const int s = row / 2064, pos = row - s * 2064; src = pos < 16 ? p.in[6] + pos * 1024 : p.in[0] + ((size_t)s * 2048 + (pos - 16)) * 1024; }
    else src = p.in[1] + (size_t)(row - 16512) * 1024;
    v[rr] = ((const float4*)src)[tid];
  }
  __syncthreads();
#pragma unroll
  for (int rr = 0; rr < 8; ++rr) {
    const int row = item * 8 + rr;
    ((float4*)(x + (size_t)row * DM))[tid] = v[rr];
    st_bf4(xb + (size_t)row * DM + 4 * tid, v[rr].x, v[rr].y, v[rr].z, v[rr].w);
    float ss = v[rr].x * v[rr].x + v[rr].y * v[rr].y + v[rr].z * v[rr].z + v[rr].w * v[rr].w;
#pragma unroll
    for (int o = 32; o > 0; o >>= 1) ss += __shfl_xor(ss, o);
    if ((tid & 63) == 0) red[rr * 4 + (tid >> 6)] = ss;
  }
  __syncthreads();
  if (tid < 128) {
    const int rr = tid >> 4, j = tid & 15;
    ssq[(size_t)(item * 8 + rr) * 16 + j] = (j == 0) ? (red[rr * 4] + red[rr * 4 + 1] + red[rr * 4 + 2] + red[rr * 4 + 3]) : 0.f;
  }
}

DI void final_phase(const Params& p, int vb, int nvb) {
  const float* x = (const float*)(p.ws + X_OFF);
  const float* ssq = (const float*)(p.ws + SSQ_OFF);
  const int tid = otid();
  const float4 fw = ((const float4*)p.in[29])[tid];
  for (int row0 = vb; row0 < T_TOK; row0 += 4 * nvb) {
    float4 v[4]; float rs[4]; float* dst[4];
#pragma unroll
    for (int u = 0; u < 4; ++u) {
      const int row = row0 + u * nvb;
      dst[u] = nullptr;
      if (row < T_TOK) {
        if (row < 16512) { const int s = row / 2064, pos = row - s * 2064; if (pos >= 16) dst[u] = p.out + O_YP + ((size_t)s * 2048 + (pos - 16)) * 1024; }
        else dst[u] = p.out + O_YS + (size_t)(row - 16512) * 1024;
      }
      if (dst[u]) { rs[u] = ((const float*)(p.ws + RSV_OFF))[row]; v[u] = ((const float4*)(x + (size_t)row * DM))[tid]; }
    }
#pragma unroll
    for (int u = 0; u < 4; ++u) {
      if (dst[u]) {
        float4 o = v[u];
        o.x *= rs[u] * fw.x; o.y *= rs[u] * fw.y; o.z *= rs[u] * fw.z; o.w *= rs[u] * fw.w;
        ((float4*)dst[u])[tid] = o;
      }
    }
  }
}

struct CI { int r0, nv, sbase, stream, last, sample; };
DI CI chunk_info(int ci) {
  CI c;
  if (ci < 264) {
    const int s = ci / 33, k = ci - s * 33;
    c.stream = s; c.sbase = s * 2064; c.sample = 0;
    if (k == 0) { c.r0 = c.sbase; c.nv = 16; } else { c.r0 = c.sbase + 16 + 64 * (k - 1); c.nv = 64; }
    c.last = (k == 32);
  } else {
    const int s = ci - 264;
    c.stream = 8 + s; c.sbase = 16512 + 32 * s; c.r0 = c.sbase; c.nv = 32; c.last = 1; c.sample = 1;
  }
  return c;
}

DI void dconv_store(const Params& p, int l, const CI& c, int cc, int ch, int half, char* RM, char* RT, float* cqo, const float w0, const float w1, const float w2, const float w3) {
  const u16* P = (const u16*)(p.ws + P_OFF);
  const int t0 = 32 * half;
  int pad = 64 - c.nv;
  asm volatile("" : "+v"(pad));
  float r[35];
  const int rowb = c.r0 + t0 - 3 - (64 - c.nv);
  int sbase_v = c.sbase;
  asm volatile("" : "+v"(sbase_v));
#pragma unroll
  for (int i = 0; i < 35; ++i) {
    int rowu = rowb + i;
    rowu = rowu < sbase_v ? sbase_v : rowu;
    r[i] = bf2f(P[(unsigned)rowu * (unsigned)PLD + (unsigned)cc]);
  }
  float hist[3] = {0.f, 0.f, 0.f};
  if (c.sample) {
#pragma unroll
    for (int j = 0; j < 3; ++j) hist[j] = p.in[3][((size_t)(l * 16 + (c.stream - 8)) * 3 + j) * 3072 + cc];
  }
#pragma unroll
  for (int i = 0; i < 35; ++i) {
    const int u = t0 - 3 + i, rowu = rowb + i;
    if (u < pad - 3) r[i] = 0.f;
    else if (rowu < sbase_v) { const int j = 3 + rowu - sbase_v; r[i] = (j == 0) ? hist[0] : (j == 1 ? hist[1] : hist[2]); }
  }
#pragma unroll
  for (int q = 0; q < 4; ++q) {
    const int tq = t0 + 8 * q;
    float o[8];
#pragma unroll
    for (int i = 0; i < 8; ++i) {
      const float sv = r[8 * q + i] * w0 + r[8 * q + i + 1] * w1 + r[8 * q + i + 2] * w2 + r[8 * q + i + 3] * w3;
      o[i] = (tq + i >= pad) ? silu_(sv) : 0.f;
    }
    if (RM) {
#pragma unroll
      for (int i = 0; i < 8; ++i) *(u16*)(RM + sw256(tq + i, ch >> 3) + (ch & 7) * 2) = f2bf(o[i]);
    }
    if (RT) {
      u32x4 v; v[0] = pk2(o[0], o[1]); v[1] = pk2(o[2], o[3]); v[2] = pk2(o[4], o[5]); v[3] = pk2(o[6], o[7]);
      *(u32x4*)(RT + sw128(ch, 4 * half + q)) = v;
    }
  }
  if (half && c.last) { cqo[cc] = r[32]; cqo[3072 + cc] = r[33]; cqo[6144 + cc] = r[34]; }
}

DI void delta_pre_item(const Params& p, int l, int it, char* smem, const float (&tw)[12]) {
  const int ci = it >> 3, h = it & 7;
  const CI c = chunk_info(ci);
  const u16* P = (const u16*)(p.ws + P_OFF);
  char* R0 = smem; char* R1 = smem + 16384; char* R2 = smem + 32768; float* Lm = (float*)(smem + 49152);
  float* sBeta = (float*)(smem + 65536); float* sGc = sBeta + 64; float* sNk = sBeta + 128; float* sNq = sBeta + 192;
  const int tid = otid(), lane = tid & 63, wid = tid >> 6, lr = lane & 31, lh = lane >> 5;
  const int ch = tid & 127, half = tid >> 7, t0 = 32 * half;
  const int pad = 64 - c.nv;
  float* cqo = p.out + (c.sample ? O_SCQ + ((size_t)(l * 16 + (c.stream - 8)) * 3) * 3072 : O_PCQ + ((size_t)(l * 8 + c.stream) * 3) * 3072);
  __syncthreads();
  dconv_store(p, l, c, h * 128 + ch, ch, half, R0, nullptr, cqo, tw[0], tw[1], tw[2], tw[3]);
  dconv_store(p, l, c, 1024 + h * 128 + ch, ch, half, R1, R2, cqo, tw[4], tw[5], tw[6], tw[7]);
  if (tid < 64) {
    float beta = 0.f, g = 0.f;
    if (tid >= pad) {
      const size_t row = (size_t)(c.r0 + tid - pad);
      beta = sigmoid_(bf2f(P[row * PLD + PC_BETA + h]));
      g = -__expf(p.in[13][l * 8 + h]) * softplus_(bf2f(P[row * PLD + PC_ALPHA + h]) + p.in[14][l * 8 + h]);
    }
#pragma unroll
    for (int o = 1; o < 64; o <<= 1) { const float v = __shfl_up(g, o); if (lane >= o) g += v; }
    sBeta[tid] = beta; sGc[tid] = g;
  }
  __syncthreads();
  const int ti = wid >> 1, tj = wid & 1;
  f32x16 aQK, aKK, aQQ;
  zero16(aQK); zero16(aKK); zero16(aQQ);
#pragma unroll
  for (int ks = 0; ks < 8; ++ks) {
    const bf16x8 kf = ldsfrag(R1, sw256(32 * tj + lr, 2 * ks + lh));
    const bf16x8 qf = ldsfrag(R0, sw256(32 * ti + lr, 2 * ks + lh));
    const bf16x8 kif = ldsfrag(R1, sw256(32 * ti + lr, 2 * ks + lh));
    aQK = MFMA(kf, qf, aQK);
    aKK = MFMA(kf, kif, aKK);
    if (ti == tj) aQQ = MFMA(qf, qf, aQQ);
  }
  if (ti == tj && (((lr >> 2) & 1) == lh)) {
    float vk = 0.f, vq = 0.f;
#pragma unroll
    for (int reg = 0; reg < 16; ++reg) if (crow(reg, lh) == lr) { vk = aKK[reg]; vq = aQQ[reg]; }
    sNk[32 * ti + lr] = vk; sNq[32 * ti + lr] = vq;
  }
  __syncthreads();
  const size_t itb = (size_t)it;
  {
    u16* Ag = (u16*)(p.ws + A_OFF) + itb * 4096;
    const int i = 32 * ti + lr;
    const float gi = sGc[i], rqi = __builtin_amdgcn_rsqf(sNq[i] + EPS) * 0.08838834764831845f, bki = sBeta[i] * __builtin_amdgcn_rsqf(sNk[i] + EPS);
#pragma unroll
    for (int b = 0; b < 4; ++b) {
      float av[4], lv[4];
#pragma unroll
      for (int r = 0; r < 4; ++r) {
        const int j = 32 * tj + 8 * b + 4 * lh + r;
        const float rkj = __builtin_amdgcn_rsqf(sNk[j] + EPS);
        const float dec = (j <= i) ? __expf(gi - sGc[j]) : 0.f;
        av[r] = rqi * rkj * aQK[4 * b + r] * dec;
        lv[r] = (j < i) ? bki * rkj * aKK[4 * b + r] * dec : 0.f;
      }
      st_bf4(Ag + i * 64 + 16 * (2 * tj + (b >> 1)) + 8 * lh + 4 * (b & 1), av[0], av[1], av[2], av[3]);
      *(float4*)(Lm + i * 64 + 32 * tj + 8 * b + 4 * lh) = make_float4(lv[0], lv[1], lv[2], lv[3]);
      if (wid == 2) st_bf4((u16*)(smem + 66560) + lr * 32 + 8 * b + 4 * lh, lv[0], lv[1], lv[2], lv[3]);
    }
    u16* Qg = (u16*)(p.ws + QD_OFF) + itb * 8192;
    u16* Kg = (u16*)(p.ws + KD_OFF) + itb * 8192;
    const float glc = sGc[63];
#pragma unroll
    for (int ii = 0; ii < 4; ++ii) {
      const int q = tid + 256 * ii;
      {
        const int t = q >> 4, chn = q & 15, s = chn >> 1, hh = chn & 1;
        const float sc = __builtin_amdgcn_rsqf(sNq[t] + EPS) * 0.08838834764831845f * __expf(sGc[t]);
        const int c0 = 16 * s + 4 * hh, c1 = c0 + 8;
        const float4 v0 = ld_bf4((const u16*)(R0 + sw256(t, c0 >> 3) + (c0 & 7) * 2));
        const float4 v1 = ld_bf4((const u16*)(R0 + sw256(t, c1 >> 3) + (c1 & 7) * 2));
        uint4 o; o.x = pk2(v0.x * sc, v0.y * sc); o.y = pk2(v0.z * sc, v0.w * sc); o.z = pk2(v1.x * sc, v1.y * sc); o.w = pk2(v1.z * sc, v1.w * sc);
        *(uint4*)(Qg + t * 128 + 8 * chn) = o;
      }
      {
        const int dk = q >> 3, chn = q & 7, s = chn >> 1, hh = chn & 1;
        const int ta = 16 * s + 4 * hh, tb = ta + 8;
        const float4 v0 = ld_bf4((const u16*)(R2 + sw128(dk, ta >> 3) + (ta & 7) * 2));
        const float4 v1 = ld_bf4((const u16*)(R2 + sw128(dk, tb >> 3) + (tb & 7) * 2));
        float sa[4], sb[4];
#pragma unroll
        for (int r = 0; r < 4; ++r) { sa[r] = __builtin_amdgcn_rsqf(sNk[ta + r] + EPS) * __expf(glc - sGc[ta + r]); sb[r] = __builtin_amdgcn_rsqf(sNk[tb + r] + EPS) * __expf(glc - sGc[tb + r]); }
        uint4 o; o.x = pk2(v0.x * sa[0], v0.y * sa[1]); o.y = pk2(v0.z * sa[2], v0.w * sa[3]); o.z = pk2(v1.x * sb[0], v1.y * sb[1]); o.w = pk2(v1.z * sb[2], v1.w * sb[3]);
        *(uint4*)(Kg + dk * 64 + 8 * chn) = o;
      }
    }
    if (tid == 0) ((float*)(p.ws + GL_OFF))[it] = __expf(glc);
  }
  __syncthreads();
  dconv_store(p, l, c, 2048 + h * 128 + ch, ch, half, nullptr, R0, cqo, tw[8], tw[9], tw[10], tw[11]);
  {
    u16* L21b = (u16*)(smem + 66560); u16* T11t = (u16*)(smem + 68608); u16* T22b = (u16*)(smem + 70656);
    if (wid < 2) {
      const int blk = wid, cc = 32 * blk + lr;
      float tc[32];
#pragma unroll
      for (int i = 0; i < 32; ++i) tc[i] = 0.f;
#pragma unroll
      for (int i = 0; i < 32; ++i) {
        float sacc = (i == lr) ? 1.f : 0.f;
#pragma unroll
        for (int j4 = 0; j4 < i; j4 += 4) {
          const float4 lv = *(const float4*)(Lm + (32 * blk + i) * 64 + 32 * blk + j4);
          sacc -= lv.x * tc[j4]; sacc -= lv.y * tc[j4 + 1]; sacc -= lv.z * tc[j4 + 2]; sacc -= lv.w * tc[j4 + 3];
        }
        tc[i] = sacc;
      }
      if (lh == 0) {
        const float b1 = sBeta[cc], c1 = b1 * __builtin_amdgcn_rsqf(sNk[cc] + EPS) * __expf(sGc[cc]);
#pragma unroll
        for (int i = 0; i < 32; ++i) {
          const int off = sw128(32 * blk + i, cc >> 3) + (cc & 7) * 2;
          *(u16*)(R1 + off) = f2bf(tc[i] * c1);
          *(u16*)(R1 + 8192 + off) = f2bf(tc[i] * b1);
        }
        if (blk == 0) {
#pragma unroll
          for (int q = 0; q < 4; ++q) {
            u32x4 v; v[0] = pk2(tc[8 * q], tc[8 * q + 1]); v[1] = pk2(tc[8 * q + 2], tc[8 * q + 3]); v[2] = pk2(tc[8 * q + 4], tc[8 * q + 5]); v[3] = pk2(tc[8 * q + 6], tc[8 * q + 7]);
            *(u32x4*)(T11t + lr * 32 + 8 * q) = v;
          }
        } else {
#pragma unroll
          for (int i = 0; i < 32; ++i) T22b[i * 32 + lr] = f2bf(tc[i]);
        }
      }
    } else {
#pragma unroll
      for (int i = 0; i < 2; ++i) {
        const int idx = (tid - 128) + 128 * i, mat = idx >> 7, rc = idx & 127;
        u32x4 z; z[0] = 0u; z[1] = 0u; z[2] = 0u; z[3] = 0u;
        *(u32x4*)(R1 + mat * 8192 + sw128(rc >> 2, 4 + (rc & 3))) = z;
      }
    }
    __syncthreads();
    if (wid == 0) {
      f32x16 Mx, D2;
      zero16(Mx); zero16(D2);
#pragma unroll
      for (int ks = 0; ks < 2; ++ks) {
        const bf16x8 xf = *(const bf16x8*)(L21b + lr * 32 + (2 * ks + lh) * 8);
        const bf16x8 yf = *(const bf16x8*)(T11t + lr * 32 + (2 * ks + lh) * 8);
        Mx = MFMA(xf, yf, Mx);
      }
#pragma unroll
      for (int sx = 0; sx < 2; ++sx) {
        const bf16x8 yp = sx ? pack8<1>(Mx) : pack8<0>(Mx);
        const uint2 lo = *(const uint2*)(T22b + lr * 32 + 16 * sx + 4 * lh);
        const uint2 hi = *(const uint2*)(T22b + lr * 32 + 16 * sx + 8 + 4 * lh);
        u32x4 xv; xv[0] = lo.x; xv[1] = lo.y; xv[2] = hi.x; xv[3] = hi.y;
        D2 = MFMA(__builtin_bit_cast(bf16x8, xv), yp, D2);
      }
      const float b1 = sBeta[lr], c1 = b1 * __builtin_amdgcn_rsqf(sNk[lr] + EPS) * __expf(sGc[lr]);
#pragma unroll
      for (int r = 0; r < 16; ++r) {
        const int off = sw128(32 + crow(r, lh), lr >> 3) + (lr & 7) * 2;
        *(u16*)(R1 + off) = f2bf(-D2[r] * c1);
        *(u16*)(R1 + 8192 + off) = f2bf(-D2[r] * b1);
      }
    }
  }
  __syncthreads();
  {
    u16* Wg = (u16*)(p.ws + WW_OFF) + itb * 8192;
    u16* Ug = (u16*)(p.ws + UT_OFF) + itb * 8192;
    f32x16 aw[2], au[2];
    zero16(aw[0]); zero16(aw[1]); zero16(au[0]); zero16(au[1]);
#pragma unroll
    for (int ks = 0; ks < 4; ++ks) {
      const bf16x8 kT = ldsfrag(R2, sw128(32 * wid + lr, 2 * ks + lh));
      const bf16x8 vT = ldsfrag(R0, sw128(32 * wid + lr, 2 * ks + lh));
#pragma unroll
      for (int bb = 0; bb < 2; ++bb) {
        const bf16x8 t1 = ldsfrag(R1, sw128(32 * bb + lr, 2 * ks + lh));
        const bf16x8 t2 = ldsfrag(R1 + 8192, sw128(32 * bb + lr, 2 * ks + lh));
        aw[bb] = MFMA(kT, t1, aw[bb]);
        au[bb] = MFMA(t2, vT, au[bb]);
      }
    }
#pragma unroll
    for (int bb = 0; bb < 2; ++bb)
#pragma unroll
      for (int b = 0; b < 4; ++b) {
        st_bf4(Wg + (32 * bb + lr) * 128 + 32 * wid + 16 * (b >> 1) + 8 * lh + 4 * (b & 1), aw[bb][4 * b], aw[bb][4 * b + 1], aw[bb][4 * b + 2], aw[bb][4 * b + 3]);
        st_bf4(Ug + (32 * wid + lr) * 64 + 32 * bb + 8 * b + 4 * lh, au[bb][4 * b], au[bb][4 * b + 1], au[bb][4 * b + 2], au[bb][4 * b + 3]);
      }
  }
}

DI void delta_seq_item(const Params& p, int l, int item, char* smem) {
  const int stream = item >> 3, h = item & 7;
  const int tid = otid(), lane = tid & 63, wid = tid >> 6, lr = lane & 31, lh = lane >> 5;
  const int dv = 32 * wid + lr;
  u16* P = (u16*)(p.ws + P_OFF);
  f32x16 S[4];
  float* Sout;
  int nchunk, ci0;
  if (stream < 8) {
#pragma unroll
    for (int m = 0; m < 4; ++m) zero16(S[m]);
    Sout = p.out + O_PS + ((size_t)(l * 8 + stream) * 8 + h) * 16384;
    nchunk = 33; ci0 = stream * 33;
  } else {
    const float* S0 = p.in[2] + ((size_t)(l * 16 + (stream - 8)) * 8 + h) * 16384;
    const float* sp = S0 + (4 * lh) * 128 + dv;
#pragma unroll
    for (int m = 0; m < 4; ++m)
#pragma unroll
      for (int b = 0; b < 4; ++b) {
#pragma unroll
        for (int r = 0; r < 4; ++r) S[m][4 * b + r] = sp[r * 128];
        sp += 8 * 128;
        __builtin_amdgcn_sched_barrier(0);
      }
    Sout = p.out + O_SS + ((size_t)(l * 16 + (stream - 8)) * 8 + h) * 16384;
    nchunk = 1; ci0 = 264 + (stream - 8);
  }
  char* sW = smem; char* sQ = smem + 16384; char* sK = smem + 32768; char* sA = smem + 49152; char* sO = smem + 57344;
#define DMA256(gbase, lbase) { _Pragma("unroll") for (int ii = 0; ii < 4; ++ii) { const int pos = tid + 256 * ii, row = pos >> 4, chn = (pos & 15) ^ (row & 15); \
    __builtin_amdgcn_global_load_lds((const unsigned*)((gbase) + row * 128 + chn * 8), (lds_u32*)((lbase) + pos * 16), 16, 0, 0); } }
#define DMA128(gbase, lbase, n) { _Pragma("unroll") for (int ii = 0; ii < (n); ++ii) { const int pos = tid + 256 * ii, row = pos >> 3, chn = (pos & 7) ^ ((row >> 1) & 7); \
    __builtin_amdgcn_global_load_lds((const unsigned*)((gbase) + row * 64 + chn * 8), (lds_u32*)((lbase) + pos * 16), 16, 0, 0); } }
  __syncthreads();
  {
    const size_t it = (size_t)ci0 * 8 + h;
    const u16* Wg = (const u16*)(p.ws + WW_OFF) + it * 8192;
    const u16* Qg = (const u16*)(p.ws + QD_OFF) + it * 8192;
    DMA256(Wg, sW); DMA256(Qg, sQ);
  }
  asm volatile("s_waitcnt vmcnt(0)" ::: "memory");
  __syncthreads();
  for (int k = 0; k < nchunk; ++k) {
    const int ci = ci0 + k;
    const CI c = chunk_info(ci);
    const size_t it = (size_t)ci * 8 + h;
    const u16* Kg = (const u16*)(p.ws + KD_OFF) + it * 8192;
    const u16* Ag = (const u16*)(p.ws + A_OFF) + it * 4096;
    const u16* Ug = (const u16*)(p.ws + UT_OFF) + it * 8192;
    const float gl = ((const float*)(p.ws + GL_OFF))[it];
    if (k == 0) { DMA128(Kg, sK, 4); DMA128(Ag, sA, 2); }
    uint2 uvr[2][4];
#pragma unroll
    for (int m = 0; m < 2; ++m)
#pragma unroll
      for (int b = 0; b < 4; ++b) uvr[m][b] = *(const uint2*)(Ug + dv * 64 + 32 * m + 8 * b + 4 * lh);
    const int et = tid >> 2, eq = tid & 3, epad = 64 - c.nv;
    const bool erow = (et >= epad);
    const size_t erow_off = (size_t)(c.r0 + (erow ? et - epad : 0)) * PLD + h * 128 + 32 * eq;
    f32x16 M1[2], M2[2];
    zero16(M1[0]); zero16(M1[1]); zero16(M2[0]); zero16(M2[1]);
#pragma unroll
    for (int mt = 0; mt < 4; ++mt) {
#pragma unroll
      for (int sx = 0; sx < 2; ++sx) {
        const int ks = 2 * mt + sx;
        const bf16x8 Sp = sx ? pack8<1>(S[mt]) : pack8<0>(S[mt]);
#pragma unroll
        for (int m = 0; m < 2; ++m) {
          const bf16x8 wf = ldsfrag(sW, sw256(32 * m + lr, 2 * ks + lh));
          const bf16x8 qf = ldsfrag(sQ, sw256(32 * m + lr, 2 * ks + lh));
          M1[m] = MFMA(wf, Sp, M1[m]);
          M2[m] = MFMA(qf, Sp, M2[m]);
        }
      }
    }
    asm volatile("s_waitcnt vmcnt(0)" ::: "memory");
    __syncthreads();
    const bool more = (k + 1 < nchunk);
    if (more) {
      const u16* Wg = (const u16*)(p.ws + WW_OFF) + (it + 8) * 8192;
      const u16* Qg = (const u16*)(p.ws + QD_OFF) + (it + 8) * 8192;
      DMA256(Wg, sW); DMA256(Qg, sQ);
    }
    uint2 zr[8];
#pragma unroll
    for (int i = 0; i < 8; ++i) zr[i] = *(const uint2*)(P + erow_off + PC_Z + 4 * i);
#pragma unroll
    for (int m = 0; m < 2; ++m)
#pragma unroll
      for (int b = 0; b < 4; ++b) {
        const uint2 u2 = uvr[m][b];
        M1[m][4 * b] = __uint_as_float(u2.x << 16) - M1[m][4 * b]; M1[m][4 * b + 1] = __uint_as_float(u2.x & 0xffff0000u) - M1[m][4 * b + 1];
        M1[m][4 * b + 2] = __uint_as_float(u2.y << 16) - M1[m][4 * b + 2]; M1[m][4 * b + 3] = __uint_as_float(u2.y & 0xffff0000u) - M1[m][4 * b + 3];
      }
    bf16x8 Vp[4];
    Vp[0] = pack8<0>(M1[0]); Vp[1] = pack8<1>(M1[0]); Vp[2] = pack8<0>(M1[1]); Vp[3] = pack8<1>(M1[1]);
#pragma unroll
    for (int mt = 0; mt < 4; ++mt) {
#pragma unroll
      for (int r = 0; r < 16; ++r) S[mt][r] *= gl;
#pragma unroll
      for (int kk = 0; kk < 4; ++kk) {
        const bf16x8 kf = ldsfrag(sK, sw128(32 * mt + lr, 2 * kk + lh));
        S[mt] = MFMA(kf, Vp[kk], S[mt]);
      }
    }
#pragma unroll
    for (int m = 0; m < 2; ++m)
#pragma unroll
      for (int kk = 0; kk < 4; ++kk) {
        const bf16x8 af = ldsfrag(sA, sw128(32 * m + lr, 2 * kk + lh));
        M2[m] = MFMA(af, Vp[kk], M2[m]);
      }
#pragma unroll
    for (int m = 0; m < 2; ++m)
#pragma unroll
      for (int r = 0; r < 16; ++r) *(u16*)(sO + (32 * m + crow(r, lh)) * 256 + dv * 2) = f2bf(M2[m][r]);
    __syncthreads();
    if (more) { DMA128(Kg + 8 * 8192, sK, 4); DMA128(Ag + 8 * 4096, sA, 2); }
    {
      float ov[32];
      float ss = 0.f;
#pragma unroll
      for (int i = 0; i < 4; ++i) {
        const u32x4 t4 = *(const u32x4*)(sO + et * 256 + 64 * eq + 16 * i);
#pragma unroll
        for (int e = 0; e < 4; ++e) {
          const float a0 = __uint_as_float(t4[e] << 16), a1 = __uint_as_float(t4[e] & 0xffff0000u);
          ov[8 * i + 2 * e] = a0; ov[8 * i + 2 * e + 1] = a1; ss += a0 * a0 + a1 * a1;
        }
      }
      ss += __shfl_xor(ss, 1); ss += __shfl_xor(ss, 2);
      const float rs = __builtin_amdgcn_rsqf(ss * (1.f / 128.f) + EPS);
      if (erow) {
        u16* op = P + erow_off + PC_OA;
        const float* nw = p.in[15] + l * 128 + 32 * eq;
#pragma unroll
        for (int i = 0; i < 8; ++i) {
          const float zx = __uint_as_float(zr[i].x << 16), zy = __uint_as_float(zr[i].x & 0xffff0000u), zz = __uint_as_float(zr[i].y << 16), zw = __uint_as_float(zr[i].y & 0xffff0000u);
          const float4 w4 = *(const float4*)(nw + 4 * i);
          st_bf4(op + 4 * i, ov[4 * i] * rs * w4.x * silu_(zx), ov[4 * i + 1] * rs * w4.y * silu_(zy), ov[4 * i + 2] * rs * w4.z * silu_(zz), ov[4 * i + 3] * rs * w4.w * silu_(zw));
        }
      }
    }
    if (more) {
      asm volatile("s_waitcnt vmcnt(0)" ::: "memory");
      __syncthreads();
    }
  }
#undef DMA256
#undef DMA128
  float* so = Sout + (4 * lh) * 128 + dv;
#pragma unroll
  for (int m = 0; m < 4; ++m)
#pragma unroll
    for (int b = 0; b < 4; ++b) {
#pragma unroll
      for (int r = 0; r < 4; ++r) so[r * 128] = S[m][4 * b + r];
      so += 8 * 128;
      __builtin_amdgcn_sched_barrier(0);
    }
}

struct LT { int r0, nv, first, last, stream; };
DI LT lru_tile(int tl) {
  LT t;
  if (tl < 520) { const int s = tl / 65, j = tl - s * 65; t.stream = s; t.first = (j == 0); t.last = (j == 64); t.nv = j ? 32 : 16; t.r0 = s * 2064 + (j ? 16 + 32 * (j - 1) : 0); }
  else { const int s = tl - 520; t.stream = 8 + s; t.first = 1; t.last = 1; t.nv = 32; t.r0 = 16512 + 32 * s; }
  return t;
}
DI void lru_a_item(const Params& p, int l, int item, char* smem, const bf16x8 (&wrf)[8], const bf16x8 (&wif)[8],
                   const float cw0, const float cw1, const float cw2, const float cw3, const float cb, const float br, const float bi, const float c8) {
  const int tl = item >> 3, n = item & 7;
  const LT T = lru_tile(tl);
  const int tid = otid(), lane = tid & 63, wid = tid >> 6, lr = lane & 31, lh = lane >> 5;
  u16* P = (u16*)(p.ws + P_OFF);
  u16* Ya = (u16*)(p.out + O_YP);
  const u16* W = (const u16*)(p.ws + W_OFF);
  float* AG = (float*)(p.ws + AG_OFF);
  float* raw = (float*)smem; float* xc = (float*)(smem + 18432); char* xcb = smem + 34816;
  const int ch = tid & 127, rp = tid >> 7;
  const int gc = n * 128 + ch;
  const int d = 32 * wid + lr, gd = n * 128 + d;
  float lyv[16];
#pragma unroll
  for (int r = 0; r < 16; ++r) { const int t = crow(r, lh); lyv[r] = (t < T.nv) ? bf2f(P[(size_t)(T.r0 + t) * PLD + PC_LY + gd]) : 0.f; }
  __syncthreads();
#pragma unroll
  for (int i = 0; i < 18; ++i) {
    const int rr = rp + 2 * i;
    if (rr < 3 + T.nv) {
      float v;
      if (rr >= 3 || !T.first) v = bf2f(P[(size_t)(T.r0 + rr - 3) * PLD + PC_LX + gc]);
      else v = (T.stream >= 8) ? p.in[5][((size_t)(l * 16 + (T.stream - 8)) * 3 + rr) * 1024 + gc] : 0.f;
      raw[rr * 128 + ch] = v;
    }
  }
  __syncthreads();
#pragma unroll 4
  for (int t = rp; t < 32; t += 2) {
    float v = 0.f;
    if (t < T.nv) v = cb + raw[t * 128 + ch] * cw0 + raw[(t + 1) * 128 + ch] * cw1 + raw[(t + 2) * 128 + ch] * cw2 + raw[(t + 3) * 128 + ch] * cw3;
    xc[t * 128 + ch] = v;
    *(u16*)(xcb + sw256(t, ch >> 3) + (ch & 7) * 2) = f2bf(v);
  }
  if (T.last && tid < 128) {
    float* ocx = (T.stream < 8) ? p.out + O_PCX + (size_t)(l * 8 + T.stream) * 3 * 1024 : p.out + O_SCX + (size_t)(l * 16 + (T.stream - 8)) * 3 * 1024;
    ocx[gc] = raw[T.nv * 128 + ch]; ocx[1024 + gc] = raw[(T.nv + 1) * 128 + ch]; ocx[2048 + gc] = raw[(T.nv + 2) * 128 + ch];
  }
  __syncthreads();
  f32x16 aR, aI;
  zero16(aR); zero16(aI);
#pragma unroll
  for (int ks = 0; ks < 8; ++ks) {
    const bf16x8 af = ldsfrag(xcb, sw256(lr, 2 * ks + lh));
    aR = MFMA(af, wrf[ks], aR);
    aI = MFMA(af, wif[ks], aI);
  }
  float av[16], bv[16], hv[16], pv[16];
#pragma unroll
  for (int r = 0; r < 16; ++r) {
    const int t = crow(r, lh);
    const float rr = sigmoid_(aR[r] + br), ig = sigmoid_(aI[r] + bi);
    const float la = c8 * rr;
    const float a = __expf(la), mult = __builtin_amdgcn_sqrtf(fmaxf(1.f - a * a, 0.f));
    const float xv = xc[t * 128 + d];
    av[r] = (t < T.nv) ? a : 1.f;
    bv[r] = (t < T.nv) ? mult * ig * xv : 0.f;
  }
  float hc = 0.f, pc = 1.f;
#pragma unroll
  for (int b = 0; b < 4; ++b) {
    float cA = hc, qA = pc, tA[4], uA[4], tB[4], uB[4];
#pragma unroll
    for (int r = 0; r < 4; ++r) { cA = av[4 * b + r] * cA + bv[4 * b + r]; qA = av[4 * b + r] * qA; tA[r] = cA; uA[r] = qA; }
    hc = __shfl(cA, lr); pc = __shfl(qA, lr);
    float cB = hc, qB = pc;
#pragma unroll
    for (int r = 0; r < 4; ++r) { cB = av[4 * b + r] * cB + bv[4 * b + r]; qB = av[4 * b + r] * qB; tB[r] = cB; uB[r] = qB; }
    hc = __shfl(cB, lr + 32); pc = __shfl(qB, lr + 32);
#pragma unroll
    for (int r = 0; r < 4; ++r) { hv[4 * b + r] = lh ? tB[r] : tA[r]; pv[4 * b + r] = lh ? uB[r] : uA[r]; }
  }
#pragma unroll
  for (int r = 0; r < 16; ++r) {
    const int t = crow(r, lh);
    if (t < T.nv) {
      const float g = gelu_tanh_(lyv[r]);
      P[(size_t)(T.r0 + t) * PLD + PC_LY + gd] = f2bf(hv[r] * g);
      Ya[(size_t)(T.r0 + t) * 1024 + gd] = f2bf(pv[r] * g);
    }
  }
  if (lh == 0) { AG[(size_t)(tl * 2) * 1024 + gd] = pc; AG[(size_t)(tl * 2 + 1) * 1024 + gd] = hc; }
}

DI void lru_b_item(const Params& p, int l, int item, char* smem) {
  const int tid = otid();
  u16* P = (u16*)(p.ws + P_OFF);
  const u16* Ya = (const u16*)(p.out + O_YP);
  const float* AG = (const float*)(p.ws + AG_OFF);
  float* cin = (float*)smem;
  int stream, n, qtr, ntile, tl0, rbase, L;
  if (item < 256) { stream = item >> 5; n = (item >> 2) & 7; qtr = item & 3; ntile = 65; tl0 = stream * 65; rbase = stream * 2064; L = 2064; }
  else { const int q = item - 256; stream = 8 + (q >> 3); n = q & 7; qtr = -1; ntile = 1; tl0 = 520 + (stream - 8); rbase = 16512 + 32 * (stream - 8); L = 32; }
  __syncthreads();
  if (tid < 128) {
    const int gd = n * 128 + tid;
    float c = (stream >= 8) ? p.in[4][(size_t)(l * 16 + (stream - 8)) * 1024 + gd] : 0.f;
#pragma unroll 13
    for (int j = 0; j < ntile; ++j) {
      const float a = AG[(size_t)((tl0 + j) * 2) * 1024 + gd], h = AG[(size_t)((tl0 + j) * 2 + 1) * 1024 + gd];
      cin[j * 128 + tid] = c;
      c = a * c + h;
    }
    if (qtr <= 0) {
      float* oh = (stream < 8) ? p.out + O_PH + (size_t)(l * 8 + stream) * 1024 : p.out + O_SH + (size_t)(l * 16 + (stream - 8)) * 1024;
      oh[gd] = c;
    }
  }
  __syncthreads();
  const int ck = tid & 15, rsub = tid >> 4;
  int pb = 0, pe = L;
  if (qtr >= 0) { pb = 516 * qtr; pe = pb + 516; }
  for (int pr0 = pb + rsub; pr0 < pe; pr0 += 64) {
    u32x4 yl[4], ya[4];
#pragma unroll
    for (int u = 0; u < 4; ++u) {
      const int pr = pr0 + 16 * u;
      if (pr < pe) {
        const size_t row = (size_t)(rbase + pr);
        yl[u] = *(const u32x4*)(P + row * PLD + PC_LY + n * 128 + 8 * ck);
        ya[u] = *(const u32x4*)(Ya + row * 1024 + n * 128 + 8 * ck);
      }
    }
#pragma unroll
    for (int u = 0; u < 4; ++u) {
      const int pr = pr0 + 16 * u;
      if (pr < pe) {
        const int j = (stream < 8) ? (pr < 16 ? 0 : 1 + ((pr - 16) >> 5)) : 0;
        const size_t row = (size_t)(rbase + pr);
        const float* cp = cin + j * 128 + 8 * ck;
        u32x4 o;
#pragma unroll
        for (int e = 0; e < 4; ++e) {
          const float y0 = __uint_as_float(yl[u][e] << 16) + __uint_as_float(ya[u][e] << 16) * cp[2 * e];
          const float y1 = __uint_as_float(yl[u][e] & 0xffff0000u) + __uint_as_float(ya[u][e] & 0xffff0000u) * cp[2 * e + 1];
          o[e] = pk2(y0, y1);
        }
        *(u32x4*)(P + row * PLD + PC_Y + n * 128 + 8 * ck) = o;
      }
    }
  }
}

#define XB_TMO      128
#define XB_XCNT(j)  (256  + 64 * (j))
#define XB_XSUB(j)  (1280 + 64 * (j))
#define XB_XGEN(j)  (2304 + 64 * (j))
#define XB_TOP      3328
#define XB_TOPGEN   3392
#define XCD_BAR_WORDS 3456
#define XB_SPIN_CAP (1u << 22)
DI unsigned xb_ld(unsigned* p) { return __hip_atomic_load(p, __ATOMIC_RELAXED, __HIP_MEMORY_SCOPE_AGENT); }
DI unsigned xb_add(unsigned* p, unsigned v) { return __hip_atomic_fetch_add(p, v, __ATOMIC_RELAXED, __HIP_MEMORY_SCOPE_AGENT); }
DI unsigned xb_xcc_id() { return (unsigned)__builtin_amdgcn_s_getreg((3 << 11) | 20) & 0xFu; }
#define XB_SPIN(cond, bar) do { unsigned _sp = 0; while (cond) { __builtin_amdgcn_s_sleep(1); \
    if ((++_sp & 255u) == 0u) { if (xb_ld(&(bar)[XB_TMO])) break; if (_sp > XB_SPIN_CAP) { atomicAdd(&(bar)[XB_TMO], 1u); break; } } } } while (0)
struct XcdBarrier { unsigned* bar; unsigned x; volatile unsigned* st; };
DI XcdBarrier xcd_barrier_post(unsigned* bar, volatile unsigned* st) {
  XcdBarrier b; b.bar = bar; b.x = xb_xcc_id(); b.st = st;
  if (threadIdx.x == 0) (void)xb_add(&bar[XB_XCNT(b.x)], 1u);
  return b;
}
DI void xcd_barrier_complete(unsigned* bar, unsigned x, unsigned& nloc, unsigned& nx) {
  const unsigned G = gridDim.x * gridDim.y * gridDim.z;
  unsigned sum, cnt, mine, sp = 0u;
  for (;;) {
    sum = 0u; cnt = 0u; mine = 0u;
#pragma unroll
    for (unsigned j = 0; j < 16; ++j) { const unsigned c = xb_ld(&bar[XB_XCNT(j)]); sum += c; cnt += (c > 0u) ? 1u : 0u; mine = (j == x) ? c : mine; }
    if (sum == G) break;
    __builtin_amdgcn_s_sleep(1);
    if ((++sp & 255u) == 0u) { if (xb_ld(&bar[XB_TMO])) break; if (sp > XB_SPIN_CAP) { atomicAdd(&bar[XB_TMO], 1u); break; } }
  }
  nloc = mine > 0u ? mine : 1u; nx = cnt > 0u ? cnt : 1u;
}
DI void xcd_barrier(const XcdBarrier& b) {
  asm volatile("s_waitcnt vmcnt(0)" ::: "memory");
  __syncthreads();
  if (threadIdx.x == 0) {
    unsigned* bar = b.bar;
    __builtin_amdgcn_s_waitcnt(0);
    unsigned nloc = b.st[0], nx = b.st[1];
    if (nloc == 0u) { xcd_barrier_complete(bar, b.x, nloc, nx); b.st[0] = nloc; b.st[1] = nx; }
    const unsigned old = xb_add(&bar[XB_XSUB(b.x)], 1u);
    const unsigned gen = old / nloc;
    if (old + 1u == (gen + 1u) * nloc) {
      __builtin_amdgcn_fence(__ATOMIC_RELEASE, "agent");
      asm volatile("s_waitcnt vmcnt(0)" ::: "memory");
      const unsigned og = xb_add(&bar[XB_TOP], 1u);
      const unsigned tg = og / nx;
      if (og + 1u == (tg + 1u) * nx) xb_add(&bar[XB_TOPGEN], 1u);
      else XB_SPIN(xb_ld(&bar[XB_TOPGEN]) == tg, bar);
      __builtin_amdgcn_fence(__ATOMIC_ACQUIRE, "agent");
      xb_add(&bar[XB_XGEN(b.x)], 1u);
      asm volatile("s_waitcnt vmcnt(0)" ::: "memory");
    } else {
      XB_SPIN(xb_ld(&bar[XB_XGEN(b.x)]) == gen, bar);
      __builtin_amdgcn_fence(__ATOMIC_ACQUIRE, "agent");
      asm volatile("s_waitcnt vmcnt(0)" ::: "memory");
    }
  }
  __syncthreads();
}

__global__ void __launch_bounds__(512, 2) mega(Params p, int lo, int hi) {
  extern __shared__ __attribute__((aligned(16))) char smem[];
  volatile unsigned* bst = (volatile unsigned*)(smem + 2 * HALF_LDS);
  if (threadIdx.x == 0) { bst[0] = 0u; bst[1] = 0u; }
  __syncthreads();
  const XcdBarrier gb = xcd_barrier_post((unsigned*)(p.ws + BAR_OFF), bst);
  if (lo < 0) cg::this_grid().sync();
#define GRID_SYNC() xcd_barrier(gb)
  const int hid = __builtin_amdgcn_readfirstlane((int)(threadIdx.x >> 8));
  char* hs = smem + hid * HALF_LDS;
  const int vb0 = 2 * blockIdx.x + hid;
  const int nvb = 2 * gridDim.x;
  int ph = 0;
#if defined(__HIP_DEVICE_COMPILE__)
#define LOAD_PARAMS(q) const __attribute__((address_space(4))) Params* pk_ = (const __attribute__((address_space(4))) Params*)__builtin_amdgcn_kernarg_segment_ptr(); \
    asm volatile("" : "+s"(pk_)); Params q; _Pragma("unroll") for (int i_ = 0; i_ < 30; ++i_) q.in[i_] = pk_->in[i_]; q.out = pk_->out; q.ws = pk_->ws;
#else
#define LOAD_PARAMS(q) Params q = p;
#endif
#define PH(...) { if (ph >= lo && ph < hi) { if (ph > lo) GRID_SYNC(); LOAD_PARAMS(q) asm volatile("" : "+s"(q.ws), "+s"(q.out)); \
    int lz_ = 0; asm volatile("" : "+s"(lz_)); const int vb = vb0 + lz_; const int bid = (int)blockIdx.x + lz_; (void)vb; (void)bid; \
    const u16* xb = (const u16*)(q.ws + XB_OFF); const u16* P = (const u16*)(q.ws + P_OFF); const u16* W = (const u16*)(q.ws + W_OFF); (void)xb; (void)P; (void)W; __VA_ARGS__ } ++ph; }
  PH({
    for (int w = vb; w < 3776 + 2128; w += nvb) {
      if (w < 3776) wconv_tile(q, 0, w < 3712 ? w : 7104 + (w - 3712), hs); else gather_item(q, w - 3776, hs);
    }
  })
#pragma unroll 1
  for (int l = 0; l < 5; ++l) {
    PH({ rs_pass(q, smem, l > 0 ? 11 : 0, 0.5f, (const float*)(q.ws + PART_OFF)); if (l < 4) { GRID_SYNC(); EpiGU e; e.H = (u16*)(q.ws + P_OFF); e.rsv = (const float*)(q.ws + RSV_OFF); wide_gemm(xb, W + WB_GU1, 5632, DM, e, smem, bid); } })
    if (l == 4) break;
    PH({ EpiDOWN e; e.x = (float*)(q.ws + X_OFF); e.xb = (u16*)(q.ws + XB_OFF); e.ssq = (float*)(q.ws + SSQ_OFF); e.f = 0.5f; resid_gemm(P, DFF, W + WB_DN1, DFF, e, (float*)(q.ws + PART_OFF), smem, bid); })
    PH({ rs_pass(q, smem, 11, 0.5f, (const float*)(q.ws + PART_OFF)); GRID_SYNC(); EpiWIN e; e.P = (u16*)(q.ws + P_OFF); e.rsv = (const float*)(q.ws + RSV_OFF); wide_gemm(xb, W + WB_WIN, 6400, DM, e, smem, bid); })
    PH({
      float tw[12];
      { const int t4 = otid(); const float* cwp4 = q.in[12] + (size_t)l * 4 * 3072 + (vb & 7) * 128 + (t4 & 127);
        _Pragma("unroll") for (int sel = 0; sel < 3; ++sel) _Pragma("unroll") for (int j = 0; j < 4; ++j) tw[4 * sel + j] = cwp4[sel * 1024 + j * 3072]; }
      for (int w = vb; w < NITEM; w += nvb) delta_pre_item(q, l, w, hs, tw);
    })
    PH({
      if (vb < 64) delta_seq_item(q, l, vb, hs);
      else {
        const int nb = nvb - 64;
        const int b = vb - 64;
        if (b < 128) delta_seq_item(q, l, 64 + b, hs);
        {
          const int t5 = otid();
          const int n5 = b & 7;
          const int d5 = 32 * (t5 >> 6) + (t5 & 31);
          const int lh5 = (t5 >> 5) & 1;
          const u16* W5 = (const u16*)(q.ws + W_OFF);
          bf16x8 wrf[8];
          bf16x8 wif[8];
          _Pragma("unroll") for (int ks = 0; ks < 8; ++ks) {
            wrf[ks] = *(const bf16x8*)(W5 + WB_WR + n5 * 16384 + d5 * 128 + (2 * ks + lh5) * 8);
            wif[ks] = *(const bf16x8*)(W5 + WB_WI + n5 * 16384 + d5 * 128 + (2 * ks + lh5) * 8);
          }
          const int gc5 = n5 * 128 + (t5 & 127);
          const int gd5 = n5 * 128 + d5;
          const float* cwp5 = q.in[16] + (size_t)l * 4 * 1024 + gc5;
          const float cw0 = cwp5[0];
          const float cw1 = cwp5[1024];
          const float cw2 = cwp5[2048];
          const float cw3 = cwp5[3072];
          const float cb5 = q.in[17][l * 1024 + gc5];
          const float br5 = q.in[19][l * 1024 + gd5];
          const float bi5 = q.in[21][l * 1024 + gd5];
          const float c85 = -8.f * softplus_(-q.in[22][l * 1024 + gd5]);
          for (int w = (b < 128 ? b + nb : b); w < 128 + NLT * 8; w += nb) lru_a_item(q, l, w - 128, hs, wrf, wif, cw0, cw1, cw2, cw3, cb5, br5, bi5, c85);
        }
        const int ntot = 3392 + (l < 3 ? 3712 : 0);
        for (int t = b; t < ntot; t += nb) {
          if (t < 3392) wconv_tile(q, l, 3712 + t, hs);
          else wconv_tile(q, l + 1, t - 3392, hs);
        }
      }
    })
    PH({
      const int nw = 384 + (l < 3 ? 64 : 0);
      for (int w = vb; w < nw; w += nvb) { if (w < 384) lru_b_item(q, l, w, hs); else wconv_tile(q, l + 1, 7104 + (w - 384), hs); }
    })
    PH({
      u16* Pw = (u16*)(q.ws + P_OFF);
      const float* rsv = (const float*)(q.ws + RSV_OFF);
      { EpiTMP e; e.T = Pw + PC_MRG; wide_gemm(P + PC_OA, W + WB_BA, 1024, DM, e, smem, bid, PLD, 16384); }
      { EpiGATE e; e.T = Pw + PC_MRG; e.M = Pw + PC_MRG; e.rsv = rsv; e.accum = 0; wide_gemm(xb, W + WB_WG, 1024, DM, e, smem, bid, 0, 16384); }
      { EpiTMP e; e.T = Pw + PC_Z; wide_gemm(P + PC_Y, W + WB_BB, 1024, DM, e, smem, bid, PLD, 16384); }
      { EpiGATE e; e.T = Pw + PC_Z; e.M = Pw + PC_MRG; e.rsv = rsv; e.accum = 1; wide_gemm(xb, W + WB_WG + (size_t)1024 * DM, 1024, DM, e, smem, bid, 0, 16384); }
      u16* mpart = (u16*)(q.out + O_YP + 12582912);
      tail_slices(P + PC_OA, PLD, PC_Y - PC_OA, W + WB_BA, (int)(WB_BB - WB_BA), mpart, smem, bid);
      tail_slices(xb, DM, 0, W + WB_WG, 1024 * DM, mpart + (size_t)4 * 768 * 1024, smem, bid);
    })
    PH({ merge_tail_fix(q, (const u16*)(q.out + O_YP + 12582912)); GRID_SYNC(); EpiDOWN e; e.x = (float*)(q.ws + X_OFF); e.xb = (u16*)(q.ws + XB_OFF); e.ssq = (float*)(q.ws + SSQ_OFF); e.f = 1.f; resid_gemm(P + PC_MRG, PLD, W + WB_WO, DM, e, q.out + O_YP + 9437184, smem, bid); })
    PH({ rs_pass(q, smem, 4, 1.f, q.out + O_YP + 9437184); GRID_SYNC(); EpiGU e; e.H = (u16*)(q.ws + P_OFF); e.rsv = (const float*)(q.ws + RSV_OFF); wide_gemm(xb, W + WB_GU2, 5632, DM, e, smem, bid); })
    PH({ EpiDOWN e; e.x = (float*)(q.ws + X_OFF); e.xb = (u16*)(q.ws + XB_OFF); e.ssq = (float*)(q.ws + SSQ_OFF); e.f = 0.5f; resid_gemm(P, DFF, W + WB_DN2, DFF, e, (float*)(q.ws + PART_OFF), smem, bid); })
  }
  PH({ final_phase(q, vb, nvb); })
}

extern "C" void kernel_launch(void* const* d_in, const int* in_sizes, int n_in, void* d_out, int out_size, void* d_ws, size_t ws_size,
                              hipStream_t stream) {
  if (ws_size < WS_NEED || n_in < 30) { fprintf(stderr, "workspace too small: %zu < %zu\n", ws_size, (size_t)WS_NEED); return; }
  static int grid_blocks = 0;
  if (!grid_blocks) {
    hipFuncSetAttribute((const void*)mega, hipFuncAttributeMaxDynamicSharedMemorySize, LDS_BYTES);
    int dev = 0, cus = 0, per_cu = 0;
    hipGetDevice(&dev);
    hipDeviceGetAttribute(&cus, hipDeviceAttributeMultiprocessorCount, dev);
    hipOccupancyMaxActiveBlocksPerMultiprocessor(&per_cu, mega, 512, LDS_BYTES);
    per_cu = 1;
    grid_blocks = cus * per_cu;
  }
  Params p{};
  for (int i = 0; i < 30; ++i) p.in[i] = (const float*)d_in[i];
  p.out = (float*)d_out;
  p.ws = (char*)d_ws;
  hipMemsetAsync((char*)d_ws + BAR_OFF, 0, XCD_BAR_WORDS * 4, stream);
#ifdef MK_MULTI
  for (int ph = 0; ph < 43; ++ph) {
    int lo = ph, hi = ph + 1;
    hipLaunchKernelGGL(mega, dim3(grid_blocks), dim3(512), LDS_BYTES, stream, p, lo, hi);
  }
#else
  int lo = 0, hi = 43;
  void* args[] = {&p, &lo, &hi};
  hipError_t e = hipLaunchCooperativeKernel((void*)mega, dim3(grid_blocks), dim3(512), args, LDS_BYTES, stream);
  if (e != hipSuccess) fprintf(stderr, "cooperative launch failed: %s (grid %d)\n", hipGetErrorString(e), grid_blocks);
#endif
}
```
